# Optimizing an MI355X kernel written in HIP

```python
import math
import jax, jax.numpy as jnp
from jax import lax
import numpy as np

D_MODEL = 1024
BATCH = 8
SEQ = 4096
DEPTH = 2

D_MIX = D_MODEL
MLA_HEADS = 8
QK_NOPE_DIM = 64
QK_ROPE_DIM = 32
V_HEAD_DIM = 64
Q_LORA_RANK = 256
KV_LORA_RANK = 128
MLA_WIDTH = MLA_HEADS * V_HEAD_DIM
ROPE_THETA = 10000.0
Q_BLOCK = 128
SSM_WIDTH = D_MIX - MLA_WIDTH
SSM_GROUP = 16
SSM_GROUPS = SSM_WIDTH // SSM_GROUP
SSM_STATE = 64
DT_MIN = 0.001
DT_MAX = 0.1
IN_WIDTH = Q_LORA_RANK + KV_LORA_RANK + QK_ROPE_DIM + SSM_WIDTH
MEM_LEN = 256
X_HEADS = 4
X_HEAD_DIM = D_MODEL // X_HEADS
D_FF = -(-8 * D_MODEL // (3 * 256)) * 256
EPS = 1e-6

kernel_name = 'hybrid_mla_s5_memory_decoder'


def rmsnorm(x, g):
    xf = x.astype(jnp.float32)
    y = xf * lax.rsqrt(jnp.mean(xf * xf, axis=-1, keepdims=True) + EPS)
    return (y * g.astype(jnp.float32)).astype(x.dtype)


def apply_rope(x, cos, sin):
    xf = x.astype(jnp.float32)
    half = xf.shape[-1] // 2
    x1, x2 = xf[..., :half], xf[..., half:]
    return jnp.concatenate([x1 * cos - x2 * sin, x2 * cos + x1 * sin], axis=-1).astype(x.dtype)


def mla_group(c_q, c_kv, k_r, q_norm_g, w_uq, kv_norm_g, w_ukv, cos, sin):
    B, S, _ = c_q.shape
    q = (rmsnorm(c_q, q_norm_g) @ w_uq).reshape(B, S, MLA_HEADS, QK_NOPE_DIM + QK_ROPE_DIM)
    q_nope = q[..., :QK_NOPE_DIM]
    q_rope = apply_rope(q[..., QK_NOPE_DIM:], cos[:, :, None, :], sin[:, :, None, :])
    kv = (rmsnorm(c_kv, kv_norm_g) @ w_ukv).reshape(B, S, MLA_HEADS, QK_NOPE_DIM + V_HEAD_DIM)
    k_nope = kv[..., :QK_NOPE_DIM].transpose(0, 2, 1, 3)
    v = kv[..., QK_NOPE_DIM:].transpose(0, 2, 1, 3)
    k_rope = apply_rope(k_r, cos, sin)
    scale = (QK_NOPE_DIM + QK_ROPE_DIM) ** -0.5
    qn = (q_nope * scale).transpose(0, 2, 1, 3)
    qr = (q_rope * scale).transpose(0, 2, 1, 3)
    outs = []
    for i in range(S // Q_BLOCK):
        lo, hi = i * Q_BLOCK, (i + 1) * Q_BLOCK
        s = (jnp.einsum('bhqd,bhkd->bhqk', qn[:, :, lo:hi], k_nope[:, :, :hi])
             + jnp.einsum('bhqr,bkr->bhqk', qr[:, :, lo:hi], k_rope[:, :hi])).astype(jnp.float32)
        mask = jnp.arange(hi)[None, :] <= jnp.arange(lo, hi)[:, None]
        s = jnp.where(mask, s, -jnp.inf)
        p = jax.nn.softmax(s, axis=-1).astype(v.dtype)
        outs.append(jnp.einsum('bhqk,bhkd->bqhd', p, v[:, :, :hi]))
    o = jnp.concatenate(outs, axis=1)
    return o.reshape(B, S, MLA_WIDTH)


def s5_group(u, lam_re, lam_im, log_dt, b_re, b_im, c_re, c_im, d, w_glu, b_glu):
    B, S, _ = u.shape
    f32 = jnp.float32
    uf = u.astype(f32)
    ug = uf.reshape(B, S, SSM_GROUPS, SSM_GROUP)
    lam = lax.complex(lam_re.astype(f32), lam_im.astype(f32))
    dt = jnp.exp(log_dt.astype(f32))[:, None]
    a_bar = jnp.exp(lam * dt)
    b_mat = lax.complex(b_re.astype(f32), b_im.astype(f32))
    b_bar = ((a_bar - 1.0) / lam)[..., None] * b_mat
    bu = jnp.einsum('bsgc,gpc->bsgp', ug.astype(jnp.complex64), b_bar)
    a_elems = jnp.broadcast_to(a_bar, bu.shape)

    def combine(e1, e2):
        a1, x1 = e1
        a2, x2 = e2
        return a1 * a2, a2 * x1 + x2

    _, states = lax.associative_scan(combine, (a_elems, bu), axis=1)
    c_mat = lax.complex(c_re.astype(f32), c_im.astype(f32))
    y = jnp.einsum('bsgp,gcp->bsgc', states, c_mat).real.reshape(B, S, SSM_WIDTH)
    y = y + d.astype(f32) * uf
    g = jax.nn.gelu(y)
    y = y * jax.nn.sigmoid(g @ w_glu.astype(f32) + b_glu.astype(f32))
    return y.astype(u.dtype)


def memory_cross_attention(hn, memn, w_xq, w_xkv, w_xo):
    B, S, _ = hn.shape
    M = memn.shape[1]
    q = (hn @ w_xq).reshape(B, S, X_HEADS, X_HEAD_DIM)
    kv = (memn @ w_xkv).reshape(B, M, 2, X_HEADS, X_HEAD_DIM)
    k, v = kv[:, :, 0], kv[:, :, 1]
    s = jnp.einsum('bshd,bmhd->bhsm', q, k).astype(jnp.float32) * (X_HEAD_DIM ** -0.5)
    p = jax.nn.softmax(s, axis=-1).astype(v.dtype)
    o = jnp.einsum('bhsm,bmhd->bshd', p, v).reshape(B, S, D_MODEL)
    return o @ w_xo


def swiglu(hn, w_gate, w_up, w_down):
    return (jax.nn.silu(hn @ w_gate) * (hn @ w_up)) @ w_down


def setup_inputs(seed: int = 0) -> dict:
    key = jax.random.key(seed)
    ks = jax.random.split(key, 40)
    f32 = jnp.float32

    def nrm(k, shape, fan_in):
        return jax.random.normal(k, shape, f32) * (fan_in ** -0.5)

    def gain(k, shape):
        return 1.0 + 0.05 * jax.random.normal(k, shape, f32)

    L = DEPTH
    x = jax.random.normal(ks[0], (BATCH, SEQ, D_MODEL), f32)
    mem = jax.random.normal(ks[1], (BATCH, MEM_LEN, D_MODEL), f32)
    start = jax.random.randint(ks[2], (BATCH, 1), 0, 1024, dtype=jnp.int32)
    positions = start + jnp.arange(SEQ, dtype=jnp.int32)[None, :]
    n_idx = jnp.arange(SSM_STATE, dtype=f32)
    ssm_lambda_re = -0.5 * jnp.exp(0.05 * jax.random.normal(ks[9], (L, SSM_GROUPS, SSM_STATE), f32))
    ssm_lambda_im = jnp.pi * n_idx + 0.01 * jax.random.normal(ks[10], (L, SSM_GROUPS, SSM_STATE), f32)
    ssm_log_dt = jax.random.uniform(ks[11], (L, SSM_GROUPS), f32, math.log(DT_MIN), math.log(DT_MAX))
    return {
        'x': x,
        'mem': mem,
        'positions': positions,
        'norm_mix_g': gain(ks[3], (L, D_MODEL)),
        'w_in': nrm(ks[4], (L, D_MODEL, IN_WIDTH), D_MODEL),
        'q_norm_g': gain(ks[5], (L, Q_LORA_RANK)),
        'w_uq': nrm(ks[6], (L, Q_LORA_RANK, MLA_HEADS * (QK_NOPE_DIM + QK_ROPE_DIM)), Q_LORA_RANK),
        'kv_norm_g': gain(ks[7], (L, KV_LORA_RANK)),
        'w_ukv': nrm(ks[8], (L, KV_LORA_RANK, MLA_HEADS * (QK_NOPE_DIM + V_HEAD_DIM)), KV_LORA_RANK),
        'ssm_lambda_re': ssm_lambda_re,
        'ssm_lambda_im': ssm_lambda_im,
        'ssm_log_dt': ssm_log_dt,
        'ssm_b_re': nrm(ks[12], (L, SSM_GROUPS, SSM_STATE, SSM_GROUP), 2 * SSM_GROUP),
        'ssm_b_im': nrm(ks[13], (L, SSM_GROUPS, SSM_STATE, SSM_GROUP), 2 * SSM_GROUP),
        'ssm_c_re': nrm(ks[14], (L, SSM_GROUPS, SSM_GROUP, SSM_STATE), 2 * SSM_STATE),
        'ssm_c_im': nrm(ks[15], (L, SSM_GROUPS, SSM_GROUP, SSM_STATE), 2 * SSM_STATE),
        'ssm_d': jax.random.normal(ks[16], (L, SSM_WIDTH), f32),
        'ssm_w_glu': nrm(ks[17], (L, SSM_WIDTH, SSM_WIDTH), SSM_WIDTH),
        'ssm_b_glu': 0.01 * jax.random.normal(ks[18], (L, SSM_WIDTH), f32),
        'attn_out_g': gain(ks[19], (L, MLA_WIDTH)),
        'ssm_out_g': gain(ks[20], (L, SSM_WIDTH)),
        'w_out': nrm(ks[21], (L, D_MIX, D_MODEL), D_MIX),
        'norm_x_g': gain(ks[22], (L, D_MODEL)),
        'mem_norm_g': gain(ks[23], (L, D_MODEL)),
        'w_xq': nrm(ks[24], (L, D_MODEL, D_MODEL), D_MODEL),
        'w_xkv': nrm(ks[25], (L, D_MODEL, 2 * D_MODEL), D_MODEL),
        'w_xo': nrm(ks[26], (L, D_MODEL, D_MODEL), D_MODEL),
        'norm_ffn_g': gain(ks[27], (L, D_MODEL)),
        'w_gate': nrm(ks[28], (L, D_MODEL, D_FF), D_MODEL),
        'w_up': nrm(ks[29], (L, D_MODEL, D_FF), D_MODEL),
        'w_down': nrm(ks[30], (L, D_FF, D_MODEL), D_FF),
        'final_norm_g': gain(ks[31], (D_MODEL,)),
    }


def reference(x, mem, positions, norm_mix_g, w_in, q_norm_g, w_uq, kv_norm_g, w_ukv,
              ssm_lambda_re, ssm_lambda_im, ssm_log_dt, ssm_b_re, ssm_b_im, ssm_c_re, ssm_c_im,
              ssm_d, ssm_w_glu, ssm_b_glu, attn_out_g, ssm_out_g, w_out, norm_x_g, mem_norm_g,
              w_xq, w_xkv, w_xo, norm_ffn_g, w_gate, w_up, w_down, final_norm_g):
    freqs = ROPE_THETA ** (-jnp.arange(0, QK_ROPE_DIM, 2, dtype=jnp.float32) / QK_ROPE_DIM)
    ang = positions.astype(jnp.float32)[..., None] * freqs
    cos, sin = jnp.cos(ang), jnp.sin(ang)
    split_at = [Q_LORA_RANK, Q_LORA_RANK + KV_LORA_RANK, Q_LORA_RANK + KV_LORA_RANK + QK_ROPE_DIM]
    h = x
    for l in range(DEPTH):
        xn = rmsnorm(h, norm_mix_g[l])
        proj = xn @ w_in[l]
        c_q, c_kv, k_r, u = jnp.split(proj, split_at, axis=-1)
        a_out = mla_group(c_q, c_kv, k_r, q_norm_g[l], w_uq[l], kv_norm_g[l], w_ukv[l], cos, sin)
        s_out = s5_group(u, ssm_lambda_re[l], ssm_lambda_im[l], ssm_log_dt[l], ssm_b_re[l], ssm_b_im[l],
                         ssm_c_re[l], ssm_c_im[l], ssm_d[l], ssm_w_glu[l], ssm_b_glu[l])
        mixed = jnp.concatenate([rmsnorm(a_out, attn_out_g[l]), rmsnorm(s_out, ssm_out_g[l])], axis=-1)
        h = h + mixed @ w_out[l]
        h = h + memory_cross_attention(rmsnorm(h, norm_x_g[l]), rmsnorm(mem, mem_norm_g[l]),
                                       w_xq[l], w_xkv[l], w_xo[l])
        h = h + swiglu(rmsnorm(h, norm_ffn_g[l]), w_gate[l], w_up[l], w_down[l])
    return rmsnorm(h, final_norm_g)
```

```cpp
#include <hip/hip_runtime.h>
#include <hip/hip_bf16.h>
#include <cstdint>
#include <cstdio>
#include <cmath>

#define LAS __attribute__((address_space(3)))
typedef unsigned short bf16_t;
typedef short bf16x8 __attribute__((ext_vector_type(8)));
typedef short s16x4 __attribute__((ext_vector_type(4)));
typedef float f32x4 __attribute__((ext_vector_type(4)));
typedef float f32x2 __attribute__((ext_vector_type(2)));
typedef float f32x16 __attribute__((ext_vector_type(16)));
typedef unsigned u32x4 __attribute__((ext_vector_type(4)));
typedef unsigned u32x2 __attribute__((ext_vector_type(2)));

constexpr int D = 1024, NB = 8, S = 4096, T = NB * S, NL = 2, FF = 2816;
constexpr int NH = 8, QKD = 96, HD = 64;
constexpr int LC = 32, KS1 = 16 * LC  , KS3 = KS1 + 128  , NCHB = S / LC  , NCH = T / LC  ;
constexpr int MEMT = 256;
constexpr float EPS = 1e-6f;
constexpr float LOG2E = 1.4426950408889634f;

constexpr size_t MiB = 1u << 20;
constexpr size_t WS_CTL = 0, CTL_ZERO_BYTES = 4 * MiB;
constexpr size_t WS_CS = 4 * MiB;
constexpr size_t WS_W = 8 * MiB;
constexpr size_t WL_IN = 0, WL_UP = 2 * MiB, WL_GLU = 3 * MiB, WL_OUT = 3 * MiB + 512 * 1024, WL_XQ = 5 * MiB + 512 * 1024, WL_GU = 7 * MiB + 512 * 1024, WL_DN = 18 * MiB + 512 * 1024, WL_STRIDE = 24 * MiB + 512 * 1024;
constexpr size_t WS_WXKV = WS_W + 2 * WL_STRIDE;
constexpr size_t WS_WXO = WS_WXKV + 8 * MiB;
constexpr size_t WS_SSM = 70 * MiB;
constexpr size_t SSM_G_STRIDE = 896 * 1024, SSM_BT3_OFF = 256 * 1024;
constexpr size_t WS_AL = 126 * MiB;
constexpr size_t WS_WKVW = 128 * MiB;
constexpr size_t WS_HB = 192 * MiB;
constexpr size_t WS_ASSM = 256 * MiB;
constexpr size_t WS_RA = 296 * MiB;
constexpr size_t WS_END = WS_RA + 176 * MiB;
constexpr size_t RA_PROJB = 0, RA_AO = 0, RA_Q = 32 * MiB, RA_K = 80 * MiB, RA_V = 128 * MiB, RA_XLOC = 160 * MiB;
constexpr size_t RA_Y = 32 * MiB, RA_G = 64 * MiB, RA_SOUT = 96 * MiB;
constexpr size_t RA_P = 0, RA_HID = 0, RA_MEMN = 0, RA_KVM = 4 * MiB;
constexpr int CW_BAR = 4096;
constexpr int CW_SQ = 65536;
enum SqId { SQ_MIX = 0, SQ_CQ = 1, SQ_CKV = 2, SQ_A = 3, SQ_S = 4, SQ_X = 5, SQ_FFN = 6, SQ_PER_LAYER = 7 };
static_assert((size_t)(CW_SQ + 16 * T) * 4 <= CTL_ZERO_BYTES, "ctl");

constexpr int RING_BYTES = 131072, XCH_OFF = RING_BYTES  , LDSCTL_OFF = XCH_OFF + 12288, LDS_BYTES = 147456;

__device__ __forceinline__ unsigned cvt_pk_bf16(float lo, float hi) { typedef __bf16 bf2 __attribute__((ext_vector_type(2))); f32x2 v = {lo, hi}; bf2 b = __builtin_convertvector(v, bf2); return __builtin_bit_cast(unsigned, b); }
__device__ __forceinline__ float bf_lo(unsigned w) { return __uint_as_float(w << 16); }
__device__ __forceinline__ float bf_hi(unsigned w) { return __uint_as_float(w & 0xffff0000u); }
__device__ __forceinline__ float rstd_of(float sq, float inv_n) { return rsqrtf(sq * inv_n + EPS); }

#define XB_TMO      128
#define XB_XCNT(j)  (256  + 64 * (j))
#define XB_XSUB(j)  (1280 + 64 * (j))
#define XB_XGEN(j)  (2304 + 64 * (j))
#define XB_TOP      3328
#define XB_TOPGEN   3392
#define XCD_BAR_WORDS 3456
#define XB_SPIN_CAP (1u << 20)
__device__ __forceinline__ unsigned xb_ld(unsigned* p)              { return __hip_atomic_load(p, __ATOMIC_RELAXED, __HIP_MEMORY_SCOPE_AGENT); }
__device__ __forceinline__ unsigned xb_add(unsigned* p, unsigned v) { return __hip_atomic_fetch_add(p, v, __ATOMIC_RELAXED, __HIP_MEMORY_SCOPE_AGENT); }
__device__ __forceinline__ unsigned xb_xcc_id() { return (unsigned)__builtin_amdgcn_s_getreg((3 << 11) | 20) & 0xFu; }
#define XB_SPIN(cond, bar) do { unsigned _sp = 0; while (cond) { __builtin_amdgcn_s_sleep(1); \
    if ((++_sp & 255u) == 0u) { if (xb_ld(&(bar)[XB_TMO])) break; if (_sp > XB_SPIN_CAP) { atomicAdd(&(bar)[XB_TMO], 1u); break; } } } } while (0)
struct XcdBarrier { unsigned* bar; unsigned x; volatile LAS unsigned* st; };
__device__ __forceinline__ XcdBarrier xcd_barrier_post(unsigned* bar, volatile LAS unsigned* st) {
    XcdBarrier b; b.bar = bar; b.x = xb_xcc_id(); b.st = st;
    if (threadIdx.x == 0) (void)xb_add(&bar[XB_XCNT(b.x)], 1u);
    return b;
}
__device__ __forceinline__ void xcd_barrier_complete(unsigned* bar, unsigned x, unsigned& nloc, unsigned& nx) {
    const unsigned G = gridDim.x * gridDim.y * gridDim.z;
    unsigned sum, cnt, mine, sp = 0u;
    for (;;) {
        sum = 0u; cnt = 0u; mine = 0u;
#pragma unroll
        for (unsigned j = 0; j < 16; ++j) { const unsigned c = xb_ld(&bar[XB_XCNT(j)]); sum += c; cnt += (c > 0u) ? 1u : 0u; mine = (j == x) ? c : mine; }
        if (sum == G) break;
        __builtin_amdgcn_s_sleep(1);
        if ((++sp & 255u) == 0u) { if (xb_ld(&bar[XB_TMO])) break; if (sp > XB_SPIN_CAP) { atomicAdd(&bar[XB_TMO], 1u); break; } }
    }
    nloc = mine > 0u ? mine : 1u; nx = cnt > 0u ? cnt : 1u;
}
__device__ __forceinline__ void xcd_barrier(const XcdBarrier& b) {
    asm volatile("s_waitcnt vmcnt(0)" ::: "memory");
    __syncthreads();
    if (threadIdx.x == 0) {
        unsigned* bar = b.bar; asm volatile("" : "+s"(bar));
        __builtin_amdgcn_s_waitcnt(0);
        unsigned nloc = b.st[0], nx = b.st[1];
        if (nloc == 0u) { xcd_barrier_complete(bar, b.x, nloc, nx); b.st[0] = nloc; b.st[1] = nx; }
        const unsigned old = xb_add(&bar[XB_XSUB(b.x)], 1u);
        const unsigned gen = old / nloc;
        if (old + 1u == (gen + 1u) * nloc) {
            __builtin_amdgcn_fence(__ATOMIC_RELEASE, "agent");
            asm volatile("s_waitcnt vmcnt(0)" ::: "memory");
            const unsigned og = xb_add(&bar[XB_TOP], 1u);
            const unsigned tg = og / nx;
            if (og + 1u == (tg + 1u) * nx) xb_add(&bar[XB_TOPGEN], 1u);
            else XB_SPIN(xb_ld(&bar[XB_TOPGEN]) == tg, bar);
            __builtin_amdgcn_fence(__ATOMIC_ACQUIRE, "agent");
            xb_add(&bar[XB_XGEN(b.x)], 1u);
            asm volatile("s_waitcnt vmcnt(0)" ::: "memory");
        } else {
            XB_SPIN(xb_ld(&bar[XB_XGEN(b.x)]) == gen, bar);
            __builtin_amdgcn_fence(__ATOMIC_ACQUIRE, "agent");
            asm volatile("s_waitcnt vmcnt(0)" ::: "memory");
        }
    }
    __syncthreads();
}

namespace pg8 {
constexpr int BM = 256, BK = 64, HALF = 128, HTB = HALF * BK * 2, STAGE_BYTES = 8 * HTB, NXCD = 8, WGM = 8;
__host__ __device__ __forceinline__ int lds_byte(int r, int c) { const int st = (r >> 4) * 2 + (c >> 5), rr = r & 15, cc = c & 31, ob = rr * 64 + cc * 2; return st * 1024 + (ob ^ (((ob >> 9) & 1) << 5)); }
__host__ __device__ __forceinline__ void stage_rc(int b, int& R, int& C) { const int st = b / 1024, sb = b % 1024, swz = sb ^ (((sb >> 9) & 1) << 5); R = (st >> 1) * 16 + swz / 64; C = (st & 1) * 32 + (swz % 64) / 2; }
__host__ __device__ __forceinline__ int perm32(int rho) { const int n = rho >> 4, i = rho & 15; return 8 * (i >> 2) + 4 * n + (i & 3); }
struct Unit { int pm, pn; };
struct StaticOrder {
    int nM, nN, nwg, G, c;
    __device__ void init(int nM_, int nN_, int G_, int c_) { nM = nM_; nN = nN_; nwg = nM * nN; G = G_; c = c_; }
    __device__ bool next(int i, Unit& u) const {
        const long L = (long)i * G + c; if (L >= nwg) return false;
        int wgid = (int)L; { const int q = nwg / NXCD, r = nwg % NXCD, xcd = wgid % NXCD, off = wgid / NXCD; wgid = (xcd < r ? xcd * (q + 1) : r * (q + 1) + (xcd - r) * q) + off; }
        const int nig = WGM * nN, gid = wgid / nig, fm = gid * WGM, gsz = (nM - fm) < WGM ? (nM - fm) : WGM;
        u.pm = fm + ((wgid % nig) % gsz); u.pn = (wgid % nig) / gsz; return true;
    }
};
struct Ctx { int wr, wc, fr, fq, wid, lane, tid; LAS unsigned char* lds; };
typedef f32x4 Acc[2][2][4][2];

struct GemmArgs { int K, lda, ldb, tsplit; long a_delta; };

template <class Epi, class Panel>
__device__ __forceinline__ void gemm_phase(LAS unsigned char* lds, const GemmArgs g, const StaticOrder& S, const Panel& PN, const Epi& E) {
    int tid_ = threadIdx.x; asm volatile("" : "+v"(tid_));
    const int tid = tid_, wid = __builtin_amdgcn_readfirstlane(tid >> 6), lane = tid & 63, wr = wid >> 2, wc = wid & 3, fr = lane & 15, fq = lane >> 4;
    const int nt = g.K / BK;
    Ctx cx{wr, wc, fr, fq, wid, lane, tid, lds};
    unsigned voffA[2], voffB[2];
#pragma unroll
    for (int i = 0; i < 2; ++i) { int R, C; stage_rc(tid * 16 + i * 8192, R, C); const int Rb = (R & ~31) + perm32(R & 31);
        voffA[i] = (unsigned)(R * g.lda + C) * 2u; voffB[i] = (unsigned)(Rb * g.ldb + C) * 2u; }
    const size_t kstep = (size_t)(BK * 2);
    const size_t hstepA = (size_t)HALF * g.lda * 2, hstepB = (size_t)HALF * g.ldb * 2;
    const unsigned ldsw = (unsigned)wid * 1024u;
    const int aoff = lds_byte(wr * 64 + fr, fq * 8), boff = lds_byte(wc * 32 + fr, fq * 8);
#define PG8_SA(b, h) (((b) * 2 + (h)) * HTB)
#define PG8_SB(b, h) ((4 + (b) * 2 + (h)) * HTB)
#define PG8_STAGE(bufoff, gbase, voff) do { _Pragma("unroll") for (int _i = 0; _i < 2; ++_i) \
        __builtin_amdgcn_global_load_lds((const unsigned*)((const char*)(gbase) + (voff)[_i]), (LAS unsigned*)(lds + (bufoff) + ldsw + _i * 8192), 16, 0, 0); } while (0)
#define PG8_LDA(dst, b, h) do { _Pragma("unroll") for (int m = 0; m < 4; ++m) _Pragma("unroll") for (int k = 0; k < 2; ++k) dst[m][k] = *(const LAS bf16x8*)(lds + PG8_SA(b, h) + aoff + m * 2048 + k * 1024); } while (0)
#define PG8_LDB(dst, b, h) do { _Pragma("unroll") for (int n = 0; n < 2; ++n) _Pragma("unroll") for (int k = 0; k < 2; ++k) dst[n][k] = *(const LAS bf16x8*)(lds + PG8_SB(b, h) + boff + n * 2048 + k * 1024); } while (0)
#define PG8_MMA(ai, bj, At, Bt) do { __builtin_amdgcn_s_setprio(1); _Pragma("unroll") for (int m = 0; m < 4; ++m) _Pragma("unroll") for (int n = 0; n < 2; ++n) _Pragma("unroll") for (int k = 0; k < 2; ++k) \
        acc[ai][bj][m][n] = __builtin_amdgcn_mfma_f32_16x16x32_bf16(Bt[n][k], At[m][k], acc[ai][bj][m][n], 0, 0, 0); __builtin_amdgcn_s_setprio(0); } while (0)
#define PG8_WAIT_V(n) asm volatile("s_waitcnt vmcnt(" #n ")" ::: "memory")
#define PG8_WAIT_L(n) asm volatile("s_waitcnt lgkmcnt(" #n ")" ::: "memory")
#define PG8_BAR __builtin_amdgcn_s_barrier()
#define PG8_SCHED __builtin_amdgcn_sched_barrier(0)
#define PG8_AP(base, tt) ((base) + (size_t)(tt) * kstep + (((tt) >= g.tsplit) ? g.a_delta : 0l))
    Unit cur, nxt; int ui = 0;
    if (!S.next(0, cur)) return;
    Acc acc;
#pragma unroll
    for (int a = 0; a < 2; ++a)
#pragma unroll
        for (int b = 0; b < 2; ++b)
#pragma unroll
            for (int m = 0; m < 4; ++m)
#pragma unroll
                for (int n = 0; n < 2; ++n) acc[a][b][m][n] = (f32x4){0.f, 0.f, 0.f, 0.f};
    bf16x8 At[4][2], B0[2][2], B1[2][2];
    const char* cA; const char* cB; PN(cur, cA, cB);
    if constexpr (Epi::HAS_BEGIN) E.begin(cur, cx, ui);
    PG8_STAGE(PG8_SB(0, 0), cB, voffB); PG8_STAGE(PG8_SB(0, 1), cB + hstepB, voffB); PG8_STAGE(PG8_SA(0, 0), cA, voffA); PG8_STAGE(PG8_SA(0, 1), cA + hstepA, voffA);
    if (wr == 1) PG8_BAR;
    PG8_WAIT_V(2); PG8_BAR;
    PG8_STAGE(PG8_SB(1, 0), cB + kstep, voffB); PG8_STAGE(PG8_SA(1, 0), cA + kstep, voffA); PG8_STAGE(PG8_SB(1, 1), cB + hstepB + kstep, voffB);
    PG8_WAIT_V(6); PG8_BAR;
    for (;;) {
        const bool has_next = S.next(ui + 1, nxt);
        const char* nA = cA; const char* nB = cB; if (has_next) PN(nxt, nA, nB);
#pragma unroll 1
        for (int t = 0; t < nt; t += 2) {
            const bool last = (t == nt - 2);
            if constexpr (Epi::HAS_MID) { if (t == g.tsplit) E.mid(acc, cur, cx, ui); }
            const char* a1 = PG8_AP(cA, t + 1);
            const char* a2 = last ? nA : PG8_AP(cA, t + 2); const char* b2 = last ? nB : cB + (size_t)(t + 2) * kstep;
            const char* a3 = last ? nA + kstep : PG8_AP(cA, t + 3); const char* b3 = b2 + kstep;
            PG8_LDB(B0, 0, 0); PG8_LDB(B1, 0, 1); PG8_SCHED; PG8_LDA(At, 0, 0); PG8_STAGE(PG8_SA(1, 1), a1 + hstepA, voffA);
            PG8_WAIT_V(8); PG8_WAIT_L(0); PG8_BAR; PG8_MMA(0, 0, At, B0); PG8_MMA(0, 1, At, B1); PG8_BAR; PG8_SCHED;
            PG8_LDA(At, 0, 1); PG8_STAGE(PG8_SB(0, 0), b2, voffB); PG8_STAGE(PG8_SB(0, 1), b2 + hstepB, voffB); PG8_STAGE(PG8_SA(0, 0), a2, voffA);
            PG8_WAIT_V(8); PG8_WAIT_L(0); PG8_BAR; PG8_MMA(1, 0, At, B0); PG8_MMA(1, 1, At, B1); PG8_BAR; PG8_SCHED;
            PG8_LDB(B0, 1, 0); PG8_LDB(B1, 1, 1); PG8_SCHED; PG8_LDA(At, 1, 0); PG8_STAGE(PG8_SA(0, 1), a2 + hstepA, voffA);
            PG8_WAIT_V(8); PG8_WAIT_L(0); PG8_BAR; PG8_MMA(0, 0, At, B0); PG8_MMA(0, 1, At, B1); PG8_BAR; PG8_SCHED;
            PG8_LDA(At, 1, 1); PG8_STAGE(PG8_SB(1, 0), b3, voffB); PG8_STAGE(PG8_SB(1, 1), b3 + hstepB, voffB); PG8_STAGE(PG8_SA(1, 0), a3, voffA);
            PG8_WAIT_V(8); PG8_WAIT_L(0); PG8_BAR; PG8_MMA(1, 0, At, B0); PG8_MMA(1, 1, At, B1); PG8_BAR; PG8_SCHED;
        }
        if (wr == 0) PG8_BAR;
        E(acc, cur, cx, ui);
        if (!has_next) break;
#pragma unroll
        for (int a = 0; a < 2; ++a)
#pragma unroll
            for (int b = 0; b < 2; ++b)
#pragma unroll
                for (int m = 0; m < 4; ++m)
#pragma unroll
                    for (int n = 0; n < 2; ++n) acc[a][b][m][n] = (f32x4){0.f, 0.f, 0.f, 0.f};
        cur = nxt; cA = nA; cB = nB; ++ui;
        if constexpr (Epi::HAS_BEGIN) E.begin(cur, cx, ui);
        if (wr == 1) PG8_BAR;
    }
    PG8_WAIT_V(0);
    PG8_BAR;
    asm volatile("" ::: "memory");
#undef PG8_SA
#undef PG8_SB
#undef PG8_STAGE
#undef PG8_LDA
#undef PG8_LDB
#undef PG8_MMA
#undef PG8_WAIT_V
#undef PG8_WAIT_L
#undef PG8_BAR
#undef PG8_SCHED
#undef PG8_AP
}
}
namespace ep {
using pg8::Acc; using pg8::Ctx; using pg8::Unit;
#define EP_FOR_ROWS _Pragma("unroll") for (int ai = 0; ai < 2; ++ai) _Pragma("unroll") for (int m = 0; m < 4; ++m)
#define EP_RU (ai * 128 + cx.wr * 64 + m * 16)
#define EP_FENCE asm volatile("" ::: "memory")
__device__ __forceinline__ u32x4 pack8(const f32x4 a, const f32x4 b) { u32x4 w; w.x = cvt_pk_bf16(a[0], a[1]); w.y = cvt_pk_bf16(a[2], a[3]); w.z = cvt_pk_bf16(b[0], b[1]); w.w = cvt_pk_bf16(b[2], b[3]); return w; }
__device__ __forceinline__ float sq8(const f32x4 a, const f32x4 b) { return (a[0] * a[0] + a[1] * a[1]) + (a[2] * a[2] + a[3] * a[3]) + (b[0] * b[0] + b[1] * b[1]) + (b[2] * b[2] + b[3] * b[3]); }
__device__ __forceinline__ void row_atomic(float* sq_u, int fr, float ss, int fq) { ss += __shfl_xor(ss, 16); ss += __shfl_xor(ss, 32); if (fq == 0) unsafeAtomicAdd(sq_u + fr, ss); }
template <class TT> __device__ __forceinline__ TT* lane_ptr(TT* uni, unsigned lane_bytes) { return (TT*)((char*)uni + lane_bytes); }
template <class TT> __device__ __forceinline__ const TT* lane_ptr(const TT* uni, unsigned lane_bytes) { return (const TT*)((const char*)uni + lane_bytes); }
__device__ __forceinline__ void rope8(f32x4& a, f32x4& b, const f32x4 c4, const f32x4 s4) {
    const f32x4 a0 = a, b0 = b;
    a[0] = a0[0] * c4[0] - a0[1] * s4[0]; a[1] = a0[1] * c4[0] + a0[0] * s4[0]; a[2] = a0[2] * c4[1] - a0[3] * s4[1]; a[3] = a0[3] * c4[1] + a0[2] * s4[1];
    b[0] = b0[0] * c4[2] - b0[1] * s4[2]; b[1] = b0[1] * c4[2] + b0[0] * s4[2]; b[2] = b0[2] * c4[3] - b0[3] * s4[3]; b[3] = b0[3] * c4[3] + b0[2] * s4[3];
}
__device__ __forceinline__ size_t koff_u(int b, int h, int s16, int chunk) { return ((((size_t)(b * 8 + h) * 64 + (s16 >> 6)) * 12 + chunk) * 64 + (s16 & 63)) * 16; }
__device__ __forceinline__ size_t voff_u(int b, int h, int s16, int dh) { return ((((size_t)(b * 8 + h) * 64 + (s16 >> 6)) * 2 + dh) * 64 + (s16 & 63)) * 64; }

struct EpiProj {
    static constexpr bool HAS_MID = false, HAS_BEGIN = false;
    const float* sq_in; float* sq_cq; float* sq_ckv; bf16_t* projb; bf16_t* assm; unsigned char* kb; const float* cs;
    __device__ __forceinline__ void operator()(Acc& acc, const Unit& u, const Ctx& cx, int) const {
        const unsigned l_pj = (unsigned)(cx.fr * 512 + cx.fq * 8) * 2u, l_cs = (unsigned)(cx.fr * 32 + cx.fq * 4) * 4u, l_k = (unsigned)cx.fr * 16u, l_as = (unsigned)(cx.fr * 16) * 2u;
        EP_FOR_ROWS { const int rowu = u.pm * 256 + EP_RU; const float rs = rstd_of(sq_in[rowu + cx.fr], 1.0f / 1024.0f);
            if (u.pn == 0) { float ss = 0.f;
#pragma unroll
                for (int bj = 0; bj < 2; ++bj) { const f32x4 v0 = acc[ai][bj][m][0] * rs, v1 = acc[ai][bj][m][1] * rs; ss += sq8(v0, v1);
                    *(u32x4*)lane_ptr(projb + (size_t)rowu * 512 + bj * 128 + cx.wc * 32, l_pj) = pack8(v0, v1); }
                row_atomic(sq_cq + rowu, cx.fr, ss, cx.fq);
            } else if (u.pn == 1) {
                { const f32x4 v0 = acc[ai][0][m][0] * rs, v1 = acc[ai][0][m][1] * rs; *(u32x4*)lane_ptr(projb + (size_t)rowu * 512 + 256 + cx.wc * 32, l_pj) = pack8(v0, v1); row_atomic(sq_ckv + rowu, cx.fr, sq8(v0, v1), cx.fq); }
                f32x4 v0 = acc[ai][1][m][0] * rs, v1 = acc[ai][1][m][1] * rs;
                if (cx.wc != 0) { v0 = (f32x4){0.f, 0.f, 0.f, 0.f}; v1 = v0; }
                *(u32x4*)lane_ptr(projb + (size_t)rowu * 512 + 384 + cx.wc * 32, l_pj) = pack8(v0, v1);
                if (cx.wc == 0) { const float* cp = lane_ptr(cs + (size_t)rowu * 32, l_cs); const f32x4 c4 = *(const f32x4*)cp, s4 = *(const f32x4*)(cp + 16);
                    rope8(v0, v1, c4, s4); const u32x4 w = pack8(v0, v1); const int b = rowu >> 12, s16 = rowu & 4095;
#pragma unroll
                    for (int h = 0; h < 8; ++h) *(u32x4*)lane_ptr(kb + koff_u(b, h, s16, 8) , l_k + (unsigned)cx.fq * 1024u) = w; }
            } else {
#pragma unroll
                for (int bj = 0; bj < 2; ++bj) { const f32x4 v0 = acc[ai][bj][m][0] * rs, v1 = acc[ai][bj][m][1] * rs; const int chu = (u.pn - 2) * 256 + bj * 128 + cx.wc * 32;
                    *(u32x4*)lane_ptr(assm + ((size_t)(chu >> 4) * NCH + (rowu >> 5)) * KS3 + (rowu & 31) * 16, l_as + (unsigned)(cx.fq >> 1) * (unsigned)(NCH * KS3 * 2) + (unsigned)(cx.fq & 1) * 16u) = pack8(v0, v1); }
            }
            EP_FENCE;
        }
    }
};
struct EpiQ {
    static constexpr bool HAS_MID = false, HAS_BEGIN = false;
    const float* sq_cq; bf16_t* qb; const float* cs;
    __device__ __forceinline__ void operator()(Acc& acc, const Unit& u, const Ctx& cx, int) const {
        const unsigned l_q = (unsigned)(cx.fr * 768 + cx.fq * 8) * 2u, l_cs = (unsigned)(cx.fr * 32 + cx.fq * 4) * 4u;
        EP_FOR_ROWS { const int rowu = u.pm * 256 + EP_RU; const float rs = rstd_of(sq_cq[rowu + cx.fr], 1.0f / 256.0f);
            f32x4 c4 = (f32x4){1.f, 1.f, 1.f, 1.f}, s4 = (f32x4){0.f, 0.f, 0.f, 0.f}; if (u.pn == 2) { const float* cp = lane_ptr(cs + (size_t)rowu * 32, l_cs); c4 = *(const f32x4*)cp; s4 = *(const f32x4*)(cp + 16); }
#pragma unroll
            for (int bj = 0; bj < 2; ++bj) { f32x4 v0 = acc[ai][bj][m][0] * rs, v1 = acc[ai][bj][m][1] * rs;
                if (u.pn == 2) rope8(v0, v1, c4, s4);
                *(u32x4*)lane_ptr(qb + (size_t)rowu * 768 + u.pn * 256 + bj * 128 + cx.wc * 32, l_q) = pack8(v0, v1); }
            EP_FENCE; }
    }
};
struct EpiKV {
    static constexpr bool HAS_MID = false, HAS_BEGIN = false;
    const float* sq_ckv; unsigned char* kb; unsigned char* vb;
    __device__ __forceinline__ void operator()(Acc& acc, const Unit& u, const Ctx& cx, int) const {
        const unsigned l_kv = (cx.wc < 2) ? (unsigned)cx.fr * 16u + (unsigned)cx.fq * 1024u : (unsigned)cx.fr * 64u + (unsigned)cx.fq * 16u;
        EP_FOR_ROWS { const int rowu = u.pm * 256 + EP_RU; const float rs = rstd_of(sq_ckv[rowu + cx.fr], 1.0f / 128.0f); const int b = rowu >> 12, s16 = rowu & 4095;
#pragma unroll
            for (int bj = 0; bj < 2; ++bj) { const f32x4 v0 = acc[ai][bj][m][0] * rs, v1 = acc[ai][bj][m][1] * rs; const int h = 2 * u.pn + bj;
                unsigned char* dst = (cx.wc < 2) ? kb + koff_u(b, h, s16, cx.wc * 4) : vb + voff_u(b, h, s16, cx.wc - 2);
                *(u32x4*)lane_ptr(dst, l_kv) = pack8(v0, v1); }
            EP_FENCE; }
    }
};
struct EpiXloc {
    static constexpr bool HAS_MID = false, HAS_BEGIN = false;
    float* xloc;
    __device__ __forceinline__ void operator()(Acc& acc, const Unit& u, const Ctx& cx, int) const {
        const unsigned l_x = (unsigned)(cx.fr * 128 + cx.fq * 8) * 4u;
        EP_FOR_ROWS { const int rowu = u.pm * 256 + EP_RU; float* o = lane_ptr(xloc + (size_t)rowu * 128 + cx.wc * 32, l_x); *(f32x4*)o = acc[ai][0][m][0]; *(f32x4*)(o + 4) = acc[ai][0][m][1]; EP_FENCE; }
    }
};
__device__ __forceinline__ float gelu_tanh_f(float x) { const float z = 0.7978845608028654f * (x + 0.044715f * x * x * x); return x * __builtin_amdgcn_rcpf(1.0f + __builtin_amdgcn_exp2f(-2.0f * LOG2E * z)); }
__device__ __forceinline__ f32x4 gelu4(const f32x4 v) { return (f32x4){gelu_tanh_f(v[0]), gelu_tanh_f(v[1]), gelu_tanh_f(v[2]), gelu_tanh_f(v[3])}; }
struct EpiY {
    static constexpr bool HAS_MID = false, HAS_BEGIN = false;
    bf16_t* yb; bf16_t* gb;
    __device__ __forceinline__ void operator()(Acc& acc, const Unit& u, const Ctx& cx, int) const {
        const unsigned l_y = (unsigned)((cx.fr * 32 + (cx.fq >> 1)) * 512 + (cx.fq & 1) * 8) * 2u;
        EP_FOR_ROWS { const int rowu = u.pm * 256 + EP_RU, g = rowu >> 10, chunku = rowu & 1023;
#pragma unroll
            for (int bj = 0; bj < 2; ++bj) { const int colu = u.pn * 256 + bj * 128 + cx.wc * 32; const size_t o = ((size_t)chunku * 32 + (colu >> 4)) * 512 + g * 16;
                const f32x4 v0 = acc[ai][bj][m][0], v1 = acc[ai][bj][m][1]; *(u32x4*)lane_ptr(yb + o, l_y) = pack8(v0, v1); *(u32x4*)lane_ptr(gb + o, l_y) = pack8(gelu4(v0), gelu4(v1)); }
            EP_FENCE;
        }
    }
};
__device__ __forceinline__ float sigm(float z) { return __builtin_amdgcn_rcpf(1.0f + __builtin_amdgcn_exp2f(-LOG2E * z)); }
struct EpiGlu {
    static constexpr bool HAS_MID = false, HAS_BEGIN = false;
    const bf16_t* yb; const float* bglu; bf16_t* sout; float* sq_s;
    __device__ __forceinline__ void operator()(Acc& acc, const Unit& u, const Ctx& cx, int) const {
        const unsigned l_y = (unsigned)(cx.fr * 512 + cx.fq * 8) * 2u, l_b = (unsigned)(cx.fq * 8) * 4u;
        EP_FOR_ROWS { const int rowu = u.pm * 256 + EP_RU; float ss = 0.f;
#pragma unroll
            for (int bj = 0; bj < 2; ++bj) { const int colu = u.pn * 256 + bj * 128 + cx.wc * 32; const u32x4 yw = *(const u32x4*)lane_ptr(yb + (size_t)rowu * 512 + colu, l_y);
                const float* bp = lane_ptr(bglu + colu, l_b); const f32x4 z0 = acc[ai][bj][m][0] + *(const f32x4*)bp, z1 = acc[ai][bj][m][1] + *(const f32x4*)(bp + 4);
                const f32x4 v0 = (f32x4){bf_lo(yw.x) * sigm(z0[0]), bf_hi(yw.x) * sigm(z0[1]), bf_lo(yw.y) * sigm(z0[2]), bf_hi(yw.y) * sigm(z0[3])};
                const f32x4 v1 = (f32x4){bf_lo(yw.z) * sigm(z1[0]), bf_hi(yw.z) * sigm(z1[1]), bf_lo(yw.w) * sigm(z1[2]), bf_hi(yw.w) * sigm(z1[3])};
                ss += sq8(v0, v1); *(u32x4*)lane_ptr(sout + (size_t)rowu * 512 + colu, l_y) = pack8(v0, v1); }
            row_atomic(sq_s + rowu, cx.fr, ss, cx.fq);
            EP_FENCE;
        }
    }
};
template <bool MIX> struct EpiRes {
    static constexpr bool HAS_MID = MIX, HAS_BEGIN = MIX;
    const float* hin32; float* hout32; bf16_t* hb; float* sq_next; const float* sq_a; const float* sq_s;
    __device__ __forceinline__ void begin(const Unit& u, const Ctx& cx, int ui) const {
        if (cx.tid < 256) { const int row = u.pm * 256 + cx.tid; const float ra = rstd_of(sq_a[row], 1.0f / 512.0f), rsd = rstd_of(sq_s[row], 1.0f / 512.0f);
            ((LAS f32x2*)(cx.lds + XCH_OFF + (ui & 1) * 2048))[cx.tid] = (f32x2){ra / rsd, rsd}; }
    }
    __device__ __forceinline__ void mid(Acc& acc, const Unit&, const Ctx& cx, int ui) const {
        const LAS f32x2* tab = (const LAS f32x2*)(cx.lds + XCH_OFF + (ui & 1) * 2048) + cx.fr;
        EP_FOR_ROWS { const float r = tab[EP_RU].x;
#pragma unroll
            for (int bj = 0; bj < 2; ++bj) { acc[ai][bj][m][0] *= r; acc[ai][bj][m][1] *= r; } }
    }
    __device__ __forceinline__ void operator()(Acc& acc, const Unit& u, const Ctx& cx, int ui) const {
        const LAS f32x2* tab = (const LAS f32x2*)(cx.lds + XCH_OFF + (ui & 1) * 2048) + cx.fr;
        const unsigned l_h = (unsigned)(cx.fr * 1024 + cx.fq * 8) * 4u, l_hb = l_h >> 1;
        EP_FOR_ROWS { const int ru = EP_RU, rowu = u.pm * 256 + ru; float sc = 1.0f; if (MIX) sc = tab[ru].y; float ss = 0.f;
#pragma unroll
            for (int bj = 0; bj < 2; ++bj) { const size_t o = (size_t)rowu * 1024 + u.pn * 256 + bj * 128 + cx.wc * 32; f32x4 h0, h1;
                if (hin32) { const float* hq = lane_ptr(hin32 + o, l_h); h0 = *(const f32x4*)hq; h1 = *(const f32x4*)(hq + 4); }
                else { const u32x4 w = *(const u32x4*)lane_ptr(hb + o, l_hb); h0 = (f32x4){bf_lo(w.x), bf_hi(w.x), bf_lo(w.y), bf_hi(w.y)}; h1 = (f32x4){bf_lo(w.z), bf_hi(w.z), bf_lo(w.w), bf_hi(w.w)}; }
                const f32x4 v0 = h0 + acc[ai][bj][m][0] * sc, v1 = h1 + acc[ai][bj][m][1] * sc;
                if (hout32) { float* hp = lane_ptr(hout32 + o, l_h); *(f32x4*)hp = v0; *(f32x4*)(hp + 4) = v1; }
                else *(u32x4*)lane_ptr(hb + o, l_hb) = pack8(v0, v1);
                ss += sq8(v0, v1); }
            row_atomic(sq_next + rowu, cx.fr, ss, cx.fq);
            EP_FENCE;
        }
    }
};
struct EpiSoftmax {
    static constexpr bool HAS_MID = false, HAS_BEGIN = false;
    const float* sq_x; bf16_t* pb;
    __device__ __forceinline__ void operator()(Acc& acc, const Unit& u, const Ctx& cx, int) const {
        LAS float* PM = (LAS float*)(cx.lds + XCH_OFF + 4096) + cx.fr * 4; LAS float* PS = (LAS float*)(cx.lds + XCH_OFF + 8192) + cx.fr * 4;
        EP_FOR_ROWS { const int ru = EP_RU; const float rs = rstd_of(sq_x[u.pm * 256 + ru + cx.fr], 1.0f / 1024.0f); float mx = -3.0e38f;
#pragma unroll
            for (int bj = 0; bj < 2; ++bj)
#pragma unroll
                for (int n = 0; n < 2; ++n) { f32x4 v = acc[ai][bj][m][n] * rs; acc[ai][bj][m][n] = v; mx = fmaxf(fmaxf(mx, fmaxf(v[0], v[1])), fmaxf(v[2], v[3])); }
            mx = fmaxf(mx, __shfl_xor(mx, 16)); mx = fmaxf(mx, __shfl_xor(mx, 32));
            if (cx.fq == 0) PM[ru * 4 + cx.wc] = mx; EP_FENCE; }
        asm volatile("s_waitcnt lgkmcnt(0)" ::: "memory"); __builtin_amdgcn_s_barrier(); asm volatile("" ::: "memory");
        EP_FOR_ROWS { const int ru = EP_RU; const f32x4 q = *(const LAS f32x4*)(PM + ru * 4); const float mx = fmaxf(fmaxf(q[0], q[1]), fmaxf(q[2], q[3])); float sm = 0.f;
#pragma unroll
            for (int bj = 0; bj < 2; ++bj)
#pragma unroll
                for (int n = 0; n < 2; ++n) { f32x4 v = acc[ai][bj][m][n]; v = (f32x4){__builtin_amdgcn_exp2f(v[0] - mx), __builtin_amdgcn_exp2f(v[1] - mx), __builtin_amdgcn_exp2f(v[2] - mx), __builtin_amdgcn_exp2f(v[3] - mx)};
                    acc[ai][bj][m][n] = v; sm += (v[0] + v[1]) + (v[2] + v[3]); }
            sm += __shfl_xor(sm, 16); sm += __shfl_xor(sm, 32);
            if (cx.fq == 0) PS[ru * 4 + cx.wc] = sm; EP_FENCE; }
        asm volatile("s_waitcnt lgkmcnt(0)" ::: "memory"); __builtin_amdgcn_s_barrier(); asm volatile("" ::: "memory");
        const unsigned l_p = (unsigned)(cx.fr * 1024 + cx.fq * 8) * 2u;
        EP_FOR_ROWS { const int ru = EP_RU, rowu = u.pm * 256 + ru; const f32x4 q = *(const LAS f32x4*)(PS + ru * 4); const float inv = __builtin_amdgcn_rcpf((q[0] + q[1]) + (q[2] + q[3]));
#pragma unroll
            for (int bj = 0; bj < 2; ++bj) *(u32x4*)lane_ptr(pb + (size_t)rowu * 1024 + u.pn * 256 + bj * 128 + cx.wc * 32, l_p) = pack8(acc[ai][bj][m][0] * inv, acc[ai][bj][m][1] * inv);
            EP_FENCE; }
    }
};
struct EpiSwiglu {
    static constexpr bool HAS_MID = false, HAS_BEGIN = false;
    const float* sq_f; bf16_t* hid;
    __device__ __forceinline__ void operator()(Acc& acc, const Unit& u, const Ctx& cx, int) const {
        const unsigned l_h = (unsigned)(cx.fr * FF + cx.fq * 8) * 2u;
        EP_FOR_ROWS { const int rowu = u.pm * 256 + EP_RU; const float rs = rstd_of(sq_f[rowu + cx.fr], 1.0f / 1024.0f); f32x4 o[2];
#pragma unroll
            for (int n = 0; n < 2; ++n) { const f32x4 g = acc[ai][0][m][n] * rs, up = acc[ai][1][m][n] * rs; o[n] = (f32x4){g[0] * sigm(g[0]) * up[0], g[1] * sigm(g[1]) * up[1], g[2] * sigm(g[2]) * up[2], g[3] * sigm(g[3]) * up[3]}; }
            *(u32x4*)lane_ptr(hid + (size_t)rowu * FF + u.pn * 128 + cx.wc * 32, l_h) = pack8(o[0], o[1]); EP_FENCE; }
    }
};
template <class OutFn> struct EpiStore {
    static constexpr bool HAS_MID = false, HAS_BEGIN = false;
    OutFn of;
    __device__ __forceinline__ void operator()(Acc& acc, const Unit& u, const Ctx& cx, int) const {
        int ld; bf16_t* base = of(u, ld); const unsigned l_o = (unsigned)(cx.fr * ld + cx.fq * 8) * 2u;
        EP_FOR_ROWS { const int ru = EP_RU;
#pragma unroll
            for (int bj = 0; bj < 2; ++bj) *(u32x4*)lane_ptr(base + (size_t)ru * ld + bj * 128 + cx.wc * 32, l_o) = pack8(acc[ai][bj][m][0], acc[ai][bj][m][1]);
            EP_FENCE; }
    }
};
}
namespace att {
constexpr int KSLOT = 12288, VSLOT = 8192, NSLOT = 3;
constexpr int L_K = 0, L_V = NSLOT * KSLOT, L_WS = L_V + NSLOT * VSLOT, L_OST = L_WS + 8 * 256, L_END = L_OST + 8 * 4096;
static_assert(L_END <= RING_BYTES, "attention LDS");
__device__ __forceinline__ int crow(int r, int hi) { return (r & 3) + 8 * (r >> 2) + 4 * hi; }
#define SBAR() __builtin_amdgcn_sched_barrier(0)
__device__ __forceinline__ void cmask(f32x16& p0, f32x16& p1, int jb, int qrel, int hi) {
    const float NEG = -INFINITY; const int kb = 64 * jb + 4 * hi;
#pragma unroll
    for (int r = 0; r < 16; ++r) { const int kv = kb + (r & 3) + 8 * (r >> 2); if (kv > qrel) p0[r] = NEG; if (kv + 32 > qrel) p1[r] = NEG; }
}
__device__ __forceinline__ void glds16(const void* gsrc, unsigned lds_dst) { unsigned keep;
    asm volatile("s_mov_b32 %0, m0\n\ts_mov_b32 m0, %2\n\ts_nop 0\n\tglobal_load_lds_dwordx4 %1, off\n\ts_mov_b32 m0, %0" : "=&s"(keep) : "v"(gsrc), "s"(lds_dst) : "memory"); }
__device__ __forceinline__ float max3f(float a, float b, float c) { float r; asm("v_max3_f32 %0, %1, %2, %3" : "=v"(r) : "v"(a), "v"(b), "v"(c)); return r; }
__device__ __forceinline__ float max2f(float a, float b) { float r; asm("v_max_f32_e32 %0, %1, %2" : "=v"(r) : "v"(a), "v"(b)); return r; }
__device__ __forceinline__ float fadd_s(float a, float b) { float r; asm("v_add_f32_e32 %0, %1, %2" : "=v"(r) : "v"(a), "v"(b)); return r; }
__device__ __forceinline__ float fsub_s(float a, float b) { float r; asm("v_sub_f32_e32 %0, %1, %2" : "=v"(r) : "v"(a), "v"(b)); return r; }
#define WAIT_BAR(N) asm volatile("s_waitcnt vmcnt(" #N ") lgkmcnt(0)\n\ts_barrier" ::: "memory")
typedef LAS const char* lds_cptr;
typedef short v4i16_t __attribute__((ext_vector_type(4)));
__device__ __forceinline__ void qkt(f32x16& p0, f32x16& p1, lds_cptr kb, const bf16x8* qr) { const f32x16 negm = f32x16{};
#pragma unroll
    for (int d0 = 0; d0 < 6; ++d0) { const bf16x8 b0 = *(const LAS bf16x8*)(kb + d0 * 2048), b1 = *(const LAS bf16x8*)(kb + d0 * 2048 + 512);
        if (d0 == 0) { p0 = __builtin_amdgcn_mfma_f32_32x32x16_bf16(b0, qr[0], negm, 0, 0, 0); p1 = __builtin_amdgcn_mfma_f32_32x32x16_bf16(b1, qr[0], negm, 0, 0, 0); }
        else { p0 = __builtin_amdgcn_mfma_f32_32x32x16_bf16(b0, qr[d0], p0, 0, 0, 0); p1 = __builtin_amdgcn_mfma_f32_32x32x16_bf16(b1, qr[d0], p1, 0, 0, 0); } }
}
__device__ __forceinline__ void kload2(bf16x8* kf, lds_cptr kp, int j) { kf[2 * j] = *(const LAS bf16x8*)(kp + j * 2048); kf[2 * j + 1] = *(const LAS bf16x8*)(kp + j * 2048 + 512); }
__device__ __forceinline__ s16x4 vtr(lds_cptr p) { return __builtin_bit_cast(s16x4, __builtin_amdgcn_ds_read_tr16_b64_v4i16((LAS v4i16_t*)p)); }
__device__ __forceinline__ float rowmax(const f32x16& p0, const f32x16& p1) {
    float a = max3f(p0[0], p0[1], p1[0]), b = max3f(p0[2], p0[3], p1[1]); a = max3f(a, p1[2], p1[3]);
#pragma unroll
    for (int r = 4; r < 16; r += 4) { a = max3f(a, p0[r], p0[r + 1]); b = max3f(b, p0[r + 2], p0[r + 3]); a = max3f(a, p1[r], p1[r + 1]); b = max3f(b, p1[r + 2], p1[r + 3]); }
    const float m = max2f(a, b);
    auto rr = __builtin_amdgcn_permlane32_swap(__float_as_uint(m), __float_as_uint(m), false, false);
    return max2f(__uint_as_float(rr[0]), __uint_as_float(rr[1]));
}
__device__ __forceinline__ void pv(f32x16* o, int vb, bf16x8 pa0, bf16x8 pa1, bf16x8 pa2, bf16x8 pa3) {
#pragma unroll
    for (int d0 = 0; d0 < 2; ++d0) { s16x4 lo[4], hi[4];
#pragma unroll
        for (int ks = 0; ks < 4; ++ks) {
            asm volatile("ds_read_b64_tr_b16 %0,%1 offset:%c2" : "=&v"(lo[ks]) : "v"(vb), "i"(d0 * 4096 + ks * 1024) : "memory");
            asm volatile("ds_read_b64_tr_b16 %0,%1 offset:%c2" : "=&v"(hi[ks]) : "v"(vb), "i"(d0 * 4096 + ks * 1024 + 512) : "memory"); }
        asm volatile("s_waitcnt lgkmcnt(0)" ::: "memory"); SBAR();
#define PK(k) (bf16x8){lo[k][0], lo[k][1], lo[k][2], lo[k][3], hi[k][0], hi[k][1], hi[k][2], hi[k][3]}
        o[d0] = __builtin_amdgcn_mfma_f32_32x32x16_bf16(pa0, PK(0), o[d0], 0, 0, 0);
        o[d0] = __builtin_amdgcn_mfma_f32_32x32x16_bf16(pa1, PK(1), o[d0], 0, 0, 0);
        o[d0] = __builtin_amdgcn_mfma_f32_32x32x16_bf16(pa2, PK(2), o[d0], 0, 0, 0);
        o[d0] = __builtin_amdgcn_mfma_f32_32x32x16_bf16(pa3, PK(3), o[d0], 0, 0, 0);
#undef PK
    }
}
template <int THRL>
__device__ __forceinline__ void attn_unit(int b, int h, int qb, const bf16_t* Q, const unsigned char* Kg, const unsigned char* Vg, bf16_t* AO, float* sq_a, LAS unsigned char* lds) {
    int tid_ = threadIdx.x; asm volatile("" : "+v"(tid_));
    const int tid = tid_, lane = tid & 63, r32 = lane & 31, hi = lane >> 5; const int wid = __builtin_amdgcn_readfirstlane(tid >> 6);
    const int q0 = qb * 256; const size_t rowbase = (size_t)b * S;
    const bf16_t* Qw = Q + (rowbase + q0 + wid * 32) * 768;
    const unsigned lds0 = (unsigned)(uintptr_t)lds;
    LAS float* wsf = (LAS float*)(lds + L_WS) + wid * 64;
    const unsigned char* ksrc = Kg + (size_t)(b * 8 + h) * 64 * KSLOT + wid * 1536 + lane * 16; const unsigned char* vsrc = Vg + (size_t)(b * 8 + h) * 64 * VSLOT + wid * 1024 + lane * 16;
    const unsigned kdst = lds0 + L_K + wid * 1536, vdst = lds0 + L_V + wid * 1024;
#define DMA_K(t, sl) do { glds16(ksrc + (size_t)(t) * KSLOT, (unsigned)__builtin_amdgcn_readfirstlane(kdst + (sl) * KSLOT)); \
        if (lane < 32) glds16(ksrc + (size_t)(t) * KSLOT + 1024, (unsigned)__builtin_amdgcn_readfirstlane(kdst + (sl) * KSLOT + 1024)); } while (0)
#define DMA_V(t, sl) glds16(vsrc + (size_t)(t) * VSLOT, (unsigned)__builtin_amdgcn_readfirstlane(vdst + (sl) * VSLOT))
    const int vb0 = (int)(lds0 + L_V) + ((lane >> 4) & 1) * 32 + (lane & 3) * 8 + (4 * hi + ((lane & 15) >> 2)) * 64;
    bf16x8 kf[12];
    const lds_cptr kp0 = (lds_cptr)lds + L_K + hi * 1024 + r32 * 16; const lds_cptr vp0 = (lds_cptr)lds + L_V + ((lane >> 4) & 1) * 32 + (lane & 3) * 8 + (4 * hi + ((lane & 15) >> 2)) * 64;
    const int NT = 4 * (qb + 1);
    DMA_K(0, 0); DMA_V(0, 0); DMA_K(1, 1);
    bf16x8 qr[6];
#pragma unroll
    for (int d0 = 0; d0 < 6; ++d0) qr[d0] = *reinterpret_cast<const bf16x8*>(&Qw[(size_t)r32 * 768 + (d0 < 4 ? h * 64 + d0 * 16 : 512 + h * 32 + (d0 - 4) * 16) + hi * 8]);
    float mhat = 0.f, l_reg = 0.f; f32x16 o[2]; o[0] = f32x16{}; o[1] = f32x16{};
    const int qrel = wid * 32 + r32;
#define CMASK(P0, P1, t) do { int jb_ = (t) - (NT - 4); if (jb_ >= 0) cmask(P0, P1, jb_, qrel, hi); } while (0)
    bool resc = false;
#define START(P0, P1) do { const float rm = rowmax(P0, P1); resc = false; \
    mhat = rm; \
    _Pragma("unroll") for (int r = 0; r < 16; ++r) P0[r] = __builtin_amdgcn_exp2f(P0[r] - mhat); } while (0)
#define RESC() do { if (resc) { asm volatile("s_waitcnt lgkmcnt(0)" ::: "memory"); \
      _Pragma("unroll") for (int d_ = 0; d_ < 2; ++d_) _Pragma("unroll") for (int r = 0; r < 16; ++r) o[d_][r] *= wsf[crow(r, hi)]; } } while (0)
    f32x16 pA0, pA1, pB0, pB1;
    int sp = 0, sc = 0, sn = 1;
#define ROT() do { sp = sc; sc = sn; sn = (sn == NSLOT - 1) ? 0 : sn + 1; } while (0)
    DMA_K(2, 2);
    WAIT_BAR(5);
    qkt(pA0, pA1, kp0, qr); asm volatile("s_nop 15\n\ts_nop 7" : "+v"(pA0), "+v"(pA1)); CMASK(pA0, pA1, 0);
    START(pA0, pA1);
#pragma unroll
    for (int r = 0; r < 16; ++r) pA1[r] = __builtin_amdgcn_exp2f(pA1[r] - mhat);
    WAIT_BAR(0);
    DMA_K(3, 0); DMA_V(1, 1);
    ROT();
#pragma unroll
    for (int j = 0; j < 6; ++j) kload2(kf, kp0 + sc * KSLOT, j);
    WAIT_BAR(3);
    s16x4 vlo[8], vhi[8]; u32x4 pw0, pw1, pw2, pw3;
#define PKW(P, B) cvt_pk_bf16(P[B], P[B + 1])
#define PAF(k) __builtin_bit_cast(bf16x8, pw##k)
#define VFR(i) (bf16x8){vlo[i][0], vlo[i][1], vlo[i][2], vlo[i][3], vhi[i][0], vhi[i][1], vhi[i][2], vhi[i][3]}
#define PIN(x) asm volatile("" : "+v"(x))
#define MX3(a, b, c) __builtin_fmaxf(__builtin_fmaxf((a), (b)), (c))
#define GAPA(MF, A0, A1, A2, A3, W0, W1, PW) do { MF; sacc += A0; sacc += A1; sacc += A2; sacc += A3; PIN(sacc); W0; W1; PIN(PW); SBAR(); } while (0)
#define GAPM(MF) do { MF; SBAR(); } while (0)
#define EX(v) __builtin_amdgcn_exp2f(v)
#define GAPB(MF, X, B) do { MF; X[B] = EX(X[B] - mhat); X[B + 1] = EX(X[B + 1] - mhat); X[B + 2] = EX(X[B + 2] - mhat); X[B + 3] = EX(X[B + 3] - mhat); PIN(X); SBAR(); } while (0)
#define VRD(i) do { vlo[i] = vtr(vp_ + (((i) >> 2) * 4096 + ((i) & 3) * 1024)); vhi[i] = vtr(vp_ + (((i) >> 2) * 4096 + ((i) & 3) * 1024 + 512)); } while (0)
#define KRD(G, j) do { if (G) { kload2(kf, kp0 + sn * KSLOT, j); SBAR(); } } while (0)
#define MF32(A, B, C) __builtin_amdgcn_mfma_f32_32x32x16_bf16(A, B, C, 0, 0, 0)
#define STEP(C0, C1, P0, P1, t, GK, GV, GL) do { SBAR(); const f32x16 zero16 = f32x16{}; \
    const lds_cptr vp_ = vp0 + sp * VSLOT; \
    VRD(0); SBAR(); float sacc = (P0[0] + P0[1]); \
    GAPA(C0 = MF32(kf[0], qr[0], zero16), P0[2], P0[3], P0[4], P0[5],     pw0[0] = PKW(P0, 0), pw0[1] = PKW(P0, 2), pw0); \
    VRD(4); SBAR(); GAPA(C1 = MF32(kf[1], qr[0], zero16), P0[6], P0[7], P0[8], P0[9],     pw0[2] = PKW(P0, 4), pw0[3] = PKW(P0, 6), pw0); \
    VRD(1); SBAR(); GAPA(C0 = MF32(kf[2], qr[1], C0),   P0[10], P0[11], P0[12], P0[13], pw1[0] = PKW(P0, 8), pw1[1] = PKW(P0, 10), pw1); \
    VRD(5); SBAR(); GAPA(C1 = MF32(kf[3], qr[1], C1),   P0[14], P0[15], P1[0], P1[1],   pw1[2] = PKW(P0, 12), pw1[3] = PKW(P0, 14), pw1); \
    VRD(2); SBAR(); GAPA(C0 = MF32(kf[4], qr[2], C0),   P1[2], P1[3], P1[4], P1[5],     pw2[0] = PKW(P1, 0), pw2[1] = PKW(P1, 2), pw2); \
    VRD(6); SBAR(); GAPA(C1 = MF32(kf[5], qr[2], C1),   P1[6], P1[7], P1[8], P1[9],     pw2[2] = PKW(P1, 4), pw2[3] = PKW(P1, 6), pw2); \
    VRD(3); SBAR(); GAPA(C0 = MF32(kf[6], qr[3], C0),   P1[10], P1[11], P1[12], P1[13], pw3[0] = PKW(P1, 8), pw3[1] = PKW(P1, 10), pw3); \
    VRD(7); SBAR(); GAPA(C1 = MF32(kf[7], qr[3], C1),   P1[14], P1[15], 0.f, 0.f,       pw3[2] = PKW(P1, 12), pw3[3] = PKW(P1, 14), pw3); \
    GAPM(C0 = MF32(kf[8], qr[4], C0)); GAPM(C1 = MF32(kf[9], qr[4], C1)); GAPM(C0 = MF32(kf[10], qr[5], C0)); GAPM(C1 = MF32(kf[11], qr[5], C1)); \
    l_reg += sacc; \
    if (GK) { DMA_K((t) + 3, sc); } if (GV) { DMA_V((t) + 1, sn); } \
    CMASK(C0, C1, t); \
    { float a = MX3(C0[0], C0[1], C1[0]), b = MX3(C0[2], C0[3], C1[1]); a = MX3(a, C1[2], C1[3]); \
      _Pragma("unroll") for (int r = 4; r < 16; r += 4) { a = MX3(a, C0[r], C0[r + 1]); b = MX3(b, C0[r + 2], C0[r + 3]); a = MX3(a, C1[r], C1[r + 1]); b = MX3(b, C1[r + 2], C1[r + 3]); } \
      float rm = __builtin_fmaxf(a, b); { auto rr = __builtin_amdgcn_permlane32_swap(__float_as_uint(rm), __float_as_uint(rm), false, false); rm = __builtin_fmaxf(__uint_as_float(rr[0]), __uint_as_float(rr[1])); } \
      resc = false; \
      rm -= mhat; \
      if (__builtin_expect(__any(rm > (float)THRL), 0)) { const float dl = __builtin_fmaxf(rm, 0.f); mhat += dl; \
        const float f = __builtin_amdgcn_exp2f(-dl); l_reg *= f; if (hi == 0) wsf[r32] = f; resc = true; } } \
    SBAR(); \
    GAPB(o[0] = MF32(PAF(0), VFR(0), o[0]), C0, 0); \
    KRD(GL, 0); GAPB(o[1] = MF32(PAF(0), VFR(4), o[1]), C0, 4); \
    KRD(GL, 1); GAPB(o[0] = MF32(PAF(1), VFR(1), o[0]), C0, 8); \
    KRD(GL, 2); GAPB(o[1] = MF32(PAF(1), VFR(5), o[1]), C0, 12); \
    KRD(GL, 3); GAPB(o[0] = MF32(PAF(2), VFR(2), o[0]), C1, 0); \
    KRD(GL, 4); GAPB(o[1] = MF32(PAF(2), VFR(6), o[1]), C1, 4); \
    KRD(GL, 5); GAPB(o[0] = MF32(PAF(3), VFR(3), o[0]), C1, 8); \
    GAPB(o[1] = MF32(PAF(3), VFR(7), o[1]), C1, 12); \
    } while (0)
    int t = 1;
#undef CMASK
#define CMASK(P0, P1, t) do {} while (0)
    for (; t + 5 < NT; t += 2) {
        STEP(pB0, pB1, pA0, pA1, t, true, true, true);     WAIT_BAR(3); RESC(); ROT();
        STEP(pA0, pA1, pB0, pB1, t + 1, true, true, true); WAIT_BAR(3); RESC(); ROT();
    }
#undef CMASK
#define CMASK(P0, P1, t) do { int jb_ = (t) - (NT - 4); if (jb_ >= 0) cmask(P0, P1, jb_, qrel, hi); } while (0)
#define ENDW(tt) do { if ((tt) + 3 < NT) { WAIT_BAR(3); } else if ((tt) + 2 < NT) { WAIT_BAR(1); } else { WAIT_BAR(0); } } while (0)
    for (; t + 1 < NT; t += 2) {
        STEP(pB0, pB1, pA0, pA1, t, (t + 3 < NT), (t + 1 < NT), (t + 1 < NT));     ENDW(t);     RESC(); ROT();
        STEP(pA0, pA1, pB0, pB1, t + 1, (t + 4 < NT), (t + 2 < NT), (t + 2 < NT)); ENDW(t + 1); RESC(); ROT();
    }
    STEP(pB0, pB1, pA0, pA1, NT - 1, false, false, false); RESC();
    { float sacc = pB0[0] + pB0[1];
#pragma unroll
      for (int r = 2; r < 16; ++r) sacc += pB0[r];
#pragma unroll
      for (int r = 0; r < 16; ++r) sacc += pB1[r];
      l_reg += sacc;
      pw0 = (u32x4){PKW(pB0, 0), PKW(pB0, 2), PKW(pB0, 4), PKW(pB0, 6)}; pw1 = (u32x4){PKW(pB0, 8), PKW(pB0, 10), PKW(pB0, 12), PKW(pB0, 14)};
      pw2 = (u32x4){PKW(pB1, 0), PKW(pB1, 2), PKW(pB1, 4), PKW(pB1, 6)}; pw3 = (u32x4){PKW(pB1, 8), PKW(pB1, 10), PKW(pB1, 12), PKW(pB1, 14)};
      SBAR(); pv(o, vb0 + sc * VSLOT, PAF(0), PAF(1), PAF(2), PAF(3)); }
#undef PKW
#undef PAF
#undef VFR
#undef PIN
#undef MX3
#undef GAPA
#undef GAPM
#undef GAPB
#undef EX
#undef VRD
#undef KRD
#undef MF32
#undef STEP
#undef ENDW
#undef DMA_K
#undef DMA_V
#undef CMASK
#undef START
#undef RESC
#undef ROT
    { auto rr = __builtin_amdgcn_permlane32_swap(__float_as_uint(l_reg), __float_as_uint(l_reg), false, false); l_reg = __uint_as_float(rr[0]) + __uint_as_float(rr[1]); }
    if (hi == 0) wsf[32 + r32] = l_reg;
    asm volatile("s_waitcnt lgkmcnt(0)" ::: "memory");
    LAS bf16_t* stg = (LAS bf16_t*)(lds + L_OST) + wid * 2048;
#pragma unroll
    for (int r = 0; r < 16; ++r) { const int orow = crow(r, hi); const float rl = __builtin_amdgcn_rcpf(wsf[32 + orow]);
#pragma unroll
        for (int d0 = 0; d0 < 2; ++d0) stg[orow * 64 + d0 * 32 + r32] = (bf16_t)(cvt_pk_bf16(o[d0][r] * rl, 0.f) & 0xffffu); }
    asm volatile("s_waitcnt lgkmcnt(0)" ::: "memory");
    bf16_t* Ow = AO + (rowbase + q0 + wid * 32) * 512 + h * 64;
#pragma unroll
    for (int i = 0; i < 4; ++i) { const int row = i * 8 + (lane >> 3), ch = lane & 7; const u32x4 v = *(const LAS u32x4*)(stg + row * 64 + ch * 8); *(u32x4*)(Ow + (size_t)row * 512 + ch * 8) = v;
        float ss = (bf_lo(v.x) * bf_lo(v.x) + bf_hi(v.x) * bf_hi(v.x)) + (bf_lo(v.y) * bf_lo(v.y) + bf_hi(v.y) * bf_hi(v.y)) + (bf_lo(v.z) * bf_lo(v.z) + bf_hi(v.z) * bf_hi(v.z)) + (bf_lo(v.w) * bf_lo(v.w) + bf_hi(v.w) * bf_hi(v.w));
        ss += __shfl_xor(ss, 1); ss += __shfl_xor(ss, 2); ss += __shfl_xor(ss, 4);
        if (ch == 0) unsafeAtomicAdd(sq_a + rowbase + q0 + wid * 32 + row, ss); }
    asm volatile("s_waitcnt lgkmcnt(0)\n\ts_barrier" ::: "memory");
}
#undef SBAR
#undef WAIT_BAR
__device__ __forceinline__ void attn_phase(int vcu, int G, const bf16_t* Q, const unsigned char* Kg, const unsigned char* Vg, bf16_t* AO, float* sq_a, LAS unsigned char* lds) {
    for (int v = vcu; v < 256; v += G) { const int bh = v >> 2, s = v & 3;
#pragma unroll 1
        for (int i = 0; i < 4; ++i) { const int qb = (i == 0) ? s : (i == 1) ? 7 - s : (i == 2) ? 8 + s : 15 - s; attn_unit<8>(bh >> 3, bh & 7, qb, Q, Kg, Vg, AO, sq_a, lds); } }
}
}

__device__ __forceinline__ void ssm_scan_phase(int vcu, int G, const float* xloc, const float* aL  , bf16_t* assm) {
    int tid_ = threadIdx.x; asm volatile("" : "+v"(tid_));
    if (tid_ >= 64) return;
    const int p = tid_;
    for (int v = vcu; v < 256; v += G) { const int b = v >> 5, g = v & 31; const float ar = aL[(g * 64 + p) * 2], ai = aL[(g * 64 + p) * 2 + 1];
        float xr = 0.f, xi = 0.f;
        const float* xl = xloc + ((size_t)g * NCH + b * NCHB) * 128; bf16_t* as = assm + ((size_t)g * NCH + b * NCHB) * KS3 + KS1;
#pragma unroll 8
        for (int c = 0; c < NCHB; ++c) { const float lr = xl[(size_t)c * 128 + p], li = xl[(size_t)c * 128 + 64 + p];
            as[(size_t)c * KS3 + p] = (bf16_t)(cvt_pk_bf16(xr, 0.f) & 0xffffu); as[(size_t)c * KS3 + 64 + p] = (bf16_t)(cvt_pk_bf16(xi, 0.f) & 0xffffu);
            const float nr = ar * xr - ai * xi + lr, ni = ar * xi + ai * xr + li; xr = nr; xi = ni; }
    }
}
__device__ __forceinline__ void sincos_d(double a, double& s, double& c) {
    const double k = rint(a * 0.63661977236758134308);
    double y = fma(-k, 1.57079632679489655800e+00, a); y = fma(-k, 6.12323399573676603587e-17, y);
    const double y2 = y * y;
    double sp = -1.0 / 1307674368000.0; sp = fma(sp, y2, 1.0 / 6227020800.0); sp = fma(sp, y2, -1.0 / 39916800.0); sp = fma(sp, y2, 1.0 / 362880.0);
    sp = fma(sp, y2, -1.0 / 5040.0); sp = fma(sp, y2, 1.0 / 120.0); sp = fma(sp, y2, -1.0 / 6.0); sp = fma(sp * y2, y, y);
    double cp = 1.0 / 20922789888000.0; cp = fma(cp, y2, -1.0 / 87178291200.0); cp = fma(cp, y2, 1.0 / 479001600.0); cp = fma(cp, y2, -1.0 / 3628800.0);
    cp = fma(cp, y2, 1.0 / 40320.0); cp = fma(cp, y2, -1.0 / 720.0); cp = fma(cp, y2, 1.0 / 24.0); cp = fma(cp, y2, -0.5); cp = fma(cp, y2, 1.0);
    const int q = (int)((long long)k & 3);
    if (q == 0) { s = sp; c = cp; } else if (q == 1) { s = cp; c = -sp; } else if (q == 2) { s = -sp; c = -cp; } else { s = -cp; c = sp; }
}
__device__ __forceinline__ float wave_sum(float v) {
#pragma unroll
    for (int o = 1; o < 64; o <<= 1) v += __shfl_xor(v, o);
    return v;
}
template <class ColFn, class GainFn>
__device__ __forceinline__ void conv_T(int gw, int NGW, int& base, int lane, LAS float* scr, int Ksrc, int ldw, int Ndst, bf16_t* dst, int ldd, ColFn colp, GainFn gain, float scale) {
    const int nblk = Ndst / 32, nitems = nblk * (Ksrc / 64);
    int first = gw - (base % NGW); if (first < 0) first += NGW;
    base += nitems;
    for (int it = first; it < nitems; it += NGW) { const int kb = it / nblk, nb = it % nblk, k0 = 64 * kb, n0 = 32 * nb;
        const float* cp = colp(n0 + (lane & 31)); float v[32];
        if (cp) { const float* q = cp + (size_t)(k0 + (lane >> 5)) * ldw;
#pragma unroll
            for (int i = 0; i < 32; ++i) v[i] = q[(size_t)(2 * i) * ldw]; }
        else {
#pragma unroll
            for (int i = 0; i < 32; ++i) v[i] = 0.f; }
#pragma unroll
        for (int i = 0; i < 32; ++i) scr[(2 * i + (lane >> 5)) * 33 + (lane & 31)] = v[i];
        asm volatile("s_waitcnt lgkmcnt(0)" ::: "memory");
        const int c = lane & 7; float gk[8];
#pragma unroll
        for (int e = 0; e < 8; ++e) gk[e] = gain(k0 + 8 * c + e) * scale;
#pragma unroll
        for (int j = 0; j < 4; ++j) { const int n = (lane >> 3) + 8 * j; const LAS float* sp = scr + (8 * c) * 33 + n;
            u32x4 o; o.x = cvt_pk_bf16(sp[0 * 33] * gk[0], sp[1 * 33] * gk[1]); o.y = cvt_pk_bf16(sp[2 * 33] * gk[2], sp[3 * 33] * gk[3]); o.z = cvt_pk_bf16(sp[4 * 33] * gk[4], sp[5 * 33] * gk[5]); o.w = cvt_pk_bf16(sp[6 * 33] * gk[6], sp[7 * 33] * gk[7]);
            *(u32x4*)(dst + (size_t)(n0 + n) * ldd + k0 + 8 * c) = o; }
        asm volatile("s_waitcnt lgkmcnt(0)" ::: "memory");
    }
}
struct In {
    const float *x, *mem; const int* pos; const float *norm_mix_g, *w_in, *q_norm_g, *w_uq, *kv_norm_g, *w_ukv, *lam_re, *lam_im, *log_dt, *b_re, *b_im, *c_re, *c_im, *ssm_d, *w_glu, *b_glu,
        *attn_out_g, *ssm_out_g, *w_out, *norm_x_g, *mem_norm_g, *w_xq, *w_xkv, *w_xo, *norm_ffn_g, *w_gate, *w_up, *w_down, *final_g;
};
struct Freqs { double f[16]; };

__device__ __forceinline__ void ssm_mats(const In& in, int l, int g, int q  , unsigned char* ws, LAS unsigned char* lds) {
    const int tid = threadIdx.x;
    LAS float* bbr = (LAS float*)lds; LAS float* bbi = bbr + 1024; LAS float* apr = bbi + 1024; LAS float* api = apr + 34 * 64; LAS float* cr = api + 34 * 64; LAS float* ci = cr + 1024;
    LAS float* ktabT = ci + 1024  ; LAS float* aprT = ktabT + 8192  ; LAS float* apiT = aprT + 64 * 35; LAS float* dvs = apiT + 64 * 35;
    const int lg = l * 32 + g;
    if (tid < 64) { const int p = tid; const double lr = in.lam_re[lg * 64 + p], li = in.lam_im[lg * 64 + p], dt = exp((double)in.log_dt[lg]);
        double sn, cn; sincos_d(fabs(li * dt), sn, cn); if (li * dt < 0) sn = -sn;
        const double er = exp(lr * dt), ar = er * cn, ai = er * sn, den = lr * lr + li * li;
        const double cfr = ((ar - 1.0) * lr + ai * li) / den, cfi = (ai * lr - (ar - 1.0) * li) / den;
        float bre[16], bim[16];
#pragma unroll
        for (int c = 0; c < 16; ++c) { bre[c] = in.b_re[(size_t)(lg * 64 + p) * 16 + c]; bim[c] = in.b_im[(size_t)(lg * 64 + p) * 16 + c]; }
#pragma unroll
        for (int c = 0; c < 16; ++c) { bbr[p * 16 + c] = (float)(cfr * bre[c] - cfi * bim[c]); bbi[p * 16 + c] = (float)(cfr * bim[c] + cfi * bre[c]); }
        double pr = 1.0, pi = 0.0;
        for (int j = 0; j < 34; ++j) { apr[j * 64 + p] = (float)pr; api[j * 64 + p] = (float)pi; aprT[p * 35 + j] = (float)pr; apiT[p * 35 + j] = (float)pi;
            if (j == LC && q == 0) { float* al = (float*)(ws + WS_AL) + (size_t)(lg * 64 + p) * 2; al[0] = (float)pr; al[1] = (float)pi; }
            const double nr = pr * ar - pi * ai, ni = pr * ai + pi * ar; pr = nr; pi = ni; }
    } else if (tid < 128) { const int p = tid - 64;
#pragma unroll
        for (int c = 0; c < 16; ++c) { cr[c * 64 + p] = in.c_re[(size_t)(lg * 16 + c) * 64 + p]; ci[c * 64 + p] = in.c_im[(size_t)(lg * 16 + c) * 64 + p]; }
    } else if (tid < 144) dvs[tid - 128] = in.ssm_d[l * 512 + g * 16 + (tid - 128)];
    __syncthreads();
    {
      const int j = tid >> 4, cb = ((tid >> 2) & 3) * 4, c2b = (tid & 3) * 4; float sum[4][4];
#pragma unroll
      for (int x = 0; x < 4; ++x)
#pragma unroll
          for (int y = 0; y < 4; ++y) sum[x][y] = 0.f;
      if (j < 8 * (q + 1)) for (int p = 0; p < 64; ++p) { const float yr = apr[j * 64 + p], yi = api[j * 64 + p]; float car[4], cai[4];
#pragma unroll
          for (int x = 0; x < 4; ++x) { const float xr = cr[(cb + x) * 64 + p], xi = ci[(cb + x) * 64 + p]; car[x] = xr * yr - xi * yi; cai[x] = xr * yi + xi * yr; }
          const f32x4 b4r = *(const LAS f32x4*)(bbr + p * 16 + c2b), b4i = *(const LAS f32x4*)(bbi + p * 16 + c2b);
#pragma unroll
          for (int x = 0; x < 4; ++x)
#pragma unroll
              for (int y = 0; y < 4; ++y) sum[x][y] += car[x] * b4r[y] - cai[x] * b4i[y]; }
#pragma unroll
      for (int x = 0; x < 4; ++x)
#pragma unroll
          for (int y = 0; y < 4; ++y) ktabT[((cb + x) * 16 + c2b + y) * 32 + j] = sum[x][y]; }
    __syncthreads();
    bf16_t* bt1 = (bf16_t*)(ws + WS_SSM + (size_t)lg * SSM_G_STRIDE); bf16_t* bt3 = (bf16_t*)(ws + WS_SSM + (size_t)lg * SSM_G_STRIDE + SSM_BT3_OFF);
    for (int idx = tid + q * (128 * 80); idx < (q + 1) * (128 * 80); idx += 512) { const int n = idx / 80, k0 = (idx % 80) * 8, s = n >> 4, c = n & 15; float v[8];
        if (k0 < KS1) { const int s2 = k0 >> 4, c0 = k0 & 15; const float dvc = (s2 == s) ? dvs[c] : 0.f; const LAS float* kt = ktabT + (c * 16 + c0) * 32 + (s2 <= s ? s - s2 : 0);
#pragma unroll
            for (int e = 0; e < 8; ++e) { float t = kt[e * 32]; if (s2 > s) t = 0.f; if (c0 + e == c) t += dvc; v[e] = t; }
        } else { const int pq = k0 - KS1, p0 = pq & 63; const bool im = (pq >> 6) != 0;
            const LAS float* xrp = cr + c * 64 + p0; const LAS float* xip = ci + c * 64 + p0; const LAS float* yrp = apr + (s + 1) * 64 + p0; const LAS float* yip = api + (s + 1) * 64 + p0;
#pragma unroll
            for (int hh = 0; hh < 2; ++hh) { const f32x4 xr = *(const LAS f32x4*)(xrp + 4 * hh), xi = *(const LAS f32x4*)(xip + 4 * hh), yr = *(const LAS f32x4*)(yrp + 4 * hh), yi = *(const LAS f32x4*)(yip + 4 * hh);
                const f32x4 re = xr * yr - xi * yi, mi = -(xr * yi + xi * yr);
#pragma unroll
                for (int e = 0; e < 4; ++e) v[4 * hh + e] = im ? mi[e] : re[e]; }
        }
        u32x4 o; o.x = cvt_pk_bf16(v[0], v[1]); o.y = cvt_pk_bf16(v[2], v[3]); o.z = cvt_pk_bf16(v[4], v[5]); o.w = cvt_pk_bf16(v[6], v[7]);
        *(u32x4*)(bt3 + (size_t)n * KS3 + k0) = o; }
    for (int idx = tid + q * (64 * 64); idx < (q + 1) * (64 * 64); idx += 512) { const int n = idx >> 6, k0 = (idx & 63) * 8, s2 = k0 >> 4, c0 = k0 & 15; float v[8];
        if (n < 128) { const int p = n & 63; const bool im = (n >> 6) != 0; const float yr = aprT[p * 35 + (LC - 1 - s2)], yi = apiT[p * 35 + (LC - 1 - s2)];
#pragma unroll
            for (int hh = 0; hh < 2; ++hh) { const f32x4 br = *(const LAS f32x4*)(bbr + p * 16 + c0 + 4 * hh), bi = *(const LAS f32x4*)(bbi + p * 16 + c0 + 4 * hh);
                const f32x4 re = br * yr - bi * yi, mi = bi * yr + br * yi;
#pragma unroll
                for (int e = 0; e < 4; ++e) v[4 * hh + e] = im ? mi[e] : re[e]; }
        } else {
#pragma unroll
            for (int e = 0; e < 8; ++e) v[e] = 0.f; }
        u32x4 o; o.x = cvt_pk_bf16(v[0], v[1]); o.y = cvt_pk_bf16(v[2], v[3]); o.z = cvt_pk_bf16(v[4], v[5]); o.w = cvt_pk_bf16(v[6], v[7]);
        *(u32x4*)(bt1 + (size_t)n * KS1 + k0) = o; }
    __syncthreads();
}

__device__ __forceinline__ void prologue(const In& in, const Freqs& fr, unsigned char* ws, LAS unsigned char* lds, int vcu, int G, int parts) {
    const int tid = threadIdx.x, lane = tid & 63, wave = __builtin_amdgcn_readfirstlane(tid >> 6);
    __syncthreads();
    if (parts & 1) for (int j = vcu; j < 256; j += G) ssm_mats(in, j >> 7, (j >> 2) & 31, j & 3, ws, lds);
    LAS float* scr = (LAS float*)(lds + wave * 16384);
    const int gw = vcu * 8 + wave, NGW = G * 8;
    if (parts & 2) {
    { bf16_t* hb = (bf16_t*)(ws + WS_HB); float* sq0 = (float*)(ws + WS_CTL) + CW_SQ + (size_t)SQ_MIX * T;
      for (int r = gw * 2; r < T; r += NGW * 2) { const f32x4* xr = (const f32x4*)(in.x + (size_t)r * D) + lane; u32x2* hrow = (u32x2*)(hb + (size_t)r * D) + lane; f32x4 v[8];
#pragma unroll
          for (int j = 0; j < 8; ++j) v[j] = xr[64 * j];
          float s0 = 0.f, s1 = 0.f;
#pragma unroll
          for (int j = 0; j < 4; ++j) { s0 += (v[j][0] * v[j][0] + v[j][1] * v[j][1]) + (v[j][2] * v[j][2] + v[j][3] * v[j][3]); s1 += (v[j + 4][0] * v[j + 4][0] + v[j + 4][1] * v[j + 4][1]) + (v[j + 4][2] * v[j + 4][2] + v[j + 4][3] * v[j + 4][3]); }
#pragma unroll
          for (int j = 0; j < 8; ++j) hrow[64 * j] = (u32x2){cvt_pk_bf16(v[j][0], v[j][1]), cvt_pk_bf16(v[j][2], v[j][3])};
          s0 = wave_sum(s0); s1 = wave_sum(s1); if (lane == 0) { sq0[r] = s0; sq0[r + 1] = s1; } } }
    { bf16_t* mn = (bf16_t*)(ws + WS_RA + RA_MEMN);
      for (int r = gw; r < NB * MEMT; r += NGW) { const f32x4* xr = (const f32x4*)(in.mem + (size_t)r * D) + lane; u32x2* mrow = (u32x2*)(mn + (size_t)r * D) + lane; f32x4 v[4]; float s = 0.f;
#pragma unroll
          for (int j = 0; j < 4; ++j) { v[j] = xr[64 * j]; s += (v[j][0] * v[j][0] + v[j][1] * v[j][1]) + (v[j][2] * v[j][2] + v[j][3] * v[j][3]); }
          const float rs = rstd_of(wave_sum(s), 1.0f / 1024.0f);
#pragma unroll
          for (int j = 0; j < 4; ++j) mrow[64 * j] = (u32x2){cvt_pk_bf16(v[j][0] * rs, v[j][1] * rs), cvt_pk_bf16(v[j][2] * rs, v[j][3] * rs)}; } }
    { float* cs = (float*)(ws + WS_CS);
      for (int i = vcu * 512 + tid; i < T * 16; i += G * 512) { const int t = i >> 4, j = i & 15; double s, c; sincos_d((double)in.pos[t] * fr.f[j], s, c); cs[(size_t)t * 32 + j] = (float)c; cs[(size_t)t * 32 + 16 + j] = (float)s; } }
    }
    if (!(parts & 4)) return;
    int cbase = 0;
    for (int l = 0; l < NL; ++l) {
        unsigned char* wl = ws + WS_W + (size_t)l * WL_STRIDE;
        { const float* W = in.w_in + (size_t)l * D * 928; const float* gn = in.norm_mix_g + l * D;
          conv_T(gw, NGW, cbase, lane, scr, D, 928, 1024, (bf16_t*)(wl + WL_IN), 1024,
                 [=](int n) -> const float* { if (n < 384) return W + n; if (n < 416) { const int i = n - 384; return W + ((i & 1) ? 400 + (i >> 1) : 384 + (i >> 1)); } if (n < 512) return nullptr; return W + 416 + (n - 512); },
                 [=](int k) { return gn[k]; }, 1.0f); }
        { const float* W = in.w_uq + (size_t)l * 256 * 768; const float* gn = in.q_norm_g + l * 256;
          conv_T(gw, NGW, cbase, lane, scr, 256, 768, 768, (bf16_t*)(wl + WL_UP), 256,
                 [=](int n) -> const float* { if (n < 512) return W + (n >> 6) * 96 + (n & 63); const int h = (n - 512) >> 5, i = (n - 512) & 31; return W + h * 96 + ((i & 1) ? 80 + (i >> 1) : 64 + (i >> 1)); },
                 [=](int k) { return gn[k]; }, 0.10206207261596575f * LOG2E); }
        { const float* W = in.w_ukv + (size_t)l * 128 * 1024; const float* gn = in.kv_norm_g + l * 128; bf16_t* dst = (bf16_t*)(wl + WL_UP) + (size_t)768 * 256;
          conv_T(gw, NGW, cbase, lane, scr, 128, 1024, 1024, dst, 256, [=](int n) -> const float* { return W + n; }, [=](int k) { return gn[k]; }, 1.0f);
          for (int i = vcu * 512 + tid; i < 1024 * 16; i += G * 512) *(u32x4*)(dst + (size_t)(i >> 4) * 256 + 128 + (i & 15) * 8) = (u32x4){0u, 0u, 0u, 0u}; }
        { const float* W = in.w_glu + (size_t)l * 512 * 512;
          conv_T(gw, NGW, cbase, lane, scr, 512, 512, 512, (bf16_t*)(wl + WL_GLU), 512, [=](int n) -> const float* { return W + n; }, [=](int) { return 1.0f; }, 1.0f); }
        { const float* W = in.w_out + (size_t)l * D * D; const float* ga = in.attn_out_g + l * 512; const float* gs = in.ssm_out_g + l * 512;
          conv_T(gw, NGW, cbase, lane, scr, D, D, D, (bf16_t*)(wl + WL_OUT), D, [=](int n) -> const float* { return W + n; }, [=](int k) { return k < 512 ? ga[k] : gs[k - 512]; }, 1.0f); }
        { const float* W = in.w_xkv + (size_t)l * D * 2048; const float* gn = in.mem_norm_g + l * D;
          conv_T(gw, NGW, cbase, lane, scr, D, 2048, 2048, (bf16_t*)(ws + WS_WXKV) + (size_t)l * 2048 * D, D, [=](int n) -> const float* { return W + n; }, [=](int k) { return gn[k]; }, 1.0f); }
        { const float* W = in.w_xo + (size_t)l * D * D;
          conv_T(gw, NGW, cbase, lane, scr, D, D, D, (bf16_t*)(ws + WS_WXO) + (size_t)l * D * D, D, [=](int n) -> const float* { return W + n; }, [=](int) { return 1.0f; }, 1.0f); }
        { const float* Wg = in.w_gate + (size_t)l * D * FF; const float* Wu = in.w_up + (size_t)l * D * FF; const float* gn = in.norm_ffn_g + l * D;
          conv_T(gw, NGW, cbase, lane, scr, D, FF, 2 * FF, (bf16_t*)(wl + WL_GU), D,
                 [=](int n) -> const float* { const int tl = n >> 8, r = n & 255; return r < 128 ? Wg + tl * 128 + r : Wu + tl * 128 + (r - 128); }, [=](int k) { return gn[k]; }, 1.0f); }
        { const float* W = in.w_down + (size_t)l * FF * D;
          conv_T(gw, NGW, cbase, lane, scr, FF, D, D, (bf16_t*)(wl + WL_DN), FF, [=](int n) -> const float* { return W + n; }, [=](int) { return 1.0f; }, 1.0f); }
        { const float* W = in.w_xq + (size_t)l * D * D; const float* gn = in.norm_x_g + l * D; bf16_t* dst = (bf16_t*)(wl + WL_XQ);
          for (int i = vcu * 512 + tid; i < D * D / 8; i += G * 512) { const int k = i >> 7; const float sc = gn[k] * (0.0625f * LOG2E); const f32x4 a = *(const f32x4*)(W + (size_t)i * 8) * sc, b = *(const f32x4*)(W + (size_t)i * 8 + 4) * sc;
              *(u32x4*)(dst + (size_t)i * 8) = ep::pack8(a, b); } }
    }
}
struct Args { In in; float* out; unsigned char* ws; Freqs fr; int ph_hi; int pad; };

template <class F> struct PanelFn { F f; __device__ __forceinline__ void operator()(const pg8::Unit& u, const char*& a, const char*& b) const { f(u, a, b); } };
template <class F> __device__ __forceinline__ PanelFn<F> make_panel(F f) { return PanelFn<F>{f}; }
template <class F> struct OutFnT { F f; __device__ __forceinline__ bf16_t* operator()(const pg8::Unit& u, int& ld) const { return f(u, ld); } };
template <class F> __device__ __forceinline__ ep::EpiStore<OutFnT<F>> make_store(F f) { return ep::EpiStore<OutFnT<F>>{OutFnT<F>{f}}; }

__global__ void __launch_bounds__(512, 2) mk_fwd(Args a) {
    extern __shared__ __attribute__((aligned(16))) unsigned char lds_raw[];
    LAS unsigned char* lds = (LAS unsigned char*)lds_raw;
    const int tid = threadIdx.x, lane = tid & 63, wave = __builtin_amdgcn_readfirstlane(tid >> 6);
    const int G = gridDim.x, bx = blockIdx.x, vcu = (G % 8 == 0) ? (bx % 8) * (G / 8) + bx / 8 : bx;
    unsigned char* ws = a.ws; float* out = a.out;
    unsigned* ctl = (unsigned*)(ws + WS_CTL);
    for (int u = tid; u < (LDS_BYTES - LDSCTL_OFF) / 4; u += 512) ((LAS unsigned*)(lds + LDSCTL_OFF))[u] = 0u;
    __syncthreads();
    XcdBarrier bar = xcd_barrier_post(ctl + CW_BAR, (volatile LAS unsigned*)(lds + LDSCTL_OFF));
    int ph = 0;
#ifndef MK_MASK
#define MK_MASK 0xffff
#endif
#define PHASE_BEGIN(id) if (ph++ >= a.ph_hi) return; if ((MK_MASK >> (id)) & 1)
#define GRID_BAR xcd_barrier(bar)
    float* sqb = (float*)ctl + CW_SQ;
#define SQ(l, id) (sqb + (size_t)((l) * SQ_PER_LAYER + (id)) * T)
    bf16_t* hb = (bf16_t*)(ws + WS_HB); bf16_t* assm = (bf16_t*)(ws + WS_ASSM); const float* cs = (const float*)(ws + WS_CS);
    unsigned char* ra = ws + WS_RA;
    pg8::StaticOrder SO;
    const long NEVER = 1 << 30;

#ifndef MK_REP_PRO
#define MK_REP_PRO 1
#define MK_REP_PARTS 7
#define MK_REP_ATTN 1
#define MK_REP_P9 1
#endif
    PHASE_BEGIN(0) { for (int rep = 0; rep < MK_REP_PRO; ++rep) prologue(a.in, a.fr, ws, lds, vcu, G, rep ? MK_REP_PARTS : 7); } GRID_BAR;
    PHASE_BEGIN(1) {
        const char* A0 = (const char*)(ra + RA_MEMN); const char* B0 = (const char*)(ws + WS_WXKV); bf16_t* kvm = (bf16_t*)(ra + RA_KVM);
        SO.init(8, 16, G, bx);
        auto PN = make_panel([=](const pg8::Unit& u, const char*& pa, const char*& pb) { pa = A0 + (size_t)u.pm * 256 * 1024 * 2; pb = B0 + (size_t)u.pn * 256 * 1024 * 2; });
        auto E = make_store([=](const pg8::Unit& u, int& ld) -> bf16_t* { ld = 2048; return kvm + ((size_t)(u.pn >> 3) * 2048 + u.pm * 256) * 2048 + (u.pn & 7) * 256; });
        pg8::gemm_phase(lds, pg8::GemmArgs{1024, 1024, 1024, (int)NEVER, 0}, SO, PN, E);
    } GRID_BAR;
    PHASE_BEGIN(2) {
        const char* kvm = (const char*)(ra + RA_KVM); bf16_t* wkvw = (bf16_t*)(ws + WS_WKVW);
        { SO.init(64, 4, G, bx);
          const char* wx = (const char*)(ws + WS_W + WL_XQ);
          auto PN = make_panel([=](const pg8::Unit& u, const char*& pa, const char*& pb) { const int l = u.pm >> 5, b = (u.pm >> 2) & 7, h = u.pm & 3;
              pa = kvm + (((size_t)l * 2048 + b * 256) * 2048 + h * 256) * 2; pb = wx + (size_t)l * WL_STRIDE + ((size_t)u.pn * 256 * 1024 + h * 256) * 2; });
          auto E = make_store([=](const pg8::Unit& u, int& ld) -> bf16_t* { const int l = u.pm >> 5, b = (u.pm >> 2) & 7, h = u.pm & 3; ld = 1024;
              return wkvw + ((size_t)(l * 16 + b) << 20) + (size_t)(h * 256) * 1024 + u.pn * 256; });
          pg8::gemm_phase(lds, pg8::GemmArgs{256, 2048, 1024, (int)NEVER, 0}, SO, PN, E); }
        { SO.init(256, 1, G, bx);
          const char* wo = (const char*)(ws + WS_WXO);
          auto PN = make_panel([=](const pg8::Unit& u, const char*& pa, const char*& pb) { const int rt = u.pm & 3, h = (u.pm >> 2) & 3, b = (u.pm >> 4) & 7, l = u.pm >> 7;
              pa = wo + (((size_t)l * 1024 + rt * 256) * 1024 + h * 256) * 2; pb = kvm + (((size_t)l * 2048 + b * 256) * 2048 + 1024 + h * 256) * 2; });
          auto E = make_store([=](const pg8::Unit& u, int& ld) -> bf16_t* { const int rt = u.pm & 3, h = (u.pm >> 2) & 3, b = (u.pm >> 4) & 7, l = u.pm >> 7; ld = 1024;
              return wkvw + ((size_t)(l * 16 + 8 + b) << 20) + (size_t)(rt * 256) * 1024 + h * 256; });
          pg8::gemm_phase(lds, pg8::GemmArgs{256, 1024, 2048, (int)NEVER, 0}, SO, PN, E); }
    } GRID_BAR;

    for (int l = 0; l < NL; ++l) {
        const char* wl = (const char*)(ws + WS_W + (size_t)l * WL_STRIDE);
        PHASE_BEGIN(3) {
            SO.init(128, 4, G, bx);
            auto PN = make_panel([=](const pg8::Unit& u, const char*& pa, const char*& pb) { pa = (const char*)hb + (size_t)u.pm * 256 * 1024 * 2; pb = wl + WL_IN + (size_t)u.pn * 256 * 1024 * 2; });
            ep::EpiProj E{SQ(l, SQ_MIX), SQ(l, SQ_CQ), SQ(l, SQ_CKV), (bf16_t*)(ra + RA_PROJB), assm, ra + RA_K, cs};
            pg8::gemm_phase(lds, pg8::GemmArgs{1024, 1024, 1024, (int)NEVER, 0}, SO, PN, E);
        } GRID_BAR;
        PHASE_BEGIN(4) {
            const char* pj = (const char*)(ra + RA_PROJB);
            { SO.init(128, 3, G, bx);
              auto PN = make_panel([=](const pg8::Unit& u, const char*& pa, const char*& pb) { pa = pj + (size_t)u.pm * 256 * 512 * 2; pb = wl + WL_UP + (size_t)u.pn * 256 * 256 * 2; });
              ep::EpiQ E{SQ(l, SQ_CQ), (bf16_t*)(ra + RA_Q), cs};
              pg8::gemm_phase(lds, pg8::GemmArgs{256, 512, 256, (int)NEVER, 0}, SO, PN, E); }
            { SO.init(128, 4, G, bx);
              auto PN = make_panel([=](const pg8::Unit& u, const char*& pa, const char*& pb) { pa = pj + (size_t)u.pm * 256 * 512 * 2 + 512; pb = wl + WL_UP + (size_t)(u.pn + 3) * 256 * 256 * 2; });
              ep::EpiKV E{SQ(l, SQ_CKV), ra + RA_K, ra + RA_V};
              pg8::gemm_phase(lds, pg8::GemmArgs{256, 512, 256, (int)NEVER, 0}, SO, PN, E); }
            { SO.init(128, 1, G, (bx + G / 2) % G);
              const char* bt = (const char*)(ws + WS_SSM) + (size_t)l * 32 * SSM_G_STRIDE;
              auto PN = make_panel([=](const pg8::Unit& u, const char*& pa, const char*& pb) { pa = (const char*)assm + (size_t)u.pm * 256 * KS3 * 2; pb = bt + (size_t)(u.pm >> 2) * SSM_G_STRIDE; });
              ep::EpiXloc E{(float*)(ra + RA_XLOC)};
              pg8::gemm_phase(lds, pg8::GemmArgs{KS1, KS3, KS1, (int)NEVER, 0}, SO, PN, E); }
        } GRID_BAR;
        PHASE_BEGIN(5) {
            ssm_scan_phase(vcu, G, (const float*)(ra + RA_XLOC), (const float*)(ws + WS_AL) + (size_t)l * 32 * 64 * 2, assm);
            for (int rep = 0; rep < MK_REP_ATTN; ++rep) att::attn_phase(vcu, G, (const bf16_t*)(ra + RA_Q), ra + RA_K, ra + RA_V, (bf16_t*)(ra + RA_AO), rep ? SQ(2, 1) : SQ(l, SQ_A), lds);
        } GRID_BAR;
        PHASE_BEGIN(6) {
            SO.init(128, 2, G, bx);
            const char* bt = (const char*)(ws + WS_SSM) + (size_t)l * 32 * SSM_G_STRIDE + SSM_BT3_OFF;
            auto PN = make_panel([=](const pg8::Unit& u, const char*& pa, const char*& pb) { pa = (const char*)assm + (size_t)u.pm * 256 * KS3 * 2; pb = bt + (size_t)(u.pm >> 2) * SSM_G_STRIDE + (size_t)u.pn * 256 * KS3 * 2; });
            ep::EpiY E{(bf16_t*)(ra + RA_Y), (bf16_t*)(ra + RA_G)};
            pg8::gemm_phase(lds, pg8::GemmArgs{KS3, KS3, KS3, (int)NEVER, 0}, SO, PN, E);
        } GRID_BAR;
        PHASE_BEGIN(7) {
            SO.init(128, 2, G, bx);
            const char* gb = (const char*)(ra + RA_G);
            auto PN = make_panel([=](const pg8::Unit& u, const char*& pa, const char*& pb) { pa = gb + (size_t)u.pm * 256 * 512 * 2; pb = wl + WL_GLU + (size_t)u.pn * 256 * 512 * 2; });
            ep::EpiGlu E{(const bf16_t*)(ra + RA_Y), a.in.b_glu + l * 512, (bf16_t*)(ra + RA_SOUT), SQ(l, SQ_S)};
            pg8::gemm_phase(lds, pg8::GemmArgs{512, 512, 512, (int)NEVER, 0}, SO, PN, E);
        } GRID_BAR;
        PHASE_BEGIN(8) {
            SO.init(128, 4, G, bx);
            const char* ao = (const char*)(ra + RA_AO);
            auto PN = make_panel([=](const pg8::Unit& u, const char*& pa, const char*& pb) { pa = ao + (size_t)u.pm * 256 * 512 * 2; pb = wl + WL_OUT + (size_t)u.pn * 256 * 1024 * 2; });
            ep::EpiRes<true> E{l == 0 ? a.in.x : nullptr, nullptr, hb, SQ(l, SQ_X), SQ(l, SQ_A), SQ(l, SQ_S)};
            pg8::gemm_phase(lds, pg8::GemmArgs{1024, 512, 1024, 8, (long)(RA_SOUT - RA_AO) - 8 * 128}, SO, PN, E);
        } GRID_BAR;
        PHASE_BEGIN(9) {
            SO.init(128, 4, G, bx);
            const char* wk = (const char*)(ws + WS_WKVW) + ((size_t)(l * 16) << 21);
            auto PN = make_panel([=](const pg8::Unit& u, const char*& pa, const char*& pb) { pa = (const char*)hb + (size_t)u.pm * 256 * 1024 * 2; pb = wk + ((size_t)(u.pm >> 4) << 21) + (size_t)u.pn * 256 * 1024 * 2; });
            ep::EpiSoftmax E{SQ(l, SQ_X), (bf16_t*)(ra + RA_P)};
            pg8::gemm_phase(lds, pg8::GemmArgs{1024, 1024, 1024, (int)NEVER, 0}, SO, PN, E);
        } GRID_BAR;
        PHASE_BEGIN(10) {
            SO.init(128, 4, G, bx);
            const char* vw = (const char*)(ws + WS_WKVW) + ((size_t)(l * 16 + 8) << 21); const char* pp = (const char*)(ra + RA_P);
            auto PN = make_panel([=](const pg8::Unit& u, const char*& pa, const char*& pb) { pa = pp + (size_t)u.pm * 256 * 1024 * 2; pb = vw + ((size_t)(u.pm >> 4) << 21) + (size_t)u.pn * 256 * 1024 * 2; });
            ep::EpiRes<false> E{nullptr, nullptr, hb, SQ(l, SQ_FFN), nullptr, nullptr};
            pg8::gemm_phase(lds, pg8::GemmArgs{1024, 1024, 1024, (int)NEVER, 0}, SO, PN, E);
        } GRID_BAR;
        PHASE_BEGIN(11) {
            SO.init(128, 22, G, bx);
            auto PN = make_panel([=](const pg8::Unit& u, const char*& pa, const char*& pb) { pa = (const char*)hb + (size_t)u.pm * 256 * 1024 * 2; pb = wl + WL_GU + (size_t)u.pn * 256 * 1024 * 2; });
            ep::EpiSwiglu E{SQ(l, SQ_FFN), (bf16_t*)(ra + RA_HID)};
            for (int rep = 0; rep < MK_REP_P9; ++rep) pg8::gemm_phase(lds, pg8::GemmArgs{1024, 1024, 1024, (int)NEVER, 0}, SO, PN, E);
        } GRID_BAR;
        PHASE_BEGIN(12) {
            SO.init(128, 4, G, bx);
            const char* hd = (const char*)(ra + RA_HID);
            auto PN = make_panel([=](const pg8::Unit& u, const char*& pa, const char*& pb) { pa = hd + (size_t)u.pm * 256 * FF * 2; pb = wl + WL_DN + (size_t)u.pn * 256 * FF * 2; });
            ep::EpiRes<false> E{nullptr, l == NL - 1 ? out : nullptr, hb, SQ(l + 1, SQ_MIX), nullptr, nullptr};
            pg8::gemm_phase(lds, pg8::GemmArgs{FF, FF, FF, (int)NEVER, 0}, SO, PN, E);
        } GRID_BAR;
    }
    PHASE_BEGIN(13) {
        const float* sqf = SQ(NL, SQ_MIX); const float* gf = a.in.final_g;
        for (int r = vcu * 8 + wave; r < T; r += G * 8) { const float rs = rstd_of(sqf[r], 1.0f / 1024.0f); f32x4* orow = (f32x4*)(out + (size_t)r * D) + lane; const f32x4* gr = (const f32x4*)gf + lane;
#pragma unroll
            for (int j = 0; j < 4; ++j) orow[64 * j] = orow[64 * j] * rs * gr[64 * j]; }
    }
#undef PHASE_BEGIN
#undef GRID_BAR
#undef SQ
}

extern "C" void kernel_launch(void* const* d_in, const int* in_sizes, int n_in, void* d_out, int out_size, void* d_ws, size_t ws_size, hipStream_t stream) {
    static int grid = 0;
    if (grid == 0) {
        if (n_in != 32 || out_size != T * D || ws_size < WS_END) { fprintf(stderr, "kernel_launch: unexpected shapes (n_in %d out %d ws %zu)\n", n_in, out_size, ws_size); grid = -1; return; }
        int dev = 0, cus = 0, per_cu = 0;
        if (hipGetDevice(&dev) != hipSuccess || hipDeviceGetAttribute(&cus, hipDeviceAttributeMultiprocessorCount, dev) != hipSuccess) { grid = -1; return; }
        if (hipFuncSetAttribute((const void*)mk_fwd, hipFuncAttributeMaxDynamicSharedMemorySize, LDS_BYTES) != hipSuccess) { fprintf(stderr, "kernel_launch: hipFuncSetAttribute failed\n"); grid = -1; return; }
        if (hipOccupancyMaxActiveBlocksPerMultiprocessor(&per_cu, (const void*)mk_fwd, 512, LDS_BYTES) != hipSuccess || per_cu < 1) { fprintf(stderr, "kernel_launch: occupancy query says %d\n", per_cu); per_cu = 1; }
        (void)hipGetLastError();
        grid = cus;
    }
    if (grid < 0) return;
    if (hipMemsetAsync((char*)d_ws + WS_CTL, 0, CTL_ZERO_BYTES, stream) != hipSuccess) return;
    Args a{};
    const void** ip = (const void**)&a.in;
    for (int i = 0; i < 32; ++i) ip[i] = d_in[i];
    a.out = (float*)d_out; a.ws = (unsigned char*)d_ws;
    for (int i = 0; i < 16; ++i) a.fr.f[i] = std::pow(10000.0, -(double)i / 16.0);
#ifndef MK_PH_HI
#define MK_PH_HI 1000
#endif
    a.ph_hi = MK_PH_HI; a.pad = 0;
    void* args[] = {&a};
    hipError_t e = hipLaunchCooperativeKernel((const void*)mk_fwd, dim3(grid), dim3(512), args, LDS_BYTES, stream);
    if (e != hipSuccess) fprintf(stderr, "kernel_launch: cooperative launch failed: %s (grid %d)\n", hipGetErrorString(e), grid);
}
```

```cpp
#include <hip/hip_runtime.h>
#include <hip/hip_bf16.h>
#include <cstdint>
#include <cstdio>
#include <cmath>

#define LAS __attribute__((address_space(3)))
typedef unsigned short bf16_t;
typedef short bf16x8 __attribute__((ext_vector_type(8)));
typedef short s16x4 __attribute__((ext_vector_type(4)));
typedef float f32x4 __attribute__((ext_vector_type(4)));
typedef float f32x2 __attribute__((ext_vector_type(2)));
typedef float f32x16 __attribute__((ext_vector_type(16)));
typedef unsigned u32x4 __attribute__((ext_vector_type(4)));
typedef unsigned u32x2 __attribute__((ext_vector_type(2)));

constexpr int D = 1024, NB = 8, S = 4096, T = NB * S, NL = 2, FF = 2816;
constexpr int NH = 8, QKD = 96, HD = 64;
constexpr int LC = 32, KS1 = 16 * LC  , KS3 = KS1 + 128  , NCHB = S / LC  , NCH = T / LC  ;
constexpr int MEMT = 256;
constexpr float EPS = 1e-6f;
constexpr float LOG2E = 1.4426950408889634f;

constexpr size_t MiB = 1u << 20;
constexpr size_t WS_CTL = 0, CTL_ZERO_BYTES = 4 * MiB;
constexpr size_t WS_CS = 4 * MiB;
constexpr size_t WS_W = 8 * MiB;
constexpr size_t WL_IN = 0, WL_UP = 2 * MiB, WL_GLU = 3 * MiB, WL_OUT = 3 * MiB + 512 * 1024, WL_XQ = 5 * MiB + 512 * 1024, WL_GU = 7 * MiB + 512 * 1024, WL_DN = 18 * MiB + 512 * 1024, WL_STRIDE = 24 * MiB + 512 * 1024;
constexpr size_t WS_WXKV = WS_W + 2 * WL_STRIDE;
constexpr size_t WS_WXO = WS_WXKV + 8 * MiB;
constexpr size_t WS_SSM = 70 * MiB;
constexpr size_t SSM_G_STRIDE = 896 * 1024, SSM_BT3_OFF = 256 * 1024;
constexpr size_t WS_AL = 126 * MiB;
constexpr size_t WS_WKVW = 128 * MiB;
constexpr size_t WS_HB = 192 * MiB;
constexpr size_t WS_ASSM = 256 * MiB;
constexpr size_t WS_RA = 296 * MiB;
constexpr size_t WS_END = WS_RA + 176 * MiB;
constexpr size_t RA_PROJB = 0, RA_AO = 0, RA_Q = 32 * MiB, RA_K = 80 * MiB, RA_V = 128 * MiB, RA_XLOC = 160 * MiB;
constexpr size_t RA_Y = 32 * MiB, RA_G = 64 * MiB, RA_SOUT = 96 * MiB;
constexpr size_t RA_P = 0, RA_HID = 0, RA_MEMN = 0, RA_KVM = 4 * MiB;
constexpr int CW_BAR = 4096;
constexpr int CW_SQ = 65536;
enum SqId { SQ_MIX = 0, SQ_CQ = 1, SQ_CKV = 2, SQ_A = 3, SQ_S = 4, SQ_X = 5, SQ_FFN = 6, SQ_PER_LAYER = 7 };
static_assert((size_t)(CW_SQ + 16 * T) * 4 <= CTL_ZERO_BYTES, "ctl");

constexpr int RING_BYTES = 131072, XCH_OFF = RING_BYTES  , LDSCTL_OFF = XCH_OFF + 12288, LDS_BYTES = 147456;

__device__ __forceinline__ unsigned cvt_pk_bf16(float lo, float hi) { typedef __bf16 bf2 __attribute__((ext_vector_type(2))); f32x2 v = {lo, hi}; bf2 b = __builtin_convertvector(v, bf2); return __builtin_bit_cast(unsigned, b); }
__device__ __forceinline__ float bf_lo(unsigned w) { return __uint_as_float(w << 16); }
__device__ __forceinline__ float bf_hi(unsigned w) { return __uint_as_float(w & 0xffff0000u); }
__device__ __forceinline__ float rstd_of(float sq, float inv_n) { return rsqrtf(sq * inv_n + EPS); }

#define XB_TMO      128
#define XB_XCNT(j)  (256  + 64 * (j))
#define XB_XSUB(j)  (1280 + 64 * (j))
#define XB_XGEN(j)  (2304 + 64 * (j))
#define XB_TOP      3328
#define XB_TOPGEN   3392
#define XCD_BAR_WORDS 3456
#define XB_SPIN_CAP (1u << 20)
__device__ __forceinline__ unsigned xb_ld(unsigned* p)              { return __hip_atomic_load(p, __ATOMIC_RELAXED, __HIP_MEMORY_SCOPE_AGENT); }
__device__ __forceinline__ unsigned xb_add(unsigned* p, unsigned v) { return __hip_atomic_fetch_add(p, v, __ATOMIC_RELAXED, __HIP_MEMORY_SCOPE_AGENT); }
__device__ __forceinline__ unsigned xb_xcc_id() { return (unsigned)__builtin_amdgcn_s_getreg((3 << 11) | 20) & 0xFu; }
#define XB_SPIN(cond, bar) do { unsigned _sp = 0; while (cond) { __builtin_amdgcn_s_sleep(1); \
    if ((++_sp & 255u) == 0u) { if (xb_ld(&(bar)[XB_TMO])) break; if (_sp > XB_SPIN_CAP) { atomicAdd(&(bar)[XB_TMO], 1u); break; } } } } while (0)
struct XcdBarrier { unsigned* bar; unsigned x; volatile LAS unsigned* st; };
__device__ __forceinline__ XcdBarrier xcd_barrier_post(unsigned* bar, volatile LAS unsigned* st) {
    XcdBarrier b; b.bar = bar; b.x = xb_xcc_id(); b.st = st;
    if (threadIdx.x == 0) (void)xb_add(&bar[XB_XCNT(b.x)], 1u);
    return b;
}
__device__ __forceinline__ void xcd_barrier_complete(unsigned* bar, unsigned x, unsigned& nloc, unsigned& nx) {
    const unsigned G = gridDim.x * gridDim.y * gridDim.z;
    unsigned sum, cnt, mine, sp = 0u;
    for (;;) {
        sum = 0u; cnt = 0u; mine = 0u;
#pragma unroll
        for (unsigned j = 0; j < 16; ++j) { const unsigned c = xb_ld(&bar[XB_XCNT(j)]); sum += c; cnt += (c > 0u) ? 1u : 0u; mine = (j == x) ? c : mine; }
        if (sum == G) break;
        __builtin_amdgcn_s_sleep(1);
        if ((++sp & 255u) == 0u) { if (xb_ld(&bar[XB_TMO])) break; if (sp > XB_SPIN_CAP) { atomicAdd(&bar[XB_TMO], 1u); break; } }
    }
    nloc = mine > 0u ? mine : 1u; nx = cnt > 0u ? cnt : 1u;
}
__device__ __forceinline__ void xcd_barrier(const XcdBarrier& b) {
    asm volatile("s_waitcnt vmcnt(0)" ::: "memory");
    __syncthreads();
    if (threadIdx.x == 0) {
        unsigned* bar = b.bar; asm volatile("" : "+s"(bar));
        __builtin_amdgcn_s_waitcnt(0);
        unsigned nloc = b.st[0], nx = b.st[1];
        if (nloc == 0u) { xcd_barrier_complete(bar, b.x, nloc, nx); b.st[0] = nloc; b.st[1] = nx; }
        const unsigned old = xb_add(&bar[XB_XSUB(b.x)], 1u);
        const unsigned gen = old / nloc;
        if (old + 1u == (gen + 1u) * nloc) {
            __builtin_amdgcn_fence(__ATOMIC_RELEASE, "agent");
            asm volatile("s_waitcnt vmcnt(0)" ::: "memory");
            const unsigned og = xb_add(&bar[XB_TOP], 1u);
            const unsigned tg = og / nx;
            if (og + 1u == (tg + 1u) * nx) xb_add(&bar[XB_TOPGEN], 1u);
            else XB_SPIN(xb_ld(&bar[XB_TOPGEN]) == tg, bar);
            __builtin_amdgcn_fence(__ATOMIC_ACQUIRE, "agent");
            xb_add(&bar[XB_XGEN(b.x)], 1u);
            asm volatile("s_waitcnt vmcnt(0)" ::: "memory");
        } else {
            XB_SPIN(xb_ld(&bar[XB_XGEN(b.x)]) == gen, bar);
            __builtin_amdgcn_fence(__ATOMIC_ACQUIRE, "agent");
            asm volatile("s_waitcnt vmcnt(0)" ::: "memory");
        }
    }
    __syncthreads();
}

namespace pg8 {
constexpr int BM = 256, BK = 64, HALF = 128, HTB = HALF * BK * 2, STAGE_BYTES = 8 * HTB, NXCD = 8, WGM = 8;
__host__ __device__ __forceinline__ int lds_byte(int r, int c) { const int st = (r >> 4) * 2 + (c >> 5), rr = r & 15, cc = c & 31, ob = rr * 64 + cc * 2; return st * 1024 + (ob ^ (((ob >> 9) & 1) << 5)); }
__host__ __device__ __forceinline__ void stage_rc(int b, int& R, int& C) { const int st = b / 1024, sb = b % 1024, swz = sb ^ (((sb >> 9) & 1) << 5); R = (st >> 1) * 16 + swz / 64; C = (st & 1) * 32 + (swz % 64) / 2; }
__host__ __device__ __forceinline__ int perm32(int rho) { const int n = rho >> 4, i = rho & 15; return 8 * (i >> 2) + 4 * n + (i & 3); }
struct Unit { int pm, pn; };
struct StaticOrder {
    int nM, nN, nwg, G, c;
    __device__ void init(int nM_, int nN_, int G_, int c_) { nM = nM_; nN = nN_; nwg = nM * nN; G = G_; c = c_; }
    __device__ bool next(int i, Unit& u) const {
        const long L = (long)i * G + c; if (L >= nwg) return false;
        int wgid = (int)L; { const int q = nwg / NXCD, r = nwg % NXCD, xcd = wgid % NXCD, off = wgid / NXCD; wgid = (xcd < r ? xcd * (q + 1) : r * (q + 1) + (xcd - r) * q) + off; }
        const int nig = WGM * nN, gid = wgid / nig, fm = gid * WGM, gsz = (nM - fm) < WGM ? (nM - fm) : WGM;
        u.pm = fm + ((wgid % nig) % gsz); u.pn = (wgid % nig) / gsz; return true;
    }
};
struct Ctx { int wr, wc, fr, fq, wid, lane, tid; LAS unsigned char* lds; };
typedef f32x4 Acc[2][2][4][2];

struct GemmArgs { int K, lda, ldb, tsplit; long a_delta; };

template <class Epi, class Panel>
__device__ __forceinline__ void gemm_phase(LAS unsigned char* lds, const GemmArgs g, const StaticOrder& S, const Panel& PN, const Epi& E) {
    int tid_ = threadIdx.x; asm volatile("" : "+v"(tid_));
    const int tid = tid_, wid = __builtin_amdgcn_readfirstlane(tid >> 6), lane = tid & 63, wr = wid >> 2, wc = wid & 3, fr = lane & 15, fq = lane >> 4;
    const int nt = g.K / BK;
    Ctx cx{wr, wc, fr, fq, wid, lane, tid, lds};
    unsigned voffA[2], voffB[2];
#pragma unroll
    for (int i = 0; i < 2; ++i) { int R, C; stage_rc(tid * 16 + i * 8192, R, C); const int Rb = (R & ~31) + perm32(R & 31);
        voffA[i] = (unsigned)(R * g.lda + C) * 2u; voffB[i] = (unsigned)(Rb * g.ldb + C) * 2u; }
    const size_t kstep = (size_t)(BK * 2);
    const size_t hstepA = (size_t)HALF * g.lda * 2, hstepB = (size_t)HALF * g.ldb * 2;
    const unsigned ldsw = (unsigned)wid * 1024u;
    const int aoff = lds_byte(wr * 64 + fr, fq * 8), boff = lds_byte(wc * 32 + fr, fq * 8);
#define PG8_SA(b, h) (((b) * 2 + (h)) * HTB)
#define PG8_SB(b, h) ((4 + (b) * 2 + (h)) * HTB)
#define PG8_STAGE(bufoff, gbase, voff) do { _Pragma("unroll") for (int _i = 0; _i < 2; ++_i) \
        __builtin_amdgcn_global_load_lds((const unsigned*)((const char*)(gbase) + (voff)[_i]), (LAS unsigned*)(lds + (bufoff) + ldsw + _i * 8192), 16, 0, 0); } while (0)
#define PG8_LDA(dst, b, h) do { _Pragma("unroll") for (int m = 0; m < 4; ++m) _Pragma("unroll") for (int k = 0; k < 2; ++k) dst[m][k] = *(const LAS bf16x8*)(lds + PG8_SA(b, h) + aoff + m * 2048 + k * 1024); } while (0)
#define PG8_LDB(dst, b, h) do { _Pragma("unroll") for (int n = 0; n < 2; ++n) _Pragma("unroll") for (int k = 0; k < 2; ++k) dst[n][k] = *(const LAS bf16x8*)(lds + PG8_SB(b, h) + boff + n * 2048 + k * 1024); } while (0)
#define PG8_MMA(ai, bj, At, Bt) do { __builtin_amdgcn_s_setprio(1); _Pragma("unroll") for (int m = 0; m < 4; ++m) _Pragma("unroll") for (int n = 0; n < 2; ++n) _Pragma("unroll") for (int k = 0; k < 2; ++k) \
        acc[ai][bj][m][n] = __builtin_amdgcn_mfma_f32_16x16x32_bf16(Bt[n][k], At[m][k], acc[ai][bj][m][n], 0, 0, 0); __builtin_amdgcn_s_setprio(0); } while (0)
#define PG8_WAIT_V(n) asm volatile("s_waitcnt vmcnt(" #n ")" ::: "memory")
#define PG8_WAIT_L(n) asm volatile("s_waitcnt lgkmcnt(" #n ")" ::: "memory")
#define PG8_BAR __builtin_amdgcn_s_barrier()
#define PG8_SCHED __builtin_amdgcn_sched_barrier(0)
#define PG8_AP(base, tt) ((base) + (size_t)(tt) * kstep + (((tt) >= g.tsplit) ? g.a_delta : 0l))
    Unit cur, nxt; int ui = 0;
    if (!S.next(0, cur)) return;
    Acc acc;
#pragma unroll
    for (int a = 0; a < 2; ++a)
#pragma unroll
        for (int b = 0; b < 2; ++b)
#pragma unroll
            for (int m = 0; m < 4; ++m)
#pragma unroll
                for (int n = 0; n < 2; ++n) acc[a][b][m][n] = (f32x4){0.f, 0.f, 0.f, 0.f};
    bf16x8 At[4][2], B0[2][2], B1[2][2];
    const char* cA; const char* cB; PN(cur, cA, cB);
    if constexpr (Epi::HAS_BEGIN) E.begin(cur, cx, ui);
    PG8_STAGE(PG8_SB(0, 0), cB, voffB); PG8_STAGE(PG8_SB(0, 1), cB + hstepB, voffB); PG8_STAGE(PG8_SA(0, 0), cA, voffA); PG8_STAGE(PG8_SA(0, 1), cA + hstepA, voffA);
    if (wr == 1) PG8_BAR;
    PG8_WAIT_V(2); PG8_BAR;
    PG8_STAGE(PG8_SB(1, 0), cB + kstep, voffB); PG8_STAGE(PG8_SA(1, 0), cA + kstep, voffA); PG8_STAGE(PG8_SB(1, 1), cB + hstepB + kstep, voffB);
    PG8_WAIT_V(6); PG8_BAR;
    for (;;) {
        const bool has_next = S.next(ui + 1, nxt);
        const char* nA = cA; const char* nB = cB; if (has_next) PN(nxt, nA, nB);
#pragma unroll 1
        for (int t = 0; t < nt; t += 2) {
            const bool last = (t == nt - 2);
            if constexpr (Epi::HAS_MID) { if (t == g.tsplit) E.mid(acc, cur, cx, ui); }
            const char* a1 = PG8_AP(cA, t + 1);
            const char* a2 = last ? nA : PG8_AP(cA, t + 2); const char* b2 = last ? nB : cB + (size_t)(t + 2) * kstep;
            const char* a3 = last ? nA + kstep : PG8_AP(cA, t + 3); const char* b3 = b2 + kstep;
            PG8_LDB(B0, 0, 0); PG8_LDB(B1, 0, 1); PG8_SCHED; PG8_LDA(At, 0, 0); PG8_STAGE(PG8_SA(1, 1), a1 + hstepA, voffA);
            PG8_WAIT_V(8); PG8_WAIT_L(0); PG8_BAR; PG8_MMA(0, 0, At, B0); PG8_MMA(0, 1, At, B1); PG8_BAR; PG8_SCHED;
            PG8_LDA(At, 0, 1); PG8_STAGE(PG8_SB(0, 0), b2, voffB); PG8_STAGE(PG8_SB(0, 1), b2 + hstepB, voffB); PG8_STAGE(PG8_SA(0, 0), a2, voffA);
            PG8_WAIT_V(8); PG8_WAIT_L(0); PG8_BAR; PG8_MMA(1, 0, At, B0); PG8_MMA(1, 1, At, B1); PG8_BAR; PG8_SCHED;
            PG8_LDB(B0, 1, 0); PG8_LDB(B1, 1, 1); PG8_SCHED; PG8_LDA(At, 1, 0); PG8_STAGE(PG8_SA(0, 1), a2 + hstepA, voffA);
            PG8_WAIT_V(8); PG8_WAIT_L(0); PG8_BAR; PG8_MMA(0, 0, At, B0); PG8_MMA(0, 1, At, B1); PG8_BAR; PG8_SCHED;
            PG8_LDA(At, 1, 1); PG8_STAGE(PG8_SB(1, 0), b3, voffB); PG8_STAGE(PG8_SB(1, 1), b3 + hstepB, voffB); PG8_STAGE(PG8_SA(1, 0), a3, voffA);
            PG8_WAIT_V(8); PG8_WAIT_L(0); PG8_BAR; PG8_MMA(1, 0, At, B0); PG8_MMA(1, 1, At, B1); PG8_BAR; PG8_SCHED;
        }
        if (wr == 0) PG8_BAR;
        E(acc, cur, cx, ui);
        if (!has_next) break;
#pragma unroll
        for (int a = 0; a < 2; ++a)
#pragma unroll
            for (int b = 0; b < 2; ++b)
#pragma unroll
                for (int m = 0; m < 4; ++m)
#pragma unroll
                    for (int n = 0; n < 2; ++n) acc[a][b][m][n] = (f32x4){0.f, 0.f, 0.f, 0.f};
        cur = nxt; cA = nA; cB = nB; ++ui;
        if constexpr (Epi::HAS_BEGIN) E.begin(cur, cx, ui);
        if (wr == 1) PG8_BAR;
    }
    PG8_WAIT_V(0);
    PG8_BAR;
    asm volatile("" ::: "memory");
#undef PG8_SA
#undef PG8_SB
#undef PG8_STAGE
#undef PG8_LDA
#undef PG8_LDB
#undef PG8_MMA
#undef PG8_WAIT_V
#undef PG8_WAIT_L
#undef PG8_BAR
#undef PG8_SCHED
#undef PG8_AP
}
}
namespace ep {
using pg8::Acc; using pg8::Ctx; using pg8::Unit;
#define EP_FOR_ROWS _Pragma("unroll") for (int ai = 0; ai < 2; ++ai) _Pragma("unroll") for (int m = 0; m < 4; ++m)
#define EP_RU (ai * 128 + cx.wr * 64 + m * 16)
#define EP_FENCE asm volatile("" ::: "memory")
__device__ __forceinline__ u32x4 pack8(const f32x4 a, const f32x4 b) { u32x4 w; w.x = cvt_pk_bf16(a[0], a[1]); w.y = cvt_pk_bf16(a[2], a[3]); w.z = cvt_pk_bf16(b[0], b[1]); w.w = cvt_pk_bf16(b[2], b[3]); return w; }
__device__ __forceinline__ float sq8(const f32x4 a, const f32x4 b) { return (a[0] * a[0] + a[1] * a[1]) + (a[2] * a[2] + a[3] * a[3]) + (b[0] * b[0] + b[1] * b[1]) + (b[2] * b[2] + b[3] * b[3]); }
__device__ __forceinline__ void row_atomic(float* sq_u, int fr, float ss, int fq) { ss += __shfl_xor(ss, 16); ss += __shfl_xor(ss, 32); if (fq == 0) unsafeAtomicAdd(sq_u + fr, ss); }
template <class TT> __device__ __forceinline__ TT* lane_ptr(TT* uni, unsigned lane_bytes) { return (TT*)((char*)uni + lane_bytes); }
template <class TT> __device__ __forceinline__ const TT* lane_ptr(const TT* uni, unsigned lane_bytes) { return (const TT*)((const char*)uni + lane_bytes); }
__device__ __forceinline__ void rope8(f32x4& a, f32x4& b, const f32x4 c4, const f32x4 s4) {
    const f32x4 a0 = a, b0 = b;
    a[0] = a0[0] * c4[0] - a0[1] * s4[0]; a[1] = a0[1] * c4[0] + a0[0] * s4[0]; a[2] = a0[2] * c4[1] - a0[3] * s4[1]; a[3] = a0[3] * c4[1] + a0[2] * s4[1];
    b[0] = b0[0] * c4[2] - b0[1] * s4[2]; b[1] = b0[1] * c4[2] + b0[0] * s4[2]; b[2] = b0[2] * c4[3] - b0[3] * s4[3]; b[3] = b0[3] * c4[3] + b0[2] * s4[3];
}
__device__ __forceinline__ size_t koff_u(int b, int h, int s16, int chunk) { return ((((size_t)(b * 8 + h) * 64 + (s16 >> 6)) * 12 + chunk) * 64 + (s16 & 63)) * 16; }
__device__ __forceinline__ size_t voff_u(int b, int h, int s16, int dh) { return ((((size_t)(b * 8 + h) * 64 + (s16 >> 6)) * 2 + dh) * 64 + (s16 & 63)) * 64; }

struct EpiProj {
    static constexpr bool HAS_MID = false, HAS_BEGIN = false;
    const float* sq_in; float* sq_cq; float* sq_ckv; bf16_t* projb; bf16_t* assm; unsigned char* kb; const float* cs;
    __device__ __forceinline__ void operator()(Acc& acc, const Unit& u, const Ctx& cx, int) const {
        const unsigned l_pj = (unsigned)(cx.fr * 512 + cx.fq * 8) * 2u, l_cs = (unsigned)(cx.fr * 32 + cx.fq * 4) * 4u, l_k = (unsigned)cx.fr * 16u, l_as = (unsigned)(cx.fr * 16) * 2u;
        EP_FOR_ROWS { const int rowu = u.pm * 256 + EP_RU; const float rs = rstd_of(sq_in[rowu + cx.fr], 1.0f / 1024.0f);
            if (u.pn == 0) { float ss = 0.f;
#pragma unroll
                for (int bj = 0; bj < 2; ++bj) { const f32x4 v0 = acc[ai][bj][m][0] * rs, v1 = acc[ai][bj][m][1] * rs; ss += sq8(v0, v1);
                    *(u32x4*)lane_ptr(projb + (size_t)rowu * 512 + bj * 128 + cx.wc * 32, l_pj) = pack8(v0, v1); }
                row_atomic(sq_cq + rowu, cx.fr, ss, cx.fq);
            } else if (u.pn == 1) {
                { const f32x4 v0 = acc[ai][0][m][0] * rs, v1 = acc[ai][0][m][1] * rs; *(u32x4*)lane_ptr(projb + (size_t)rowu * 512 + 256 + cx.wc * 32, l_pj) = pack8(v0, v1); row_atomic(sq_ckv + rowu, cx.fr, sq8(v0, v1), cx.fq); }
                f32x4 v0 = acc[ai][1][m][0] * rs, v1 = acc[ai][1][m][1] * rs;
                if (cx.wc != 0) { v0 = (f32x4){0.f, 0.f, 0.f, 0.f}; v1 = v0; }
                *(u32x4*)lane_ptr(projb + (size_t)rowu * 512 + 384 + cx.wc * 32, l_pj) = pack8(v0, v1);
                if (cx.wc == 0) { const float* cp = lane_ptr(cs + (size_t)rowu * 32, l_cs); const f32x4 c4 = *(const f32x4*)cp, s4 = *(const f32x4*)(cp + 16);
                    rope8(v0, v1, c4, s4); const u32x4 w = pack8(v0, v1); const int b = rowu >> 12, s16 = rowu & 4095;
#pragma unroll
                    for (int h = 0; h < 8; ++h) *(u32x4*)lane_ptr(kb + koff_u(b, h, s16, 8) , l_k + (unsigned)cx.fq * 1024u) = w; }
            } else {
#pragma unroll
                for (int bj = 0; bj < 2; ++bj) { const f32x4 v0 = acc[ai][bj][m][0] * rs, v1 = acc[ai][bj][m][1] * rs; const int chu = (u.pn - 2) * 256 + bj * 128 + cx.wc * 32;
                    *(u32x4*)lane_ptr(assm + ((size_t)(chu >> 4) * NCH + (rowu >> 5)) * KS3 + (rowu & 31) * 16, l_as + (unsigned)(cx.fq >> 1) * (unsigned)(NCH * KS3 * 2) + (unsigned)(cx.fq & 1) * 16u) = pack8(v0, v1); }
            }
            EP_FENCE;
        }
    }
};
struct EpiQ {
    static constexpr bool HAS_MID = false, HAS_BEGIN = false;
    const float* sq_cq; bf16_t* qb; const float* cs;
    __device__ __forceinline__ void operator()(Acc& acc, const Unit& u, const Ctx& cx, int) const {
        const unsigned l_q = (unsigned)(cx.fr * 768 + cx.fq * 8) * 2u, l_cs = (unsigned)(cx.fr * 32 + cx.fq * 4) * 4u;
        EP_FOR_ROWS { const int rowu = u.pm * 256 + EP_RU; const float rs = rstd_of(sq_cq[rowu + cx.fr], 1.0f / 256.0f);
            f32x4 c4 = (f32x4){1.f, 1.f, 1.f, 1.f}, s4 = (f32x4){0.f, 0.f, 0.f, 0.f}; if (u.pn == 2) { const float* cp = lane_ptr(cs + (size_t)rowu * 32, l_cs); c4 = *(const f32x4*)cp; s4 = *(const f32x4*)(cp + 16); }
#pragma unroll
            for (int bj = 0; bj < 2; ++bj) { f32x4 v0 = acc[ai][bj][m][0] * rs, v1 = acc[ai][bj][m][1] * rs;
                if (u.pn == 2) rope8(v0, v1, c4, s4);
                *(u32x4*)lane_ptr(qb + (size_t)rowu * 768 + u.pn * 256 + bj * 128 + cx.wc * 32, l_q) = pack8(v0, v1); }
            EP_FENCE; }
    }
};
struct EpiKV {
    static constexpr bool HAS_MID = false, HAS_BEGIN = false;
    const float* sq_ckv; unsigned char* kb; unsigned char* vb;
    __device__ __forceinline__ void operator()(Acc& acc, const Unit& u, const Ctx& cx, int) const {
        const unsigned l_kv = (cx.wc < 2) ? (unsigned)cx.fr * 16u + (unsigned)cx.fq * 1024u : (unsigned)cx.fr * 64u + (unsigned)cx.fq * 16u;
        EP_FOR_ROWS { const int rowu = u.pm * 256 + EP_RU; const float rs = rstd_of(sq_ckv[rowu + cx.fr], 1.0f / 128.0f); const int b = rowu >> 12, s16 = rowu & 4095;
#pragma unroll
            for (int bj = 0; bj < 2; ++bj) { const f32x4 v0 = acc[ai][bj][m][0] * rs, v1 = acc[ai][bj][m][1] * rs; const int h = 2 * u.pn + bj;
                unsigned char* dst = (cx.wc < 2) ? kb + koff_u(b, h, s16, cx.wc * 4) : vb + voff_u(b, h, s16, cx.wc - 2);
                *(u32x4*)lane_ptr(dst, l_kv) = pack8(v0, v1); }
            EP_FENCE; }
    }
};
struct EpiXloc {
    static constexpr bool HAS_MID = false, HAS_BEGIN = false;
    float* xloc;
    __device__ __forceinline__ void operator()(Acc& acc, const Unit& u, const Ctx& cx, int) const {
        const unsigned l_x = (unsigned)(cx.fr * 128 + cx.fq * 8) * 4u;
        EP_FOR_ROWS { const int rowu = u.pm * 256 + EP_RU; float* o = lane_ptr(xloc + (size_t)rowu * 128 + cx.wc * 32, l_x); *(f32x4*)o = acc[ai][0][m][0]; *(f32x4*)(o + 4) = acc[ai][0][m][1]; EP_FENCE; }
    }
};
__device__ __forceinline__ float gelu_tanh_f(float x) { const float z = 0.7978845608028654f * (x + 0.044715f * x * x * x); return x * __builtin_amdgcn_rcpf(1.0f + __builtin_amdgcn_exp2f(-2.0f * LOG2E * z)); }
__device__ __forceinline__ f32x4 gelu4(const f32x4 v) { return (f32x4){gelu_tanh_f(v[0]), gelu_tanh_f(v[1]), gelu_tanh_f(v[2]), gelu_tanh_f(v[3])}; }
struct EpiY {
    static constexpr bool HAS_MID = false, HAS_BEGIN = false;
    bf16_t* yb; bf16_t* gb;
    __device__ __forceinline__ void operator()(Acc& acc, const Unit& u, const Ctx& cx, int) const {
        const unsigned l_y = (unsigned)((cx.fr * 32 + (cx.fq >> 1)) * 512 + (cx.fq & 1) * 8) * 2u;
        EP_FOR_ROWS { const int rowu = u.pm * 256 + EP_RU, g = rowu >> 10, chunku = rowu & 1023;
#pragma unroll
            for (int bj = 0; bj < 2; ++bj) { const int colu = u.pn * 256 + bj * 128 + cx.wc * 32; const size_t o = ((size_t)chunku * 32 + (colu >> 4)) * 512 + g * 16;
                const f32x4 v0 = acc[ai][bj][m][0], v1 = acc[ai][bj][m][1]; *(u32x4*)lane_ptr(yb + o, l_y) = pack8(v0, v1); *(u32x4*)lane_ptr(gb + o, l_y) = pack8(gelu4(v0), gelu4(v1)); }
            EP_FENCE;
        }
    }
};
__device__ __forceinline__ float sigm(float z) { return __builtin_amdgcn_rcpf(1.0f + __builtin_amdgcn_exp2f(-LOG2E * z)); }
struct EpiGlu {
    static constexpr bool HAS_MID = false, HAS_BEGIN = false;
    const bf16_t* yb; const float* bglu; bf16_t* sout; float* sq_s;
    __device__ __forceinline__ void operator()(Acc& acc, const Unit& u, const Ctx& cx, int) const {
        const unsigned l_y = (unsigned)(cx.fr * 512 + cx.fq * 8) * 2u, l_b = (unsigned)(cx.fq * 8) * 4u;
        EP_FOR_ROWS { const int rowu = u.pm * 256 + EP_RU; float ss = 0.f;
#pragma unroll
            for (int bj = 0; bj < 2; ++bj) { const int colu = u.pn * 256 + bj * 128 + cx.wc * 32; const u32x4 yw = *(const u32x4*)lane_ptr(yb + (size_t)rowu * 512 + colu, l_y);
                const float* bp = lane_ptr(bglu + colu, l_b); const f32x4 z0 = acc[ai][bj][m][0] + *(const f32x4*)bp, z1 = acc[ai][bj][m][1] + *(const f32x4*)(bp + 4);
                const f32x4 v0 = (f32x4){bf_lo(yw.x) * sigm(z0[0]), bf_hi(yw.x) * sigm(z0[1]), bf_lo(yw.y) * sigm(z0[2]), bf_hi(yw.y) * sigm(z0[3])};
                const f32x4 v1 = (f32x4){bf_lo(yw.z) * sigm(z1[0]), bf_hi(yw.z) * sigm(z1[1]), bf_lo(yw.w) * sigm(z1[2]), bf_hi(yw.w) * sigm(z1[3])};
                ss += sq8(v0, v1); *(u32x4*)lane_ptr(sout + (size_t)rowu * 512 + colu, l_y) = pack8(v0, v1); }
            row_atomic(sq_s + rowu, cx.fr, ss, cx.fq);
            EP_FENCE;
        }
    }
};
template <bool MIX> struct EpiRes {
    static constexpr bool HAS_MID = MIX, HAS_BEGIN = MIX;
    const float* hin32; float* hout32; bf16_t* hb; float* sq_next; const float* sq_a; const float* sq_s;
    __device__ __forceinline__ void begin(const Unit& u, const Ctx& cx, int ui) const {
        if (cx.tid < 256) { const int row = u.pm * 256 + cx.tid; const float ra = rstd_of(sq_a[row], 1.0f / 512.0f), rsd = rstd_of(sq_s[row], 1.0f / 512.0f);
            ((LAS f32x2*)(cx.lds + XCH_OFF + (ui & 1) * 2048))[cx.tid] = (f32x2){ra / rsd, rsd}; }
    }
    __device__ __forceinline__ void mid(Acc& acc, const Unit&, const Ctx& cx, int ui) const {
        const LAS f32x2* tab = (const LAS f32x2*)(cx.lds + XCH_OFF + (ui & 1) * 2048) + cx.fr;
        EP_FOR_ROWS { const float r = tab[EP_RU].x;
#pragma unroll
            for (int bj = 0; bj < 2; ++bj) { acc[ai][bj][m][0] *= r; acc[ai][bj][m][1] *= r; } }
    }
    __device__ __forceinline__ void operator()(Acc& acc, const Unit& u, const Ctx& cx, int ui) const {
        const LAS f32x2* tab = (const LAS f32x2*)(cx.lds + XCH_OFF + (ui & 1) * 2048) + cx.fr;
        const unsigned l_h = (unsigned)(cx.fr * 1024 + cx.fq * 8) * 4u, l_hb = l_h >> 1;
        EP_FOR_ROWS { const int ru = EP_RU, rowu = u.pm * 256 + ru; float sc = 1.0f; if (MIX) sc = tab[ru].y; float ss = 0.f;
#pragma unroll
            for (int bj = 0; bj < 2; ++bj) { const size_t o = (size_t)rowu * 1024 + u.pn * 256 + bj * 128 + cx.wc * 32; f32x4 h0, h1;
                if (hin32) { const float* hq = lane_ptr(hin32 + o, l_h); h0 = *(const f32x4*)hq; h1 = *(const f32x4*)(hq + 4); }
                else { const u32x4 w = *(const u32x4*)lane_ptr(hb + o, l_hb); h0 = (f32x4){bf_lo(w.x), bf_hi(w.x), bf_lo(w.y), bf_hi(w.y)}; h1 = (f32x4){bf_lo(w.z), bf_hi(w.z), bf_lo(w.w), bf_hi(w.w)}; }
                const f32x4 v0 = h0 + acc[ai][bj][m][0] * sc, v1 = h1 + acc[ai][bj][m][1] * sc;
                if (hout32) { float* hp = lane_ptr(hout32 + o, l_h); *(f32x4*)hp = v0; *(f32x4*)(hp + 4) = v1; }
                else *(u32x4*)lane_ptr(hb + o, l_hb) = pack8(v0, v1);
                ss += sq8(v0, v1); }
            row_atomic(sq_next + rowu, cx.fr, ss, cx.fq);
            EP_FENCE;
        }
    }
};
struct EpiSoftmax {
    static constexpr bool HAS_MID = false, HAS_BEGIN = false;
    const float* sq_x; bf16_t* pb;
    __device__ __forceinline__ void operator()(Acc& acc, const Unit& u, const Ctx& cx, int) const {
        LAS float* PM = (LAS float*)(cx.lds + XCH_OFF + 4096) + cx.fr * 4; LAS float* PS = (LAS float*)(cx.lds + XCH_OFF + 8192) + cx.fr * 4;
        EP_FOR_ROWS { const int ru = EP_RU; const float rs = rstd_of(sq_x[u.pm * 256 + ru + cx.fr], 1.0f / 1024.0f); float mx = -3.0e38f;
#pragma unroll
            for (int bj = 0; bj < 2; ++bj)
#pragma unroll
                for (int n = 0; n < 2; ++n) { f32x4 v = acc[ai][bj][m][n] * rs; acc[ai][bj][m][n] = v; mx = fmaxf(fmaxf(mx, fmaxf(v[0], v[1])), fmaxf(v[2], v[3])); }
            mx = fmaxf(mx, __shfl_xor(mx, 16)); mx = fmaxf(mx, __shfl_xor(mx, 32));
            if (cx.fq == 0) PM[ru * 4 + cx.wc] = mx; EP_FENCE; }
        asm volatile("s_waitcnt lgkmcnt(0)" ::: "memory"); __builtin_amdgcn_s_barrier(); asm volatile("" ::: "memory");
        EP_FOR_ROWS { const int ru = EP_RU; const f32x4 q = *(const LAS f32x4*)(PM + ru * 4); const float mx = fmaxf(fmaxf(q[0], q[1]), fmaxf(q[2], q[3])); float sm = 0.f;
#pragma unroll
            for (int bj = 0; bj < 2; ++bj)
#pragma unroll
                for (int n = 0; n < 2; ++n) { f32x4 v = acc[ai][bj][m][n]; v = (f32x4){__builtin_amdgcn_exp2f(v[0] - mx), __builtin_amdgcn_exp2f(v[1] - mx), __builtin_amdgcn_exp2f(v[2] - mx), __builtin_amdgcn_exp2f(v[3] - mx)};
                    acc[ai][bj][m][n] = v; sm += (v[0] + v[1]) + (v[2] + v[3]); }
            sm += __shfl_xor(sm, 16); sm += __shfl_xor(sm, 32);
            if (cx.fq == 0) PS[ru * 4 + cx.wc] = sm; EP_FENCE; }
        asm volatile("s_waitcnt lgkmcnt(0)" ::: "memory"); __builtin_amdgcn_s_barrier(); asm volatile("" ::: "memory");
        const unsigned l_p = (unsigned)(cx.fr * 1024 + cx.fq * 8) * 2u;
        EP_FOR_ROWS { const int ru = EP_RU, rowu = u.pm * 256 + ru; const f32x4 q = *(const LAS f32x4*)(PS + ru * 4); const float inv = __builtin_amdgcn_rcpf((q[0] + q[1]) + (q[2] + q[3]));
#pragma unroll
            for (int bj = 0; bj < 2; ++bj) *(u32x4*)lane_ptr(pb + (size_t)rowu * 1024 + u.pn * 256 + bj * 128 + cx.wc * 32, l_p) = pack8(acc[ai][bj][m][0] * inv, acc[ai][bj][m][1] * inv);
            EP_FENCE; }
    }
};
struct EpiSwiglu {
    static constexpr bool HAS_MID = false, HAS_BEGIN = false;
    const float* sq_f; bf16_t* hid;
    __device__ __forceinline__ void operator()(Acc& acc, const Unit& u, const Ctx& cx, int) const {
        const unsigned l_h = (unsigned)(cx.fr * FF + cx.fq * 8) * 2u;
        EP_FOR_ROWS { const int rowu = u.pm * 256 + EP_RU; const float rs = rstd_of(sq_f[rowu + cx.fr], 1.0f / 1024.0f); f32x4 o[2];
#pragma unroll
            for (int n = 0; n < 2; ++n) { const f32x4 g = acc[ai][0][m][n] * rs, up = acc[ai][1][m][n] * rs; o[n] = (f32x4){g[0] * sigm(g[0]) * up[0], g[1] * sigm(g[1]) * up[1], g[2] * sigm(g[2]) * up[2], g[3] * sigm(g[3]) * up[3]}; }
            *(u32x4*)lane_ptr(hid + (size_t)rowu * FF + u.pn * 128 + cx.wc * 32, l_h) = pack8(o[0], o[1]); EP_FENCE; }
    }
};
template <class OutFn> struct EpiStore {
    static constexpr bool HAS_MID = false, HAS_BEGIN = false;
    OutFn of;
    __device__ __forceinline__ void operator()(Acc& acc, const Unit& u, const Ctx& cx, int) const {
        int ld; bf16_t* base = of(u, ld); const unsigned l_o = (unsigned)(cx.fr * ld + cx.fq * 8) * 2u;
        EP_FOR_ROWS { const int ru = EP_RU;
#pragma unroll
            for (int bj = 0; bj < 2; ++bj) *(u32x4*)lane_ptr(base + (size_t)ru * ld + bj * 128 + cx.wc * 32, l_o) = pack8(acc[ai][bj][m][0], acc[ai][bj][m][1]);
            EP_FENCE; }
    }
};
}
namespace att {
constexpr int KSLOT = 12288, VSLOT = 8192, NSLOT = 3;
constexpr int L_K = 0, L_V = NSLOT * KSLOT, L_WS = L_V + NSLOT * VSLOT, L_OST = L_WS + 8 * 256, L_END = L_OST + 8 * 4096;
static_assert(L_END <= RING_BYTES, "attention LDS");
__device__ __forceinline__ int crow(int r, int hi) { return (r & 3) + 8 * (r >> 2) + 4 * hi; }
#define SBAR() __builtin_amdgcn_sched_barrier(0)
__device__ __forceinline__ void cmask(f32x16& p0, f32x16& p1, int jb, int qrel, int hi) {
    const float NEG = -INFINITY; const int kb = 64 * jb + 4 * hi;
#pragma unroll
    for (int r = 0; r < 16; ++r) { const int kv = kb + (r & 3) + 8 * (r >> 2); if (kv > qrel) p0[r] = NEG; if (kv + 32 > qrel) p1[r] = NEG; }
}
__device__ __forceinline__ void glds16(const void* gsrc, unsigned lds_dst) { unsigned keep;
    asm volatile("s_mov_b32 %0, m0\n\ts_mov_b32 m0, %2\n\ts_nop 0\n\tglobal_load_lds_dwordx4 %1, off\n\ts_mov_b32 m0, %0" : "=&s"(keep) : "v"(gsrc), "s"(lds_dst) : "memory"); }
__device__ __forceinline__ float max3f(float a, float b, float c) { float r; asm("v_max3_f32 %0, %1, %2, %3" : "=v"(r) : "v"(a), "v"(b), "v"(c)); return r; }
__device__ __forceinline__ float max2f(float a, float b) { float r; asm("v_max_f32_e32 %0, %1, %2" : "=v"(r) : "v"(a), "v"(b)); return r; }
__device__ __forceinline__ float fadd_s(float a, float b) { float r; asm("v_add_f32_e32 %0, %1, %2" : "=v"(r) : "v"(a), "v"(b)); return r; }
__device__ __forceinline__ float fsub_s(float a, float b) { float r; asm("v_sub_f32_e32 %0, %1, %2" : "=v"(r) : "v"(a), "v"(b)); return r; }
#define WAIT_BAR(N) asm volatile("s_waitcnt vmcnt(" #N ") lgkmcnt(0)\n\ts_barrier" ::: "memory")
typedef LAS const char* lds_cptr;
typedef short v4i16_t __attribute__((ext_vector_type(4)));
__device__ __forceinline__ void qkt(f32x16& p0, f32x16& p1, lds_cptr kb, const bf16x8* qr) { const f32x16 negm = f32x16{};
#pragma unroll
    for (int d0 = 0; d0 < 6; ++d0) { const bf16x8 b0 = *(const LAS bf16x8*)(kb + d0 * 2048), b1 = *(const LAS bf16x8*)(kb + d0 * 2048 + 512);
        if (d0 == 0) { p0 = __builtin_amdgcn_mfma_f32_32x32x16_bf16(b0, qr[0], negm, 0, 0, 0); p1 = __builtin_amdgcn_mfma_f32_32x32x16_bf16(b1, qr[0], negm, 0, 0, 0); }
        else { p0 = __builtin_amdgcn_mfma_f32_32x32x16_bf16(b0, qr[d0], p0, 0, 0, 0); p1 = __builtin_amdgcn_mfma_f32_32x32x16_bf16(b1, qr[d0], p1, 0, 0, 0); } }
}
__device__ __forceinline__ void kload2(bf16x8* kf, lds_cptr kp, int j) { kf[2 * j] = *(const LAS bf16x8*)(kp + j * 2048); kf[2 * j + 1] = *(const LAS bf16x8*)(kp + j * 2048 + 512); }
__device__ __forceinline__ s16x4 vtr(lds_cptr p) { return __builtin_bit_cast(s16x4, __builtin_amdgcn_ds_read_tr16_b64_v4i16((LAS v4i16_t*)p)); }
__device__ __forceinline__ float rowmax(const f32x16& p0, const f32x16& p1) {
    float a = max3f(p0[0], p0[1], p1[0]), b = max3f(p0[2], p0[3], p1[1]); a = max3f(a, p1[2], p1[3]);
#pragma unroll
    for (int r = 4; r < 16; r += 4) { a = max3f(a, p0[r], p0[r + 1]); b = max3f(b, p0[r + 2], p0[r + 3]); a = max3f(a, p1[r], p1[r + 1]); b = max3f(b, p1[r + 2], p1[r + 3]); }
    const float m = max2f(a, b);
    auto rr = __builtin_amdgcn_permlane32_swap(__float_as_uint(m), __float_as_uint(m), false, false);
    return max2f(__uint_as_float(rr[0]), __uint_as_float(rr[1]));
}
__device__ __forceinline__ void pv(f32x16* o, int vb, bf16x8 pa0, bf16x8 pa1, bf16x8 pa2, bf16x8 pa3) {
#pragma unroll
    for (int d0 = 0; d0 < 2; ++d0) { s16x4 lo[4], hi[4];
#pragma unroll
        for (int ks = 0; ks < 4; ++ks) {
            asm volatile("ds_read_b64_tr_b16 %0,%1 offset:%c2" : "=&v"(lo[ks]) : "v"(vb), "i"(d0 * 4096 + ks * 1024) : "memory");
            asm volatile("ds_read_b64_tr_b16 %0,%1 offset:%c2" : "=&v"(hi[ks]) : "v"(vb), "i"(d0 * 4096 + ks * 1024 + 512) : "memory"); }
        asm volatile("s_waitcnt lgkmcnt(0)" ::: "memory"); SBAR();
#define PK(k) (bf16x8){lo[k][0], lo[k][1], lo[k][2], lo[k][3], hi[k][0], hi[k][1], hi[k][2], hi[k][3]}
        o[d0] = __builtin_amdgcn_mfma_f32_32x32x16_bf16(pa0, PK(0), o[d0], 0, 0, 0);
        o[d0] = __builtin_amdgcn_mfma_f32_32x32x16_bf16(pa1, PK(1), o[d0], 0, 0, 0);
        o[d0] = __builtin_amdgcn_mfma_f32_32x32x16_bf16(pa2, PK(2), o[d0], 0, 0, 0);
        o[d0] = __builtin_amdgcn_mfma_f32_32x32x16_bf16(pa3, PK(3), o[d0], 0, 0, 0);
#undef PK
    }
}
template <int THRL>
__device__ __forceinline__ void attn_unit(int b, int h, int qb, const bf16_t* Q, const unsigned char* Kg, const unsigned char* Vg, bf16_t* AO, float* sq_a, LAS unsigned char* lds) {
    int tid_ = threadIdx.x; asm volatile("" : "+v"(tid_));
    const int tid = tid_, lane = tid & 63, r32 = lane & 31, hi = lane >> 5; const int wid = __builtin_amdgcn_readfirstlane(tid >> 6);
    const int q0 = qb * 256; const size_t rowbase = (size_t)b * S;
    const bf16_t* Qw = Q + (rowbase + q0 + wid * 32) * 768;
    const unsigned lds0 = (unsigned)(uintptr_t)lds;
    LAS float* wsf = (LAS float*)(lds + L_WS) + wid * 64;
    const unsigned char* ksrc = Kg + (size_t)(b * 8 + h) * 64 * KSLOT + wid * 1536 + lane * 16; const unsigned char* vsrc = Vg + (size_t)(b * 8 + h) * 64 * VSLOT + wid * 1024 + lane * 16;
    const unsigned kdst = lds0 + L_K + wid * 1536, vdst = lds0 + L_V + wid * 1024;
#define DMA_K(t, sl) do { glds16(ksrc + (size_t)(t) * KSLOT, (unsigned)__builtin_amdgcn_readfirstlane(kdst + (sl) * KSLOT)); \
        if (lane < 32) glds16(ksrc + (size_t)(t) * KSLOT + 1024, (unsigned)__builtin_amdgcn_readfirstlane(kdst + (sl) * KSLOT + 1024)); } while (0)
#define DMA_V(t, sl) glds16(vsrc + (size_t)(t) * VSLOT, (unsigned)__builtin_amdgcn_readfirstlane(vdst + (sl) * VSLOT))
    const int vb0 = (int)(lds0 + L_V) + ((lane >> 4) & 1) * 32 + (lane & 3) * 8 + (4 * hi + ((lane & 15) >> 2)) * 64;
    bf16x8 kf[12];
    const lds_cptr kp0 = (lds_cptr)lds + L_K + hi * 1024 + r32 * 16; const lds_cptr vp0 = (lds_cptr)lds + L_V + ((lane >> 4) & 1) * 32 + (lane & 3) * 8 + (4 * hi + ((lane & 15) >> 2)) * 64;
    const int NT = 4 * (qb + 1);
    DMA_K(0, 0); DMA_V(0, 0); DMA_K(1, 1);
    bf16x8 qr[6];
#pragma unroll
    for (int d0 = 0; d0 < 6; ++d0) qr[d0] = *reinterpret_cast<const bf16x8*>(&Qw[(size_t)r32 * 768 + (d0 < 4 ? h * 64 + d0 * 16 : 512 + h * 32 + (d0 - 4) * 16) + hi * 8]);
    float mhat = 0.f, l_reg = 0.f; f32x16 o[2]; o[0] = f32x16{}; o[1] = f32x16{};
    const int qrel = wid * 32 + r32;
#define CMASK(P0, P1, t) do { int jb_ = (t) - (NT - 4); if (jb_ >= 0) cmask(P0, P1, jb_, qrel, hi); } while (0)
    bool resc = false;
#define START(P0, P1) do { const float rm = rowmax(P0, P1); resc = false; \
    mhat = rm; \
    _Pragma("unroll") for (int r = 0; r < 16; ++r) P0[r] = __builtin_amdgcn_exp2f(P0[r] - mhat); } while (0)
#define RESC() do { if (resc) { asm volatile("s_waitcnt lgkmcnt(0)" ::: "memory"); \
      _Pragma("unroll") for (int d_ = 0; d_ < 2; ++d_) _Pragma("unroll") for (int r = 0; r < 16; ++r) o[d_][r] *= wsf[crow(r, hi)]; } } while (0)
    f32x16 pA0, pA1, pB0, pB1;
    int sp = 0, sc = 0, sn = 1;
#define ROT() do { sp = sc; sc = sn; sn = (sn == NSLOT - 1) ? 0 : sn + 1; } while (0)
    DMA_K(2, 2);
    WAIT_BAR(5);
    qkt(pA0, pA1, kp0, qr); asm volatile("s_nop 15\n\ts_nop 7" : "+v"(pA0), "+v"(pA1)); CMASK(pA0, pA1, 0);
    START(pA0, pA1);
#pragma unroll
    for (int r = 0; r < 16; ++r) pA1[r] = __builtin_amdgcn_exp2f(pA1[r] - mhat);
    WAIT_BAR(0);
    DMA_K(3, 0); DMA_V(1, 1);
    ROT();
#pragma unroll
    for (int j = 0; j < 6; ++j) kload2(kf, kp0 + sc * KSLOT, j);
    WAIT_BAR(3);
    s16x4 vlo[8], vhi[8]; u32x4 pw0, pw1, pw2, pw3;
#define PKW(P, B) cvt_pk_bf16(P[B], P[B + 1])
#define PAF(k) __builtin_bit_cast(bf16x8, pw##k)
#define VFR(i) (bf16x8){vlo[i][0], vlo[i][1], vlo[i][2], vlo[i][3], vhi[i][0], vhi[i][1], vhi[i][2], vhi[i][3]}
#define PIN(x) asm volatile("" : "+v"(x))
#define MX3(a, b, c) __builtin_fmaxf(__builtin_fmaxf((a), (b)), (c))
#define GAPA(MF, A0, A1, A2, A3, W0, W1, PW) do { MF; sacc += A0; sacc += A1; sacc += A2; sacc += A3; PIN(sacc); W0; W1; PIN(PW); SBAR(); } while (0)
#define GAPM(MF) do { MF; SBAR(); } while (0)
#define EX(v) __builtin_amdgcn_exp2f(v)
#define GAPB(MF, X, B) do { MF; X[B] = EX(X[B] - mhat); X[B + 1] = EX(X[B + 1] - mhat); X[B + 2] = EX(X[B + 2] - mhat); X[B + 3] = EX(X[B + 3] - mhat); PIN(X); SBAR(); } while (0)
#define VRD(i) do { vlo[i] = vtr(vp_ + (((i) >> 2) * 4096 + ((i) & 3) * 1024)); vhi[i] = vtr(vp_ + (((i) >> 2) * 4096 + ((i) & 3) * 1024 + 512)); } while (0)
#define KRD(G, j) do { if (G) { kload2(kf, kp0 + sn * KSLOT, j); SBAR(); } } while (0)
#define MF32(A, B, C) __builtin_amdgcn_mfma_f32_32x32x16_bf16(A, B, C, 0, 0, 0)
#define STEP(C0, C1, P0, P1, t, GK, GV, GL) do { SBAR(); const f32x16 zero16 = f32x16{}; \
    const lds_cptr vp_ = vp0 + sp * VSLOT; \
    VRD(0); SBAR(); float sacc = (P0[0] + P0[1]); \
    GAPA(C0 = MF32(kf[0], qr[0], zero16), P0[2], P0[3], P0[4], P0[5],     pw0[0] = PKW(P0, 0), pw0[1] = PKW(P0, 2), pw0); \
    VRD(4); SBAR(); GAPA(C1 = MF32(kf[1], qr[0], zero16), P0[6], P0[7], P0[8], P0[9],     pw0[2] = PKW(P0, 4), pw0[3] = PKW(P0, 6), pw0); \
    VRD(1); SBAR(); GAPA(C0 = MF32(kf[2], qr[1], C0),   P0[10], P0[11], P0[12], P0[13], pw1[0] = PKW(P0, 8), pw1[1] = PKW(P0, 10), pw1); \
    VRD(5); SBAR(); GAPA(C1 = MF32(kf[3], qr[1], C1),   P0[14], P0[15], P1[0], P1[1],   pw1[2] = PKW(P0, 12), pw1[3] = PKW(P0, 14), pw1); \
    VRD(2); SBAR(); GAPA(C0 = MF32(kf[4], qr[2], C0),   P1[2], P1[3], P1[4], P1[5],     pw2[0] = PKW(P1, 0), pw2[1] = PKW(P1, 2), pw2); \
    VRD(6); SBAR(); GAPA(C1 = MF32(kf[5], qr[2], C1),   P1[6], P1[7], P1[8], P1[9],     pw2[2] = PKW(P1, 4), pw2[3] = PKW(P1, 6), pw2); \
    VRD(3); SBAR(); GAPA(C0 = MF32(kf[6], qr[3], C0),   P1[10], P1[11], P1[12], P1[13], pw3[0] = PKW(P1, 8), pw3[1] = PKW(P1, 10), pw3); \
    VRD(7); SBAR(); GAPA(C1 = MF32(kf[7], qr[3], C1),   P1[14], P1[15], 0.f, 0.f,       pw3[2] = PKW(P1, 12), pw3[3] = PKW(P1, 14), pw3); \
    GAPM(C0 = MF32(kf[8], qr[4], C0)); GAPM(C1 = MF32(kf[9], qr[4], C1)); GAPM(C0 = MF32(kf[10], qr[5], C0)); GAPM(C1 = MF32(kf[11], qr[5], C1)); \
    l_reg += sacc; \
    if (GK) { DMA_K((t) + 3, sc); } if (GV) { DMA_V((t) + 1, sn); } \
    CMASK(C0, C1, t); \
    { float a = MX3(C0[0], C0[1], C1[0]), b = MX3(C0[2], C0[3], C1[1]); a = MX3(a, C1[2], C1[3]); \
      _Pragma("unroll") for (int r = 4; r < 16; r += 4) { a = MX3(a, C0[r], C0[r + 1]); b = MX3(b, C0[r + 2], C0[r + 3]); a = MX3(a, C1[r], C1[r + 1]); b = MX3(b, C1[r + 2], C1[r + 3]); } \
      float rm = __builtin_fmaxf(a, b); { auto rr = __builtin_amdgcn_permlane32_swap(__float_as_uint(rm), __float_as_uint(rm), false, false); rm = __builtin_fmaxf(__uint_as_float(rr[0]), __uint_as_float(rr[1])); } \
      resc = false; \
      rm -= mhat; \
      if (__builtin_expect(__any(rm > (float)THRL), 0)) { const float dl = __builtin_fmaxf(rm, 0.f); mhat += dl; \
        const float f = __builtin_amdgcn_exp2f(-dl); l_reg *= f; if (hi == 0) wsf[r32] = f; resc = true; } } \
    SBAR(); \
    GAPB(o[0] = MF32(PAF(0), VFR(0), o[0]), C0, 0); \
    KRD(GL, 0); GAPB(o[1] = MF32(PAF(0), VFR(4), o[1]), C0, 4); \
    KRD(GL, 1); GAPB(o[0] = MF32(PAF(1), VFR(1), o[0]), C0, 8); \
    KRD(GL, 2); GAPB(o[1] = MF32(PAF(1), VFR(5), o[1]), C0, 12); \
    KRD(GL, 3); GAPB(o[0] = MF32(PAF(2), VFR(2), o[0]), C1, 0); \
    KRD(GL, 4); GAPB(o[1] = MF32(PAF(2), VFR(6), o[1]), C1, 4); \
    KRD(GL, 5); GAPB(o[0] = MF32(PAF(3), VFR(3), o[0]), C1, 8); \
    GAPB(o[1] = MF32(PAF(3), VFR(7), o[1]), C1, 12); \
    } while (0)
    int t = 1;
#undef CMASK
#define CMASK(P0, P1, t) do {} while (0)
    for (; t + 5 < NT; t += 2) {
        STEP(pB0, pB1, pA0, pA1, t, true, true, true);     WAIT_BAR(3); RESC(); ROT();
        STEP(pA0, pA1, pB0, pB1, t + 1, true, true, true); WAIT_BAR(3); RESC(); ROT();
    }
#undef CMASK
#define CMASK(P0, P1, t) do { int jb_ = (t) - (NT - 4); if (jb_ >= 0) cmask(P0, P1, jb_, qrel, hi); } while (0)
#define ENDW(tt) do { if ((tt) + 3 < NT) { WAIT_BAR(3); } else if ((tt) + 2 < NT) { WAIT_BAR(1); } else { WAIT_BAR(0); } } while (0)
    for (; t + 1 < NT; t += 2) {
        STEP(pB0, pB1, pA0, pA1, t, (t + 3 < NT), (t + 1 < NT), (t + 1 < NT));     ENDW(t);     RESC(); ROT();
        STEP(pA0, pA1, pB0, pB1, t + 1, (t + 4 < NT), (t + 2 < NT), (t + 2 < NT)); ENDW(t + 1); RESC(); ROT();
    }
    STEP(pB0, pB1, pA0, pA1, NT - 1, false, false, false); RESC();
    { float sacc = pB0[0] + pB0[1];
#pragma unroll
      for (int r = 2; r < 16; ++r) sacc += pB0[r];
#pragma unroll
      for (int r = 0; r < 16; ++r) sacc += pB1[r];
      l_reg += sacc;
      pw0 = (u32x4){PKW(pB0, 0), PKW(pB0, 2), PKW(pB0, 4), PKW(pB0, 6)}; pw1 = (u32x4){PKW(pB0, 8), PKW(pB0, 10), PKW(pB0, 12), PKW(pB0, 14)};
      pw2 = (u32x4){PKW(pB1, 0), PKW(pB1, 2), PKW(pB1, 4), PKW(pB1, 6)}; pw3 = (u32x4){PKW(pB1, 8), PKW(pB1, 10), PKW(pB1, 12), PKW(pB1, 14)};
      SBAR(); pv(o, vb0 + sc * VSLOT, PAF(0), PAF(1), PAF(2), PAF(3)); }
#undef PKW
#undef PAF
#undef VFR
#undef PIN
#undef MX3
#undef GAPA
#undef GAPM
#undef GAPB
#undef EX
#undef VRD
#undef KRD
#undef MF32
#undef STEP
#undef ENDW
#undef DMA_K
#undef DMA_V
#undef CMASK
#undef START
#undef RESC
#undef ROT
    { auto rr = __builtin_amdgcn_permlane32_swap(__float_as_uint(l_reg), __float_as_uint(l_reg), false, false); l_reg = __uint_as_float(rr[0]) + __uint_as_float(rr[1]); }
    if (hi == 0) wsf[32 + r32] = l_reg;
    asm volatile("s_waitcnt lgkmcnt(0)" ::: "memory");
    LAS bf16_t* stg = (LAS bf16_t*)(lds + L_OST) + wid * 2048;
#pragma unroll
    for (int r = 0; r < 16; ++r) { const int orow = crow(r, hi); const float rl = __builtin_amdgcn_rcpf(wsf[32 + orow]);
#pragma unroll
        for (int d0 = 0; d0 < 2; ++d0) stg[orow * 64 + d0 * 32 + r32] = (bf16_t)(cvt_pk_bf16(o[d0][r] * rl, 0.f) & 0xffffu); }
    asm volatile("s_waitcnt lgkmcnt(0)" ::: "memory");
    bf16_t* Ow = AO + (rowbase + q0 + wid * 32) * 512 + h * 64;
#pragma unroll
    for (int i = 0; i < 4; ++i) { const int row = i * 8 + (lane >> 3), ch = lane & 7; const u32x4 v = *(const LAS u32x4*)(stg + row * 64 + ch * 8); *(u32x4*)(Ow + (size_t)row * 512 + ch * 8) = v;
        float ss = (bf_lo(v.x) * bf_lo(v.x) + bf_hi(v.x) * bf_hi(v.x)) + (bf_lo(v.y) * bf_lo(v.y) + bf_hi(v.y) * bf_hi(v.y)) + (bf_lo(v.z) * bf_lo(v.z) + bf_hi(v.z) * bf_hi(v.z)) + (bf_lo(v.w) * bf_lo(v.w) + bf_hi(v.w) * bf_hi(v.w));
        ss += __shfl_xor(ss, 1); ss += __shfl_xor(ss, 2); ss += __shfl_xor(ss, 4);
        if (ch == 0) unsafeAtomicAdd(sq_a + rowbase + q0 + wid * 32 + row, ss); }
    asm volatile("s_waitcnt lgkmcnt(0)\n\ts_barrier" ::: "memory");
}
#undef SBAR
#undef WAIT_BAR
__device__ __forceinline__ void attn_phase(int vcu, int G, const bf16_t* Q, const unsigned char* Kg, const unsigned char* Vg, bf16_t* AO, float* sq_a, LAS unsigned char* lds) {
    for (int v = vcu; v < 256; v += G) { const int bh = v >> 2, s = v & 3;
#pragma unroll 1
        for (int i = 0; i < 4; ++i) { const int qb = (i == 0) ? s : (i == 1) ? 7 - s : (i == 2) ? 8 + s : 15 - s; attn_unit<8>(bh >> 3, bh & 7, qb, Q, Kg, Vg, AO, sq_a, lds); } }
}
}

__device__ __forceinline__ void ssm_scan_phase(int vcu, int G, const float* xloc, const float* aL  , bf16_t* assm) {
    int tid_ = threadIdx.x; asm volatile("" : "+v"(tid_));
    if (tid_ >= 64) return;
    const int p = tid_;
    for (int v = vcu; v < 256; v += G) { const int b = v >> 5, g = v & 31; const float ar = aL[(g * 64 + p) * 2], ai = aL[(g * 64 + p) * 2 + 1];
        float xr = 0.f, xi = 0.f;
        const float* xl = xloc + ((size_t)g * NCH + b * NCHB) * 128; bf16_t* as = assm + ((size_t)g * NCH + b * NCHB) * KS3 + KS1;
#pragma unroll 8
        for (int c = 0; c < NCHB; ++c) { const float lr = xl[(size_t)c * 128 + p], li = xl[(size_t)c * 128 + 64 + p];
            as[(size_t)c * KS3 + p] = (bf16_t)(cvt_pk_bf16(xr, 0.f) & 0xffffu); as[(size_t)c * KS3 + 64 + p] = (bf16_t)(cvt_pk_bf16(xi, 0.f) & 0xffffu);
            const float nr = ar * xr - ai * xi + lr, ni = ar * xi + ai * xr + li; xr = nr; xi = ni; }
    }
}
__device__ __forceinline__ void sincos_d(double a, double& s, double& c) {
    const double k = rint(a * 0.63661977236758134308);
    double y = fma(-k, 1.57079632679489655800e+00, a); y = fma(-k, 6.12323399573676603587e-17, y);
    const double y2 = y * y;
    double sp = -1.0 / 1307674368000.0; sp = fma(sp, y2, 1.0 / 6227020800.0); sp = fma(sp, y2, -1.0 / 39916800.0); sp = fma(sp, y2, 1.0 / 362880.0);
    sp = fma(sp, y2, -1.0 / 5040.0); sp = fma(sp, y2, 1.0 / 120.0); sp = fma(sp, y2, -1.0 / 6.0); sp = fma(sp * y2, y, y);
    double cp = 1.0 / 20922789888000.0; cp = fma(cp, y2, -1.0 / 87178291200.0); cp = fma(cp, y2, 1.0 / 479001600.0); cp = fma(cp, y2, -1.0 / 3628800.0);
    cp = fma(cp, y2, 1.0 / 40320.0); cp = fma(cp, y2, -1.0 / 720.0); cp = fma(cp, y2, 1.0 / 24.0); cp = fma(cp, y2, -0.5); cp = fma(cp, y2, 1.0);
    const int q = (int)((long long)k & 3);
    if (q == 0) { s = sp; c = cp; } else if (q == 1) { s = cp; c = -sp; } else if (q == 2) { s = -sp; c = -cp; } else { s = -cp; c = sp; }
}
__device__ __forceinline__ float wave_sum(float v) {
#pragma unroll
    for (int o = 1; o < 64; o <<= 1) v += __shfl_xor(v, o);
    return v;
}
template <class ColFn, class GainFn>
__device__ __forceinline__ void conv_T(int gw, int NGW, int& base, int lane, LAS float* scr, int Ksrc, int ldw, int Ndst, bf16_t* dst, int ldd, ColFn colp, GainFn gain, float scale) {
    const int nblk = Ndst / 32, nitems = nblk * (Ksrc / 64);
    int first = gw - (base % NGW); if (first < 0) first += NGW;
    base += nitems;
    for (int it = first; it < nitems; it += NGW) { const int kb = it / nblk, nb = it % nblk, k0 = 64 * kb, n0 = 32 * nb;
        const float* cp = colp(n0 + (lane & 31)); float v[32];
        if (cp) { const float* q = cp + (size_t)(k0 + (lane >> 5)) * ldw;
#pragma unroll
            for (int i = 0; i < 32; ++i) v[i] = q[(size_t)(2 * i) * ldw]; }
        else {
#pragma unroll
            for (int i = 0; i < 32; ++i) v[i] = 0.f; }
#pragma unroll
        for (int i = 0; i < 32; ++i) scr[(2 * i + (lane >> 5)) * 33 + (lane & 31)] = v[i];
        asm volatile("s_waitcnt lgkmcnt(0)" ::: "memory");
        const int c = lane & 7; float gk[8];
#pragma unroll
        for (int e = 0; e < 8; ++e) gk[e] = gain(k0 + 8 * c + e) * scale;
#pragma unroll
        for (int j = 0; j < 4; ++j) { const int n = (lane >> 3) + 8 * j; const LAS float* sp = scr + (8 * c) * 33 + n;
            u32x4 o; o.x = cvt_pk_bf16(sp[0 * 33] * gk[0], sp[1 * 33] * gk[1]); o.y = cvt_pk_bf16(sp[2 * 33] * gk[2], sp[3 * 33] * gk[3]); o.z = cvt_pk_bf16(sp[4 * 33] * gk[4], sp[5 * 33] * gk[5]); o.w = cvt_pk_bf16(sp[6 * 33] * gk[6], sp[7 * 33] * gk[7]);
            *(u32x4*)(dst + (size_t)(n0 + n) * ldd + k0 + 8 * c) = o; }
        asm volatile("s_waitcnt lgkmcnt(0)" ::: "memory");
    }
}
struct In {
    const float *x, *mem; const int* pos; const float *norm_mix_g, *w_in, *q_norm_g, *w_uq, *kv_norm_g, *w_ukv, *lam_re, *lam_im, *log_dt, *b_re, *b_im, *c_re, *c_im, *ssm_d, *w_glu, *b_glu,
        *attn_out_g, *ssm_out_g, *w_out, *norm_x_g, *mem_norm_g, *w_xq, *w_xkv, *w_xo, *norm_ffn_g, *w_gate, *w_up, *w_down, *final_g;
};
struct Freqs { double f[16]; };

__device__ __forceinline__ void ssm_mats(const In& in, int l, int g, int q, unsigned char* ws, LAS unsigned char* lds) {
    const int tid = threadIdx.x;
    LAS float* bbr = (LAS float*)lds; LAS float* bbi = bbr + 1024; LAS float* apr = bbi + 1024; LAS float* api = apr + 34 * 64; LAS float* cr = api + 34 * 64; LAS float* ci = cr + 1024;
    LAS float* ktabT = ci + 1024  ; LAS float* aprT = ktabT + 2048  ; LAS float* apiT = aprT + 64 * 35; LAS float* dvs = apiT + 64 * 35;
    const int lg = l * 32 + g;
    if (tid < 128) { const int p = tid & 63; const double lr = in.lam_re[lg * 64 + p], li = in.lam_im[lg * 64 + p], dt = exp((double)in.log_dt[lg]);
        double sn, cn; sincos_d(fabs(li * dt), sn, cn); if (li * dt < 0) sn = -sn;
        const double er = exp(lr * dt), ar = er * cn, ai = er * sn;
        if (tid < 64) {
            double pr = 1.0, pi = 0.0;
            for (int j = 0; j < 34; ++j) { apr[j * 64 + p] = (float)pr; api[j * 64 + p] = (float)pi; aprT[p * 35 + j] = (float)pr; apiT[p * 35 + j] = (float)pi;
                if (j == LC && q == 0) { float* al = (float*)(ws + WS_AL) + (size_t)(lg * 64 + p) * 2; al[0] = (float)pr; al[1] = (float)pi; }
                const double nr = pr * ar - pi * ai, ni = pr * ai + pi * ar; pr = nr; pi = ni; }
        } else {
            const double den = lr * lr + li * li, cfr = ((ar - 1.0) * lr + ai * li) / den, cfi = (ai * lr - (ar - 1.0) * li) / den; const float fr_ = (float)cfr, fi_ = (float)cfi;
            float bre[16], bim[16];
#pragma unroll
            for (int c = 0; c < 16; ++c) { bre[c] = in.b_re[(size_t)(lg * 64 + p) * 16 + c]; bim[c] = in.b_im[(size_t)(lg * 64 + p) * 16 + c]; }
#pragma unroll
            for (int c = 0; c < 16; ++c) { bbr[p * 16 + c] = fr_ * bre[c] - fi_ * bim[c]; bbi[p * 16 + c] = fr_ * bim[c] + fi_ * bre[c]; }
        }
    } else if (tid < 192) { const int p = tid - 128;
#pragma unroll
        for (int c = 0; c < 16; ++c) { cr[c * 64 + p] = in.c_re[(size_t)(lg * 16 + c) * 64 + p]; ci[c * 64 + p] = in.c_im[(size_t)(lg * 16 + c) * 64 + p]; }
    } else if (tid < 208) dvs[tid - 192] = in.ssm_d[l * 512 + g * 16 + (tid - 192)];
    __syncthreads();
    {
      const int j = tid >> 4, c4 = (tid >> 2) & 3, c = 4 * q + c4, c2b = (tid & 3) * 4; f32x4 sum = (f32x4){0.f, 0.f, 0.f, 0.f};
#pragma unroll 4
      for (int p = 0; p < 64; ++p) { const float yr = apr[j * 64 + p], yi = api[j * 64 + p], xr = cr[c * 64 + p], xi = ci[c * 64 + p]; const float car = xr * yr - xi * yi, cai = xr * yi + xi * yr;
          sum += car * *(const LAS f32x4*)(bbr + p * 16 + c2b) - cai * *(const LAS f32x4*)(bbi + p * 16 + c2b); }
#pragma unroll
      for (int y = 0; y < 4; ++y) ktabT[(c4 * 16 + c2b + y) * 32 + j] = sum[y]; }
    __syncthreads();
    bf16_t* bt1 = (bf16_t*)(ws + WS_SSM + (size_t)lg * SSM_G_STRIDE); bf16_t* bt3 = (bf16_t*)(ws + WS_SSM + (size_t)lg * SSM_G_STRIDE + SSM_BT3_OFF);
    for (int idx = tid; idx < 128 * 80; idx += 512) { const int rq = idx / 80, k0 = (idx % 80) * 8, s = rq >> 2, c4 = rq & 3, c = 4 * q + c4, n = s * 16 + c; float v[8];
        if (k0 < KS1) { const int s2 = k0 >> 4, c0 = k0 & 15; const float dvc = (s2 == s) ? dvs[c] : 0.f; const LAS float* kt = ktabT + (c4 * 16 + c0) * 32 + (s2 <= s ? s - s2 : 0);
#pragma unroll
            for (int e = 0; e < 8; ++e) { float t = kt[e * 32]; if (s2 > s) t = 0.f; if (c0 + e == c) t += dvc; v[e] = t; }
        } else { const int pq = k0 - KS1, p0 = pq & 63; const bool im = (pq >> 6) != 0;
            const LAS float* xrp = cr + c * 64 + p0; const LAS float* xip = ci + c * 64 + p0; const LAS float* yrp = apr + (s + 1) * 64 + p0; const LAS float* yip = api + (s + 1) * 64 + p0;
#pragma unroll
            for (int hh = 0; hh < 2; ++hh) { const f32x4 xr = *(const LAS f32x4*)(xrp + 4 * hh), xi = *(const LAS f32x4*)(xip + 4 * hh), yr = *(const LAS f32x4*)(yrp + 4 * hh), yi = *(const LAS f32x4*)(yip + 4 * hh);
                const f32x4 re = xr * yr - xi * yi, mi = -(xr * yi + xi * yr);
#pragma unroll
                for (int e = 0; e < 4; ++e) v[4 * hh + e] = im ? mi[e] : re[e]; }
        }
        u32x4 o; o.x = cvt_pk_bf16(v[0], v[1]); o.y = cvt_pk_bf16(v[2], v[3]); o.z = cvt_pk_bf16(v[4], v[5]); o.w = cvt_pk_bf16(v[6], v[7]);
        *(u32x4*)(bt3 + (size_t)n * KS3 + k0) = o; }
    for (int idx = tid; idx < 64 * 64; idx += 512) { const int rq = idx >> 6, k0 = (idx & 63) * 8, s2 = k0 >> 4, c0 = k0 & 15; float v[8];
        const bool real_row = rq < 32; const int p = 16 * q + (rq & 15); const bool im = (rq >> 4) & 1; const int n = real_row ? (im ? 64 + p : p) : 128 + 32 * q + (rq - 32);
        if (real_row) { const float yr = aprT[p * 35 + (LC - 1 - s2)], yi = apiT[p * 35 + (LC - 1 - s2)];
#pragma unroll
            for (int hh = 0; hh < 2; ++hh) { const f32x4 br = *(const LAS f32x4*)(bbr + p * 16 + c0 + 4 * hh), bi = *(const LAS f32x4*)(bbi + p * 16 + c0 + 4 * hh);
                const f32x4 re = br * yr - bi * yi, mi = bi * yr + br * yi;
#pragma unroll
                for (int e = 0; e < 4; ++e) v[4 * hh + e] = im ? mi[e] : re[e]; }
        } else {
#pragma unroll
            for (int e = 0; e < 8; ++e) v[e] = 0.f; }
        u32x4 o; o.x = cvt_pk_bf16(v[0], v[1]); o.y = cvt_pk_bf16(v[2], v[3]); o.z = cvt_pk_bf16(v[4], v[5]); o.w = cvt_pk_bf16(v[6], v[7]);
        *(u32x4*)(bt1 + (size_t)n * KS1 + k0) = o; }
    __syncthreads();
}

__device__ __forceinline__ void prologue(const In& in, const Freqs& fr, unsigned char* ws, LAS unsigned char* lds, int vcu, int G, int parts) {
    const int tid = threadIdx.x, lane = tid & 63, wave = __builtin_amdgcn_readfirstlane(tid >> 6);
    __syncthreads();
    if (parts & 1) for (int j = vcu; j < 256; j += G) ssm_mats(in, j >> 7, (j >> 2) & 31, j & 3, ws, lds);
    LAS float* scr = (LAS float*)(lds + wave * 16384);
    const int gw = vcu * 8 + wave, NGW = G * 8;
    if (parts & 2) {
    { bf16_t* hb = (bf16_t*)(ws + WS_HB); float* sq0 = (float*)(ws + WS_CTL) + CW_SQ + (size_t)SQ_MIX * T;
      for (int r = gw * 2; r < T; r += NGW * 2) { const f32x4* xr = (const f32x4*)(in.x + (size_t)r * D) + lane; u32x2* hrow = (u32x2*)(hb + (size_t)r * D) + lane; f32x4 v[8];
#pragma unroll
          for (int j = 0; j < 8; ++j) v[j] = xr[64 * j];
          float s0 = 0.f, s1 = 0.f;
#pragma unroll
          for (int j = 0; j < 4; ++j) { s0 += (v[j][0] * v[j][0] + v[j][1] * v[j][1]) + (v[j][2] * v[j][2] + v[j][3] * v[j][3]); s1 += (v[j + 4][0] * v[j + 4][0] + v[j + 4][1] * v[j + 4][1]) + (v[j + 4][2] * v[j + 4][2] + v[j + 4][3] * v[j + 4][3]); }
#pragma unroll
          for (int j = 0; j < 8; ++j) hrow[64 * j] = (u32x2){cvt_pk_bf16(v[j][0], v[j][1]), cvt_pk_bf16(v[j][2], v[j][3])};
          s0 = wave_sum(s0); s1 = wave_sum(s1); if (lane == 0) { sq0[r] = s0; sq0[r + 1] = s1; } } }
    { bf16_t* mn = (bf16_t*)(ws + WS_RA + RA_MEMN);
      for (int r = gw; r < NB * MEMT; r += NGW) { const f32x4* xr = (const f32x4*)(in.mem + (size_t)r * D) + lane; u32x2* mrow = (u32x2*)(mn + (size_t)r * D) + lane; f32x4 v[4]; float s = 0.f;
#pragma unroll
          for (int j = 0; j < 4; ++j) { v[j] = xr[64 * j]; s += (v[j][0] * v[j][0] + v[j][1] * v[j][1]) + (v[j][2] * v[j][2] + v[j][3] * v[j][3]); }
          const float rs = rstd_of(wave_sum(s), 1.0f / 1024.0f);
#pragma unroll
          for (int j = 0; j < 4; ++j) mrow[64 * j] = (u32x2){cvt_pk_bf16(v[j][0] * rs, v[j][1] * rs), cvt_pk_bf16(v[j][2] * rs, v[j][3] * rs)}; } }
    { float* cs = (float*)(ws + WS_CS);
      for (int i = vcu * 512 + tid; i < T * 16; i += G * 512) { const int t = i >> 4, j = i & 15; double s, c; sincos_d((double)in.pos[t] * fr.f[j], s, c); cs[(size_t)t * 32 + j] = (float)c; cs[(size_t)t * 32 + 16 + j] = (float)s; } }
    }
    if (!(parts & 4)) return;
    int cbase = 0;
    for (int l = 0; l < NL; ++l) {
        unsigned char* wl = ws + WS_W + (size_t)l * WL_STRIDE;
        { const float* W = in.w_in + (size_t)l * D * 928; const float* gn = in.norm_mix_g + l * D;
          conv_T(gw, NGW, cbase, lane, scr, D, 928, 1024, (bf16_t*)(wl + WL_IN), 1024,
                 [=](int n) -> const float* { if (n < 384) return W + n; if (n < 416) { const int i = n - 384; return W + ((i & 1) ? 400 + (i >> 1) : 384 + (i >> 1)); } if (n < 512) return nullptr; return W + 416 + (n - 512); },
                 [=](int k) { return gn[k]; }, 1.0f); }
        { const float* W = in.w_uq + (size_t)l * 256 * 768; const float* gn = in.q_norm_g + l * 256;
          conv_T(gw, NGW, cbase, lane, scr, 256, 768, 768, (bf16_t*)(wl + WL_UP), 256,
                 [=](int n) -> const float* { if (n < 512) return W + (n >> 6) * 96 + (n & 63); const int h = (n - 512) >> 5, i = (n - 512) & 31; return W + h * 96 + ((i & 1) ? 80 + (i >> 1) : 64 + (i >> 1)); },
                 [=](int k) { return gn[k]; }, 0.10206207261596575f * LOG2E); }
        { const float* W = in.w_ukv + (size_t)l * 128 * 1024; const float* gn = in.kv_norm_g + l * 128; bf16_t* dst = (bf16_t*)(wl + WL_UP) + (size_t)768 * 256;
          conv_T(gw, NGW, cbase, lane, scr, 128, 1024, 1024, dst, 256, [=](int n) -> const float* { return W + n; }, [=](int k) { return gn[k]; }, 1.0f);
          for (int i = vcu * 512 + tid; i < 1024 * 16; i += G * 512) *(u32x4*)(dst + (size_t)(i >> 4) * 256 + 128 + (i & 15) * 8) = (u32x4){0u, 0u, 0u, 0u}; }
        { const float* W = in.w_glu + (size_t)l * 512 * 512;
          conv_T(gw, NGW, cbase, lane, scr, 512, 512, 512, (bf16_t*)(wl + WL_GLU), 512, [=](int n) -> const float* { return W + n; }, [=](int) { return 1.0f; }, 1.0f); }
        { const float* W = in.w_out + (size_t)l * D * D; const float* ga = in.attn_out_g + l * 512; const float* gs = in.ssm_out_g + l * 512;
          conv_T(gw, NGW, cbase, lane, scr, D, D, D, (bf16_t*)(wl + WL_OUT), D, [=](int n) -> const float* { return W + n; }, [=](int k) { return k < 512 ? ga[k] : gs[k - 512]; }, 1.0f); }
        { const float* W = in.w_xkv + (size_t)l * D * 2048; const float* gn = in.mem_norm_g + l * D;
          conv_T(gw, NGW, cbase, lane, scr, D, 2048, 2048, (bf16_t*)(ws + WS_WXKV) + (size_t)l * 2048 * D, D, [=](int n) -> const float* { return W + n; }, [=](int k) { return gn[k]; }, 1.0f); }
        { const float* W = in.w_xo + (size_t)l * D * D;
          conv_T(gw, NGW, cbase, lane, scr, D, D, D, (bf16_t*)(ws + WS_WXO) + (size_t)l * D * D, D, [=](int n) -> const float* { return W + n; }, [=](int) { return 1.0f; }, 1.0f); }
        { const float* Wg = in.w_gate + (size_t)l * D * FF; const float* Wu = in.w_up + (size_t)l * D * FF; const float* gn = in.norm_ffn_g + l * D;
          conv_T(gw, NGW, cbase, lane, scr, D, FF, 2 * FF, (bf16_t*)(wl + WL_GU), D,
                 [=](int n) -> const float* { const int tl = n >> 8, r = n & 255; return r < 128 ? Wg + tl * 128 + r : Wu + tl * 128 + (r - 128); }, [=](int k) { return gn[k]; }, 1.0f); }
        { const float* W = in.w_down + (size_t)l * FF * D;
          conv_T(gw, NGW, cbase, lane, scr, FF, D, D, (bf16_t*)(wl + WL_DN), FF, [=](int n) -> const float* { return W + n; }, [=](int) { return 1.0f; }, 1.0f); }
        { const float* W = in.w_xq + (size_t)l * D * D; const float* gn = in.norm_x_g + l * D; bf16_t* dst = (bf16_t*)(wl + WL_XQ);
          for (int i = vcu * 512 + tid; i < D * D / 8; i += G * 512) { const int k = i >> 7; const float sc = gn[k] * (0.0625f * LOG2E); const f32x4 a = *(const f32x4*)(W + (size_t)i * 8) * sc, b = *(const f32x4*)(W + (size_t)i * 8 + 4) * sc;
              *(u32x4*)(dst + (size_t)i * 8) = ep::pack8(a, b); } }
    }
}
struct Args { In in; float* out; unsigned char* ws; Freqs fr; int ph_hi; int pad; };

template <class F> struct PanelFn { F f; __device__ __forceinline__ void operator()(const pg8::Unit& u, const char*& a, const char*& b) const { f(u, a, b); } };
template <class F> __device__ __forceinline__ PanelFn<F> make_panel(F f) { return PanelFn<F>{f}; }
template <class F> struct OutFnT { F f; __device__ __forceinline__ bf16_t* operator()(const pg8::Unit& u, int& ld) const { return f(u, ld); } };
template <class F> __device__ __forceinline__ ep::EpiStore<OutFnT<F>> make_store(F f) { return ep::EpiStore<OutFnT<F>>{OutFnT<F>{f}}; }

__global__ void __launch_bounds__(512, 2) mk_fwd(Args a) {
    extern __shared__ __attribute__((aligned(16))) unsigned char lds_raw[];
    LAS unsigned char* lds = (LAS unsigned char*)lds_raw;
    const int tid = threadIdx.x, lane = tid & 63, wave = __builtin_amdgcn_readfirstlane(tid >> 6);
    const int G = gridDim.x, bx = blockIdx.x, vcu = (G % 8 == 0) ? (bx % 8) * (G / 8) + bx / 8 : bx;
    unsigned char* ws = a.ws; float* out = a.out;
    unsigned* ctl = (unsigned*)(ws + WS_CTL);
    for (int u = tid; u < (LDS_BYTES - LDSCTL_OFF) / 4; u += 512) ((LAS unsigned*)(lds + LDSCTL_OFF))[u] = 0u;
    __syncthreads();
    XcdBarrier bar = xcd_barrier_post(ctl + CW_BAR, (volatile LAS unsigned*)(lds + LDSCTL_OFF));
    int ph = 0;
#ifndef MK_MASK
#define MK_MASK 0xffff
#endif
#define PHASE_BEGIN(id) if (ph++ >= a.ph_hi) return; if ((MK_MASK >> (id)) & 1)
#define GRID_BAR xcd_barrier(bar)
    float* sqb = (float*)ctl + CW_SQ;
#define SQ(l, id) (sqb + (size_t)((l) * SQ_PER_LAYER + (id)) * T)
    bf16_t* hb = (bf16_t*)(ws + WS_HB); bf16_t* assm = (bf16_t*)(ws + WS_ASSM); const float* cs = (const float*)(ws + WS_CS);
    unsigned char* ra = ws + WS_RA;
    pg8::StaticOrder SO;
    const long NEVER = 1 << 30;

#ifndef MK_REP_PRO
#define MK_REP_PRO 1
#define MK_REP_PARTS 7
#define MK_REP_ATTN 1
#define MK_REP_P9 1
#endif
    PHASE_BEGIN(0) { for (int rep = 0; rep < MK_REP_PRO; ++rep) prologue(a.in, a.fr, ws, lds, vcu, G, rep ? MK_REP_PARTS : 7); } GRID_BAR;
    PHASE_BEGIN(1) {
        const char* A0 = (const char*)(ra + RA_MEMN); const char* B0 = (const char*)(ws + WS_WXKV); bf16_t* kvm = (bf16_t*)(ra + RA_KVM);
        SO.init(8, 16, G, bx);
        auto PN = make_panel([=](const pg8::Unit& u, const char*& pa, const char*& pb) { pa = A0 + (size_t)u.pm * 256 * 1024 * 2; pb = B0 + (size_t)u.pn * 256 * 1024 * 2; });
        auto E = make_store([=](const pg8::Unit& u, int& ld) -> bf16_t* { ld = 2048; return kvm + ((size_t)(u.pn >> 3) * 2048 + u.pm * 256) * 2048 + (u.pn & 7) * 256; });
        pg8::gemm_phase(lds, pg8::GemmArgs{1024, 1024, 1024, (int)NEVER, 0}, SO, PN, E);
    } GRID_BAR;
    PHASE_BEGIN(2) {
        const char* kvm = (const char*)(ra + RA_KVM); bf16_t* wkvw = (bf16_t*)(ws + WS_WKVW);
        { SO.init(64, 4, G, bx);
          const char* wx = (const char*)(ws + WS_W + WL_XQ);
          auto PN = make_panel([=](const pg8::Unit& u, const char*& pa, const char*& pb) { const int l = u.pm >> 5, b = (u.pm >> 2) & 7, h = u.pm & 3;
              pa = kvm + (((size_t)l * 2048 + b * 256) * 2048 + h * 256) * 2; pb = wx + (size_t)l * WL_STRIDE + ((size_t)u.pn * 256 * 1024 + h * 256) * 2; });
          auto E = make_store([=](const pg8::Unit& u, int& ld) -> bf16_t* { const int l = u.pm >> 5, b = (u.pm >> 2) & 7, h = u.pm & 3; ld = 1024;
              return wkvw + ((size_t)(l * 16 + b) << 20) + (size_t)(h * 256) * 1024 + u.pn * 256; });
          pg8::gemm_phase(lds, pg8::GemmArgs{256, 2048, 1024, (int)NEVER, 0}, SO, PN, E); }
        { SO.init(256, 1, G, bx);
          const char* wo = (const char*)(ws + WS_WXO);
          auto PN = make_panel([=](const pg8::Unit& u, const char*& pa, const char*& pb) { const int rt = u.pm & 3, h = (u.pm >> 2) & 3, b = (u.pm >> 4) & 7, l = u.pm >> 7;
              pa = wo + (((size_t)l * 1024 + rt * 256) * 1024 + h * 256) * 2; pb = kvm + (((size_t)l * 2048 + b * 256) * 2048 + 1024 + h * 256) * 2; });
          auto E = make_store([=](const pg8::Unit& u, int& ld) -> bf16_t* { const int rt = u.pm & 3, h = (u.pm >> 2) & 3, b = (u.pm >> 4) & 7, l = u.pm >> 7; ld = 1024;
              return wkvw + ((size_t)(l * 16 + 8 + b) << 20) + (size_t)(rt * 256) * 1024 + h * 256; });
          pg8::gemm_phase(lds, pg8::GemmArgs{256, 1024, 2048, (int)NEVER, 0}, SO, PN, E); }
    } GRID_BAR;

    for (int l = 0; l < NL; ++l) {
        const char* wl = (const char*)(ws + WS_W + (size_t)l * WL_STRIDE);
        PHASE_BEGIN(3) {
            SO.init(128, 4, G, bx);
            auto PN = make_panel([=](const pg8::Unit& u, const char*& pa, const char*& pb) { pa = (const char*)hb + (size_t)u.pm * 256 * 1024 * 2; pb = wl + WL_IN + (size_t)u.pn * 256 * 1024 * 2; });
            ep::EpiProj E{SQ(l, SQ_MIX), SQ(l, SQ_CQ), SQ(l, SQ_CKV), (bf16_t*)(ra + RA_PROJB), assm, ra + RA_K, cs};
            pg8::gemm_phase(lds, pg8::GemmArgs{1024, 1024, 1024, (int)NEVER, 0}, SO, PN, E);
        } GRID_BAR;
        PHASE_BEGIN(4) {
            const char* pj = (const char*)(ra + RA_PROJB);
            { SO.init(128, 3, G, bx);
              auto PN = make_panel([=](const pg8::Unit& u, const char*& pa, const char*& pb) { pa = pj + (size_t)u.pm * 256 * 512 * 2; pb = wl + WL_UP + (size_t)u.pn * 256 * 256 * 2; });
              ep::EpiQ E{SQ(l, SQ_CQ), (bf16_t*)(ra + RA_Q), cs};
              pg8::gemm_phase(lds, pg8::GemmArgs{256, 512, 256, (int)NEVER, 0}, SO, PN, E); }
            { SO.init(128, 4, G, bx);
              auto PN = make_panel([=](const pg8::Unit& u, const char*& pa, const char*& pb) { pa = pj + (size_t)u.pm * 256 * 512 * 2 + 512; pb = wl + WL_UP + (size_t)(u.pn + 3) * 256 * 256 * 2; });
              ep::EpiKV E{SQ(l, SQ_CKV), ra + RA_K, ra + RA_V};
              pg8::gemm_phase(lds, pg8::GemmArgs{256, 512, 256, (int)NEVER, 0}, SO, PN, E); }
            { SO.init(128, 1, G, (bx + G / 2) % G);
              const char* bt = (const char*)(ws + WS_SSM) + (size_t)l * 32 * SSM_G_STRIDE;
              auto PN = make_panel([=](const pg8::Unit& u, const char*& pa, const char*& pb) { pa = (const char*)assm + (size_t)u.pm * 256 * KS3 * 2; pb = bt + (size_t)(u.pm >> 2) * SSM_G_STRIDE; });
              ep::EpiXloc E{(float*)(ra + RA_XLOC)};
              pg8::gemm_phase(lds, pg8::GemmArgs{KS1, KS3, KS1, (int)NEVER, 0}, SO, PN, E); }
        } GRID_BAR;
        PHASE_BEGIN(5) {
            ssm_scan_phase(vcu, G, (const float*)(ra + RA_XLOC), (const float*)(ws + WS_AL) + (size_t)l * 32 * 64 * 2, assm);
            for (int rep = 0; rep < MK_REP_ATTN; ++rep) att::attn_phase(vcu, G, (const bf16_t*)(ra + RA_Q), ra + RA_K, ra + RA_V, (bf16_t*)(ra + RA_AO), rep ? SQ(2, 1) : SQ(l, SQ_A), lds);
        } GRID_BAR;
        PHASE_BEGIN(6) {
            SO.init(128, 2, G, bx);
            const char* bt = (const char*)(ws + WS_SSM) + (size_t)l * 32 * SSM_G_STRIDE + SSM_BT3_OFF;
            auto PN = make_panel([=](const pg8::Unit& u, const char*& pa, const char*& pb) { pa = (const char*)assm + (size_t)u.pm * 256 * KS3 * 2; pb = bt + (size_t)(u.pm >> 2) * SSM_G_STRIDE + (size_t)u.pn * 256 * KS3 * 2; });
            ep::EpiY E{(bf16_t*)(ra + RA_Y), (bf16_t*)(ra + RA_G)};
            pg8::gemm_phase(lds, pg8::GemmArgs{KS3, KS3, KS3, (int)NEVER, 0}, SO, PN, E);
        } GRID_BAR;
        PHASE_BEGIN(7) {
            SO.init(128, 2, G, bx);
            const char* gb = (const char*)(ra + RA_G);
            auto PN = make_panel([=](const pg8::Unit& u, const char*& pa, const char*& pb) { pa = gb + (size_t)u.pm * 256 * 512 * 2; pb = wl + WL_GLU + (size_t)u.pn * 256 * 512 * 2; });
            ep::EpiGlu E{(const bf16_t*)(ra + RA_Y), a.in.b_glu + l * 512, (bf16_t*)(ra + RA_SOUT), SQ(l, SQ_S)};
            pg8::gemm_phase(lds, pg8::GemmArgs{512, 512, 512, (int)NEVER, 0}, SO, PN, E);
        } GRID_BAR;
        PHASE_BEGIN(8) {
            SO.init(128, 4, G, bx);
            const char* ao = (const char*)(ra + RA_AO);
            auto PN = make_panel([=](const pg8::Unit& u, const char*& pa, const char*& pb) { pa = ao + (size_t)u.pm * 256 * 512 * 2; pb = wl + WL_OUT + (size_t)u.pn * 256 * 1024 * 2; });
            ep::EpiRes<true> E{l == 0 ? a.in.x : nullptr, nullptr, hb, SQ(l, SQ_X), SQ(l, SQ_A), SQ(l, SQ_S)};
            pg8::gemm_phase(lds, pg8::GemmArgs{1024, 512, 1024, 8, (long)(RA_SOUT - RA_AO) - 8 * 128}, SO, PN, E);
        } GRID_BAR;
        PHASE_BEGIN(9) {
            SO.init(128, 4, G, bx);
            const char* wk = (const char*)(ws + WS_WKVW) + ((size_t)(l * 16) << 21);
            auto PN = make_panel([=](const pg8::Unit& u, const char*& pa, const char*& pb) { pa = (const char*)hb + (size_t)u.pm * 256 * 1024 * 2; pb = wk + ((size_t)(u.pm >> 4) << 21) + (size_t)u.pn * 256 * 1024 * 2; });
            ep::EpiSoftmax E{SQ(l, SQ_X), (bf16_t*)(ra + RA_P)};
            pg8::gemm_phase(lds, pg8::GemmArgs{1024, 1024, 1024, (int)NEVER, 0}, SO, PN, E);
        } GRID_BAR;
        PHASE_BEGIN(10) {
            SO.init(128, 4, G, bx);
            const char* vw = (const char*)(ws + WS_WKVW) + ((size_t)(l * 16 + 8) << 21); const char* pp = (const char*)(ra + RA_P);
            auto PN = make_panel([=](const pg8::Unit& u, const char*& pa, const char*& pb) { pa = pp + (size_t)u.pm * 256 * 1024 * 2; pb = vw + ((size_t)(u.pm >> 4) << 21) + (size_t)u.pn * 256 * 1024 * 2; });
            ep::EpiRes<false> E{nullptr, nullptr, hb, SQ(l, SQ_FFN), nullptr, nullptr};
            pg8::gemm_phase(lds, pg8::GemmArgs{1024, 1024, 1024, (int)NEVER, 0}, SO, PN, E);
        } GRID_BAR;
        PHASE_BEGIN(11) {
            SO.init(128, 22, G, bx);
            auto PN = make_panel([=](const pg8::Unit& u, const char*& pa, const char*& pb) { pa = (const char*)hb + (size_t)u.pm * 256 * 1024 * 2; pb = wl + WL_GU + (size_t)u.pn * 256 * 1024 * 2; });
            ep::EpiSwiglu E{SQ(l, SQ_FFN), (bf16_t*)(ra + RA_HID)};
            for (int rep = 0; rep < MK_REP_P9; ++rep) pg8::gemm_phase(lds, pg8::GemmArgs{1024, 1024, 1024, (int)NEVER, 0}, SO, PN, E);
        } GRID_BAR;
        PHASE_BEGIN(12) {
            SO.init(128, 4, G, bx);
            const char* hd = (const char*)(ra + RA_HID);
            auto PN = make_panel([=](const pg8::Unit& u, const char*& pa, const char*& pb) { pa = hd + (size_t)u.pm * 256 * FF * 2; pb = wl + WL_DN + (size_t)u.pn * 256 * FF * 2; });
            ep::EpiRes<false> E{nullptr, l == NL - 1 ? out : nullptr, hb, SQ(l + 1, SQ_MIX), nullptr, nullptr};
            pg8::gemm_phase(lds, pg8::GemmArgs{FF, FF, FF, (int)NEVER, 0}, SO, PN, E);
        } GRID_BAR;
    }
    PHASE_BEGIN(13) {
        const float* sqf = SQ(NL, SQ_MIX); const float* gf = a.in.final_g;
        for (int r = vcu * 8 + wave; r < T; r += G * 8) { const float rs = rstd_of(sqf[r], 1.0f / 1024.0f); f32x4* orow = (f32x4*)(out + (size_t)r * D) + lane; const f32x4* gr = (const f32x4*)gf + lane;
#pragma unroll
            for (int j = 0; j < 4; ++j) orow[64 * j] = orow[64 * j] * rs * gr[64 * j]; }
    }
#undef PHASE_BEGIN
#undef GRID_BAR
#undef SQ
}

extern "C" void kernel_launch(void* const* d_in, const int* in_sizes, int n_in, void* d_out, int out_size, void* d_ws, size_t ws_size, hipStream_t stream) {
    static int grid = 0;
    if (grid == 0) {
        if (n_in != 32 || out_size != T * D || ws_size < WS_END) { fprintf(stderr, "kernel_launch: unexpected shapes (n_in %d out %d ws %zu)\n", n_in, out_size, ws_size); grid = -1; return; }
        int dev = 0, cus = 0, per_cu = 0;
        if (hipGetDevice(&dev) != hipSuccess || hipDeviceGetAttribute(&cus, hipDeviceAttributeMultiprocessorCount, dev) != hipSuccess) { grid = -1; return; }
        if (hipFuncSetAttribute((const void*)mk_fwd, hipFuncAttributeMaxDynamicSharedMemorySize, LDS_BYTES) != hipSuccess) { fprintf(stderr, "kernel_launch: hipFuncSetAttribute failed\n"); grid = -1; return; }
        if (hipOccupancyMaxActiveBlocksPerMultiprocessor(&per_cu, (const void*)mk_fwd, 512, LDS_BYTES) != hipSuccess || per_cu < 1) { fprintf(stderr, "kernel_launch: occupancy query says %d\n", per_cu); per_cu = 1; }
        (void)hipGetLastError();
        grid = cus;
    }
    if (grid < 0) return;
    if (hipMemsetAsync((char*)d_ws + WS_CTL, 0, CTL_ZERO_BYTES, stream) != hipSuccess) return;
    Args a{};
    const void** ip = (const void**)&a.in;
    for (int i = 0; i < 32; ++i) ip[i] = d_in[i];
    a.out = (float*)d_out; a.ws = (unsigned char*)d_ws;
    for (int i = 0; i < 16; ++i) a.fr.f[i] = std::pow(10000.0, -(double)i / 16.0);
#ifndef MK_PH_HI
#define MK_PH_HI 1000
#endif
    a.ph_hi = MK_PH_HI; a.pad = 0;
    void* args[] = {&a};
    hipError_t e = hipLaunchCooperativeKernel((const void*)mk_fwd, dim3(grid), dim3(512), args, LDS_BYTES, stream);
    if (e != hipSuccess) fprintf(stderr, "kernel_launch: cooperative launch failed: %s (grid %d)\n", hipGetErrorString(e), grid);
}
```

```cpp
#include <hip/hip_runtime.h>
#include <hip/hip_bf16.h>
#include <cstdint>
#include <cstdio>
#include <cmath>

#define LAS __attribute__((address_space(3)))
typedef unsigned short bf16_t;
typedef short bf16x8 __attribute__((ext_vector_type(8)));
typedef short s16x4 __attribute__((ext_vector_type(4)));
typedef float f32x4 __attribute__((ext_vector_type(4)));
typedef float f32x2 __attribute__((ext_vector_type(2)));
typedef float f32x16 __attribute__((ext_vector_type(16)));
typedef unsigned u32x4 __attribute__((ext_vector_type(4)));
typedef unsigned u32x2 __attribute__((ext_vector_type(2)));

constexpr int D = 1024, NB = 8, S = 4096, T = NB * S, NL = 2, FF = 2816;
constexpr int NH = 8, QKD = 96, HD = 64;
constexpr int LC = 32, KS1 = 16 * LC  , KS3 = KS1 + 128  , NCHB = S / LC  , NCH = T / LC  ;
constexpr int MEMT = 256;
constexpr float EPS = 1e-6f;
constexpr float LOG2E = 1.4426950408889634f;

constexpr size_t MiB = 1u << 20;
constexpr size_t WS_CTL = 0, CTL_ZERO_BYTES = 4 * MiB;
constexpr size_t WS_CS = 4 * MiB;
constexpr size_t WS_W = 8 * MiB;
constexpr size_t WL_IN = 0, WL_UP = 2 * MiB, WL_GLU = 3 * MiB, WL_OUT = 3 * MiB + 512 * 1024, WL_XQ = 5 * MiB + 512 * 1024, WL_GU = 7 * MiB + 512 * 1024, WL_DN = 18 * MiB + 512 * 1024, WL_STRIDE = 24 * MiB + 512 * 1024;
constexpr size_t WS_WXKV = WS_W + 2 * WL_STRIDE;
constexpr size_t WS_WXO = WS_WXKV + 8 * MiB;
constexpr size_t WS_SSM = 70 * MiB;
constexpr size_t SSM_G_STRIDE = 896 * 1024, SSM_BT3_OFF = 256 * 1024;
constexpr size_t WS_AL = 126 * MiB;
constexpr size_t WS_WKVW = 128 * MiB;
constexpr size_t WS_HB = 192 * MiB;
constexpr size_t WS_ASSM = 256 * MiB;
constexpr size_t WS_RA = 296 * MiB;
constexpr size_t WS_END = WS_RA + 176 * MiB;
constexpr size_t RA_PROJB = 0, RA_AO = 0, RA_Q = 32 * MiB, RA_K = 80 * MiB, RA_V = 128 * MiB, RA_XLOC = 160 * MiB;
constexpr size_t RA_Y = 32 * MiB, RA_G = 64 * MiB, RA_SOUT = 96 * MiB;
constexpr size_t RA_P = 0, RA_HID = 0, RA_MEMN = 0, RA_KVM = 4 * MiB;
constexpr int CW_BAR = 4096;
constexpr int CW_SQ = 65536;
enum SqId { SQ_MIX = 0, SQ_CQ = 1, SQ_CKV = 2, SQ_A = 3, SQ_S = 4, SQ_X = 5, SQ_FFN = 6, SQ_PER_LAYER = 7 };
static_assert((size_t)(CW_SQ + 16 * T) * 4 <= CTL_ZERO_BYTES, "ctl");

constexpr int RING_BYTES = 131072, XCH_OFF = RING_BYTES  , LDSCTL_OFF = XCH_OFF + 12288, LDS_BYTES = 147456;

__device__ __forceinline__ unsigned cvt_pk_bf16(float lo, float hi) { typedef __bf16 bf2 __attribute__((ext_vector_type(2))); f32x2 v = {lo, hi}; bf2 b = __builtin_convertvector(v, bf2); return __builtin_bit_cast(unsigned, b); }
__device__ __forceinline__ float bf_lo(unsigned w) { return __uint_as_float(w << 16); }
__device__ __forceinline__ float bf_hi(unsigned w) { return __uint_as_float(w & 0xffff0000u); }
__device__ __forceinline__ float rstd_of(float sq, float inv_n) { return rsqrtf(sq * inv_n + EPS); }

#define XB_TMO      128
#define XB_XCNT(j)  (256  + 64 * (j))
#define XB_XSUB(j)  (1280 + 64 * (j))
#define XB_XGEN(j)  (2304 + 64 * (j))
#define XB_TOP      3328
#define XB_TOPGEN   3392
#define XCD_BAR_WORDS 3456
#define XB_SPIN_CAP (1u << 20)
__device__ __forceinline__ unsigned xb_ld(unsigned* p)              { return __hip_atomic_load(p, __ATOMIC_RELAXED, __HIP_MEMORY_SCOPE_AGENT); }
__device__ __forceinline__ unsigned xb_add(unsigned* p, unsigned v) { return __hip_atomic_fetch_add(p, v, __ATOMIC_RELAXED, __HIP_MEMORY_SCOPE_AGENT); }
__device__ __forceinline__ unsigned xb_xcc_id() { return (unsigned)__builtin_amdgcn_s_getreg((3 << 11) | 20) & 0xFu; }
#define XB_SPIN(cond, bar) do { unsigned _sp = 0; while (cond) { __builtin_amdgcn_s_sleep(1); \
    if ((++_sp & 255u) == 0u) { if (xb_ld(&(bar)[XB_TMO])) break; if (_sp > XB_SPIN_CAP) { atomicAdd(&(bar)[XB_TMO], 1u); break; } } } } while (0)
struct XcdBarrier { unsigned* bar; unsigned x; volatile LAS unsigned* st; };
__device__ __forceinline__ XcdBarrier xcd_barrier_post(unsigned* bar, volatile LAS unsigned* st) {
    XcdBarrier b; b.bar = bar; b.x = xb_xcc_id(); b.st = st;
    if (threadIdx.x == 0) (void)xb_add(&bar[XB_XCNT(b.x)], 1u);
    return b;
}
__device__ __forceinline__ void xcd_barrier_complete(unsigned* bar, unsigned x, unsigned& nloc, unsigned& nx) {
    const unsigned G = gridDim.x * gridDim.y * gridDim.z;
    unsigned sum, cnt, mine, sp = 0u;
    for (;;) {
        sum = 0u; cnt = 0u; mine = 0u;
#pragma unroll
        for (unsigned j = 0; j < 16; ++j) { const unsigned c = xb_ld(&bar[XB_XCNT(j)]); sum += c; cnt += (c > 0u) ? 1u : 0u; mine = (j == x) ? c : mine; }
        if (sum == G) break;
        __builtin_amdgcn_s_sleep(1);
        if ((++sp & 255u) == 0u) { if (xb_ld(&bar[XB_TMO])) break; if (sp > XB_SPIN_CAP) { atomicAdd(&bar[XB_TMO], 1u); break; } }
    }
    nloc = mine > 0u ? mine : 1u; nx = cnt > 0u ? cnt : 1u;
}
__device__ __forceinline__ void xcd_barrier(const XcdBarrier& b) {
    asm volatile("s_waitcnt vmcnt(0)" ::: "memory");
    __syncthreads();
    if (threadIdx.x == 0) {
        unsigned* bar = b.bar; asm volatile("" : "+s"(bar));
        __builtin_amdgcn_s_waitcnt(0);
        unsigned nloc = b.st[0], nx = b.st[1];
        if (nloc == 0u) { xcd_barrier_complete(bar, b.x, nloc, nx); b.st[0] = nloc; b.st[1] = nx; }
        const unsigned old = xb_add(&bar[XB_XSUB(b.x)], 1u);
        const unsigned gen = old / nloc;
        if (old + 1u == (gen + 1u) * nloc) {
            __builtin_amdgcn_fence(__ATOMIC_RELEASE, "agent");
            asm volatile("s_waitcnt vmcnt(0)" ::: "memory");
            const unsigned og = xb_add(&bar[XB_TOP], 1u);
            const unsigned tg = og / nx;
            if (og + 1u == (tg + 1u) * nx) xb_add(&bar[XB_TOPGEN], 1u);
            else XB_SPIN(xb_ld(&bar[XB_TOPGEN]) == tg, bar);
            __builtin_amdgcn_fence(__ATOMIC_ACQUIRE, "agent");
            xb_add(&bar[XB_XGEN(b.x)], 1u);
            asm volatile("s_waitcnt vmcnt(0)" ::: "memory");
        } else {
            XB_SPIN(xb_ld(&bar[XB_XGEN(b.x)]) == gen, bar);
            __builtin_amdgcn_fence(__ATOMIC_ACQUIRE, "agent");
            asm volatile("s_waitcnt vmcnt(0)" ::: "memory");
        }
    }
    __syncthreads();
}

namespace pg8 {
constexpr int BM = 256, BK = 64, HALF = 128, HTB = HALF * BK * 2, STAGE_BYTES = 8 * HTB, NXCD = 8, WGM = 8;
__host__ __device__ __forceinline__ int lds_byte(int r, int c) { const int st = (r >> 4) * 2 + (c >> 5), rr = r & 15, cc = c & 31, ob = rr * 64 + cc * 2; return st * 1024 + (ob ^ (((ob >> 9) & 1) << 5)); }
__host__ __device__ __forceinline__ void stage_rc(int b, int& R, int& C) { const int st = b / 1024, sb = b % 1024, swz = sb ^ (((sb >> 9) & 1) << 5); R = (st >> 1) * 16 + swz / 64; C = (st & 1) * 32 + (swz % 64) / 2; }
__host__ __device__ __forceinline__ int perm32(int rho) { const int n = rho >> 4, i = rho & 15; return 8 * (i >> 2) + 4 * n + (i & 3); }
struct Unit { int pm, pn; };
struct StaticOrder {
    int nM, nN, nwg, G, c;
    __device__ void init(int nM_, int nN_, int G_, int c_) { nM = nM_; nN = nN_; nwg = nM * nN; G = G_; c = c_; }
    __device__ bool next(int i, Unit& u) const {
        const long L = (long)i * G + c; if (L >= nwg) return false;
        int wgid = (int)L; { const int q = nwg / NXCD, r = nwg % NXCD, xcd = wgid % NXCD, off = wgid / NXCD; wgid = (xcd < r ? xcd * (q + 1) : r * (q + 1) + (xcd - r) * q) + off; }
        const int nig = WGM * nN, gid = wgid / nig, fm = gid * WGM, gsz = (nM - fm) < WGM ? (nM - fm) : WGM;
        u.pm = fm + ((wgid % nig) % gsz); u.pn = (wgid % nig) / gsz; return true;
    }
};
struct Ctx { int wr, wc, fr, fq, wid, lane, tid; LAS unsigned char* lds; };
typedef f32x4 Acc[2][2][4][2];

struct GemmArgs { int K, lda, ldb, tsplit; long a_delta; };

template <class Epi, class Panel>
__device__ __forceinline__ void gemm_phase(LAS unsigned char* lds, const GemmArgs g, const StaticOrder& S, const Panel& PN, const Epi& E) {
    int tid_ = threadIdx.x; asm volatile("" : "+v"(tid_));
    const int tid = tid_, wid = __builtin_amdgcn_readfirstlane(tid >> 6), lane = tid & 63, wr = wid >> 2, wc = wid & 3, fr = lane & 15, fq = lane >> 4;
    const int nt = g.K / BK;
    Ctx cx{wr, wc, fr, fq, wid, lane, tid, lds};
    unsigned voffA[2], voffB[2];
#pragma unroll
    for (int i = 0; i < 2; ++i) { int R, C; stage_rc(tid * 16 + i * 8192, R, C); const int Rb = (R & ~31) + perm32(R & 31);
        voffA[i] = (unsigned)(R * g.lda + C) * 2u; voffB[i] = (unsigned)(Rb * g.ldb + C) * 2u; }
    const size_t kstep = (size_t)(BK * 2);
    const size_t hstepA = (size_t)HALF * g.lda * 2, hstepB = (size_t)HALF * g.ldb * 2;
    const unsigned ldsw = (unsigned)wid * 1024u;
    const int aoff = lds_byte(wr * 64 + fr, fq * 8), boff = lds_byte(wc * 32 + fr, fq * 8);
#define PG8_SA(b, h) (((b) * 2 + (h)) * HTB)
#define PG8_SB(b, h) ((4 + (b) * 2 + (h)) * HTB)
#define PG8_STAGE(bufoff, gbase, voff) do { _Pragma("unroll") for (int _i = 0; _i < 2; ++_i) \
        __builtin_amdgcn_global_load_lds((const unsigned*)((const char*)(gbase) + (voff)[_i]), (LAS unsigned*)(lds + (bufoff) + ldsw + _i * 8192), 16, 0, 0); } while (0)
#define PG8_LDA(dst, b, h) do { _Pragma("unroll") for (int m = 0; m < 4; ++m) _Pragma("unroll") for (int k = 0; k < 2; ++k) dst[m][k] = *(const LAS bf16x8*)(lds + PG8_SA(b, h) + aoff + m * 2048 + k * 1024); } while (0)
#define PG8_LDB(dst, b, h) do { _Pragma("unroll") for (int n = 0; n < 2; ++n) _Pragma("unroll") for (int k = 0; k < 2; ++k) dst[n][k] = *(const LAS bf16x8*)(lds + PG8_SB(b, h) + boff + n * 2048 + k * 1024); } while (0)
#define PG8_MMA(ai, bj, At, Bt) do { __builtin_amdgcn_s_setprio(1); _Pragma("unroll") for (int m = 0; m < 4; ++m) _Pragma("unroll") for (int n = 0; n < 2; ++n) _Pragma("unroll") for (int k = 0; k < 2; ++k) \
        acc[ai][bj][m][n] = __builtin_amdgcn_mfma_f32_16x16x32_bf16(Bt[n][k], At[m][k], acc[ai][bj][m][n], 0, 0, 0); __builtin_amdgcn_s_setprio(0); } while (0)
#define PG8_WAIT_V(n) asm volatile("s_waitcnt vmcnt(" #n ")" ::: "memory")
#define PG8_WAIT_L(n) asm volatile("s_waitcnt lgkmcnt(" #n ")" ::: "memory")
#define PG8_BAR __builtin_amdgcn_s_barrier()
#define PG8_SCHED __builtin_amdgcn_sched_barrier(0)
#define PG8_AP(base, tt) ((base) + (size_t)(tt) * kstep + (((tt) >= g.tsplit) ? g.a_delta : 0l))
    Unit cur, nxt; int ui = 0;
    if (!S.next(0, cur)) return;
    Acc acc;
#pragma unroll
    for (int a = 0; a < 2; ++a)
#pragma unroll
        for (int b = 0; b < 2; ++b)
#pragma unroll
            for (int m = 0; m < 4; ++m)
#pragma unroll
                for (int n = 0; n < 2; ++n) acc[a][b][m][n] = (f32x4){0.f, 0.f, 0.f, 0.f};
    bf16x8 At[4][2], B0[2][2], B1[2][2];
    const char* cA; const char* cB; PN(cur, cA, cB);
    if constexpr (Epi::HAS_BEGIN) E.begin(cur, cx, ui);
    PG8_STAGE(PG8_SB(0, 0), cB, voffB); PG8_STAGE(PG8_SB(0, 1), cB + hstepB, voffB); PG8_STAGE(PG8_SA(0, 0), cA, voffA); PG8_STAGE(PG8_SA(0, 1), cA + hstepA, voffA);
    if (wr == 1) PG8_BAR;
    PG8_WAIT_V(2); PG8_BAR;
    PG8_STAGE(PG8_SB(1, 0), cB + kstep, voffB); PG8_STAGE(PG8_SA(1, 0), cA + kstep, voffA); PG8_STAGE(PG8_SB(1, 1), cB + hstepB + kstep, voffB);
    PG8_WAIT_V(6); PG8_BAR;
    for (;;) {
        const bool has_next = S.next(ui + 1, nxt);
        const char* nA = cA; const char* nB = cB; if (has_next) PN(nxt, nA, nB);
#pragma unroll 1
        for (int t = 0; t < nt; t += 2) {
            const bool last = (t == nt - 2);
            if constexpr (Epi::HAS_MID) { if (t == g.tsplit) E.mid(acc, cur, cx, ui); }
            const char* a1 = PG8_AP(cA, t + 1);
            const char* a2 = last ? nA : PG8_AP(cA, t + 2); const char* b2 = last ? nB : cB + (size_t)(t + 2) * kstep;
            const char* a3 = last ? nA + kstep : PG8_AP(cA, t + 3); const char* b3 = b2 + kstep;
            PG8_LDB(B0, 0, 0); PG8_LDB(B1, 0, 1); PG8_SCHED; PG8_LDA(At, 0, 0); PG8_STAGE(PG8_SA(1, 1), a1 + hstepA, voffA);
            PG8_WAIT_V(8); PG8_WAIT_L(0); PG8_BAR; PG8_MMA(0, 0, At, B0); PG8_MMA(0, 1, At, B1); PG8_BAR; PG8_SCHED;
            PG8_LDA(At, 0, 1); PG8_STAGE(PG8_SB(0, 0), b2, voffB); PG8_STAGE(PG8_SB(0, 1), b2 + hstepB, voffB); PG8_STAGE(PG8_SA(0, 0), a2, voffA);
            PG8_WAIT_V(8); PG8_WAIT_L(0); PG8_BAR; PG8_MMA(1, 0, At, B0); PG8_MMA(1, 1, At, B1); PG8_BAR; PG8_SCHED;
            PG8_LDB(B0, 1, 0); PG8_LDB(B1, 1, 1); PG8_SCHED; PG8_LDA(At, 1, 0); PG8_STAGE(PG8_SA(0, 1), a2 + hstepA, voffA);
            PG8_WAIT_V(8); PG8_WAIT_L(0); PG8_BAR; PG8_MMA(0, 0, At, B0); PG8_MMA(0, 1, At, B1); PG8_BAR; PG8_SCHED;
            PG8_LDA(At, 1, 1); PG8_STAGE(PG8_SB(1, 0), b3, voffB); PG8_STAGE(PG8_SB(1, 1), b3 + hstepB, voffB); PG8_STAGE(PG8_SA(1, 0), a3, voffA);
            PG8_WAIT_V(8); PG8_WAIT_L(0); PG8_BAR; PG8_MMA(1, 0, At, B0); PG8_MMA(1, 1, At, B1); PG8_BAR; PG8_SCHED;
        }
        if (wr == 0) PG8_BAR;
        E(acc, cur, cx, ui);
        if (!has_next) break;
#pragma unroll
        for (int a = 0; a < 2; ++a)
#pragma unroll
            for (int b = 0; b < 2; ++b)
#pragma unroll
                for (int m = 0; m < 4; ++m)
#pragma unroll
                    for (int n = 0; n < 2; ++n) acc[a][b][m][n] = (f32x4){0.f, 0.f, 0.f, 0.f};
        cur = nxt; cA = nA; cB = nB; ++ui;
        if constexpr (Epi::HAS_BEGIN) E.begin(cur, cx, ui);
        if (wr == 1) PG8_BAR;
    }
    PG8_WAIT_V(0);
    PG8_BAR;
    asm volatile("" ::: "memory");
#undef PG8_SA
#undef PG8_SB
#undef PG8_STAGE
#undef PG8_LDA
#undef PG8_LDB
#undef PG8_MMA
#undef PG8_WAIT_V
#undef PG8_WAIT_L
#undef PG8_BAR
#undef PG8_SCHED
#undef PG8_AP
}
}
namespace ep {
using pg8::Acc; using pg8::Ctx; using pg8::Unit;
#define EP_FOR_ROWS _Pragma("unroll") for (int ai = 0; ai < 2; ++ai) _Pragma("unroll") for (int m = 0; m < 4; ++m)
#define EP_RU (ai * 128 + cx.wr * 64 + m * 16)
#define EP_FENCE asm volatile("" ::: "memory")
#define EP_PRELOAD_RS(name, sqp, invn) float name[2][4]; EP_FOR_ROWS name[ai][m] = (sqp)[u.pm * 256 + EP_RU + cx.fr]; EP_FOR_ROWS name[ai][m] = rstd_of(name[ai][m], invn);
__device__ __forceinline__ u32x4 pack8(const f32x4 a, const f32x4 b) { u32x4 w; w.x = cvt_pk_bf16(a[0], a[1]); w.y = cvt_pk_bf16(a[2], a[3]); w.z = cvt_pk_bf16(b[0], b[1]); w.w = cvt_pk_bf16(b[2], b[3]); return w; }
__device__ __forceinline__ float sq8(const f32x4 a, const f32x4 b) { return (a[0] * a[0] + a[1] * a[1]) + (a[2] * a[2] + a[3] * a[3]) + (b[0] * b[0] + b[1] * b[1]) + (b[2] * b[2] + b[3] * b[3]); }
__device__ __forceinline__ void row_atomic(float* sq_u, int fr, float ss, int fq) { ss += __shfl_xor(ss, 16); ss += __shfl_xor(ss, 32); if (fq == 0) unsafeAtomicAdd(sq_u + fr, ss); }
template <class TT> __device__ __forceinline__ TT* lane_ptr(TT* uni, unsigned lane_bytes) { return (TT*)((char*)uni + lane_bytes); }
template <class TT> __device__ __forceinline__ const TT* lane_ptr(const TT* uni, unsigned lane_bytes) { return (const TT*)((const char*)uni + lane_bytes); }
__device__ __forceinline__ void rope8(f32x4& a, f32x4& b, const f32x4 c4, const f32x4 s4) {
    const f32x4 a0 = a, b0 = b;
    a[0] = a0[0] * c4[0] - a0[1] * s4[0]; a[1] = a0[1] * c4[0] + a0[0] * s4[0]; a[2] = a0[2] * c4[1] - a0[3] * s4[1]; a[3] = a0[3] * c4[1] + a0[2] * s4[1];
    b[0] = b0[0] * c4[2] - b0[1] * s4[2]; b[1] = b0[1] * c4[2] + b0[0] * s4[2]; b[2] = b0[2] * c4[3] - b0[3] * s4[3]; b[3] = b0[3] * c4[3] + b0[2] * s4[3];
}
__device__ __forceinline__ size_t koff_u(int b, int h, int s16, int chunk) { return ((((size_t)(b * 8 + h) * 64 + (s16 >> 6)) * 12 + chunk) * 64 + (s16 & 63)) * 16; }
__device__ __forceinline__ size_t voff_u(int b, int h, int s16, int dh) { return ((((size_t)(b * 8 + h) * 64 + (s16 >> 6)) * 2 + dh) * 64 + (s16 & 63)) * 64; }

struct EpiProj {
    static constexpr bool HAS_MID = false, HAS_BEGIN = false;
    const float* sq_in; float* sq_cq; float* sq_ckv; bf16_t* projb; bf16_t* assm; unsigned char* kb; const float* cs;
    __device__ __forceinline__ void operator()(Acc& acc, const Unit& u, const Ctx& cx, int) const {
        const unsigned l_pj = (unsigned)(cx.fr * 512 + cx.fq * 8) * 2u, l_cs = (unsigned)(cx.fr * 32 + cx.fq * 4) * 4u, l_k = (unsigned)cx.fr * 16u, l_as = (unsigned)(cx.fr * 16) * 2u;
        EP_PRELOAD_RS(rsv, sq_in, 1.0f / 1024.0f)
        EP_FOR_ROWS { const int rowu = u.pm * 256 + EP_RU; const float rs = rsv[ai][m];
            if (u.pn == 0) { float ss = 0.f;
#pragma unroll
                for (int bj = 0; bj < 2; ++bj) { const f32x4 v0 = acc[ai][bj][m][0] * rs, v1 = acc[ai][bj][m][1] * rs; ss += sq8(v0, v1);
                    *(u32x4*)lane_ptr(projb + (size_t)rowu * 512 + bj * 128 + cx.wc * 32, l_pj) = pack8(v0, v1); }
                row_atomic(sq_cq + rowu, cx.fr, ss, cx.fq);
            } else if (u.pn == 1) {
                { const f32x4 v0 = acc[ai][0][m][0] * rs, v1 = acc[ai][0][m][1] * rs; *(u32x4*)lane_ptr(projb + (size_t)rowu * 512 + 256 + cx.wc * 32, l_pj) = pack8(v0, v1); row_atomic(sq_ckv + rowu, cx.fr, sq8(v0, v1), cx.fq); }
                f32x4 v0 = acc[ai][1][m][0] * rs, v1 = acc[ai][1][m][1] * rs;
                if (cx.wc != 0) { v0 = (f32x4){0.f, 0.f, 0.f, 0.f}; v1 = v0; }
                *(u32x4*)lane_ptr(projb + (size_t)rowu * 512 + 384 + cx.wc * 32, l_pj) = pack8(v0, v1);
                if (cx.wc == 0) { const float* cp = lane_ptr(cs + (size_t)rowu * 32, l_cs); const f32x4 c4 = *(const f32x4*)cp, s4 = *(const f32x4*)(cp + 16);
                    rope8(v0, v1, c4, s4); const u32x4 w = pack8(v0, v1); const int b = rowu >> 12, s16 = rowu & 4095;
#pragma unroll
                    for (int h = 0; h < 8; ++h) *(u32x4*)lane_ptr(kb + koff_u(b, h, s16, 8) , l_k + (unsigned)cx.fq * 1024u) = w; }
            } else {
#pragma unroll
                for (int bj = 0; bj < 2; ++bj) { const f32x4 v0 = acc[ai][bj][m][0] * rs, v1 = acc[ai][bj][m][1] * rs; const int chu = (u.pn - 2) * 256 + bj * 128 + cx.wc * 32;
                    *(u32x4*)lane_ptr(assm + ((size_t)(chu >> 4) * NCH + (rowu >> 5)) * KS3 + (rowu & 31) * 16, l_as + (unsigned)(cx.fq >> 1) * (unsigned)(NCH * KS3 * 2) + (unsigned)(cx.fq & 1) * 16u) = pack8(v0, v1); }
            }
            EP_FENCE;
        }
    }
};
struct EpiQ {
    static constexpr bool HAS_MID = false, HAS_BEGIN = false;
    const float* sq_cq; bf16_t* qb; const float* cs;
    __device__ __forceinline__ void operator()(Acc& acc, const Unit& u, const Ctx& cx, int) const {
        const unsigned l_q = (unsigned)(cx.fr * 768 + cx.fq * 8) * 2u, l_cs = (unsigned)(cx.fr * 32 + cx.fq * 4) * 4u;
        EP_PRELOAD_RS(rsv, sq_cq, 1.0f / 256.0f)
        EP_FOR_ROWS { const int rowu = u.pm * 256 + EP_RU; const float rs = rsv[ai][m];
            f32x4 c4 = (f32x4){1.f, 1.f, 1.f, 1.f}, s4 = (f32x4){0.f, 0.f, 0.f, 0.f}; if (u.pn == 2) { const float* cp = lane_ptr(cs + (size_t)rowu * 32, l_cs); c4 = *(const f32x4*)cp; s4 = *(const f32x4*)(cp + 16); }
#pragma unroll
            for (int bj = 0; bj < 2; ++bj) { f32x4 v0 = acc[ai][bj][m][0] * rs, v1 = acc[ai][bj][m][1] * rs;
                if (u.pn == 2) rope8(v0, v1, c4, s4);
                *(u32x4*)lane_ptr(qb + (size_t)rowu * 768 + u.pn * 256 + bj * 128 + cx.wc * 32, l_q) = pack8(v0, v1); }
            EP_FENCE; }
    }
};
struct EpiKV {
    static constexpr bool HAS_MID = false, HAS_BEGIN = false;
    const float* sq_ckv; unsigned char* kb; unsigned char* vb;
    __device__ __forceinline__ void operator()(Acc& acc, const Unit& u, const Ctx& cx, int) const {
        const unsigned l_kv = (cx.wc < 2) ? (unsigned)cx.fr * 16u + (unsigned)cx.fq * 1024u : (unsigned)cx.fr * 64u + (unsigned)cx.fq * 16u;
        EP_PRELOAD_RS(rsv, sq_ckv, 1.0f / 128.0f)
        EP_FOR_ROWS { const int rowu = u.pm * 256 + EP_RU; const float rs = rsv[ai][m]; const int b = rowu >> 12, s16 = rowu & 4095;
#pragma unroll
            for (int bj = 0; bj < 2; ++bj) { const f32x4 v0 = acc[ai][bj][m][0] * rs, v1 = acc[ai][bj][m][1] * rs; const int h = 2 * u.pn + bj;
                unsigned char* dst = (cx.wc < 2) ? kb + koff_u(b, h, s16, cx.wc * 4) : vb + voff_u(b, h, s16, cx.wc - 2);
                *(u32x4*)lane_ptr(dst, l_kv) = pack8(v0, v1); }
            EP_FENCE; }
    }
};
struct EpiXloc {
    static constexpr bool HAS_MID = false, HAS_BEGIN = false;
    float* xloc;
    __device__ __forceinline__ void operator()(Acc& acc, const Unit& u, const Ctx& cx, int) const {
        const unsigned l_x = (unsigned)(cx.fr * 128 + cx.fq * 8) * 4u;
        EP_FOR_ROWS { const int rowu = u.pm * 256 + EP_RU; float* o = lane_ptr(xloc + (size_t)rowu * 128 + cx.wc * 32, l_x); *(f32x4*)o = acc[ai][0][m][0]; *(f32x4*)(o + 4) = acc[ai][0][m][1]; EP_FENCE; }
    }
};
__device__ __forceinline__ float gelu_tanh_f(float x) { const float z = 0.7978845608028654f * (x + 0.044715f * x * x * x); return x * __builtin_amdgcn_rcpf(1.0f + __builtin_amdgcn_exp2f(-2.0f * LOG2E * z)); }
__device__ __forceinline__ f32x4 gelu4(const f32x4 v) { return (f32x4){gelu_tanh_f(v[0]), gelu_tanh_f(v[1]), gelu_tanh_f(v[2]), gelu_tanh_f(v[3])}; }
struct EpiY {
    static constexpr bool HAS_MID = false, HAS_BEGIN = false;
    bf16_t* yb; bf16_t* gb;
    __device__ __forceinline__ void operator()(Acc& acc, const Unit& u, const Ctx& cx, int) const {
        const unsigned l_y = (unsigned)((cx.fr * 32 + (cx.fq >> 1)) * 512 + (cx.fq & 1) * 8) * 2u;
        EP_FOR_ROWS { const int rowu = u.pm * 256 + EP_RU, g = rowu >> 10, chunku = rowu & 1023;
#pragma unroll
            for (int bj = 0; bj < 2; ++bj) { const int colu = u.pn * 256 + bj * 128 + cx.wc * 32; const size_t o = ((size_t)chunku * 32 + (colu >> 4)) * 512 + g * 16;
                const f32x4 v0 = acc[ai][bj][m][0], v1 = acc[ai][bj][m][1]; *(u32x4*)lane_ptr(yb + o, l_y) = pack8(v0, v1); *(u32x4*)lane_ptr(gb + o, l_y) = pack8(gelu4(v0), gelu4(v1)); }
            EP_FENCE;
        }
    }
};
__device__ __forceinline__ float sigm(float z) { return __builtin_amdgcn_rcpf(1.0f + __builtin_amdgcn_exp2f(-LOG2E * z)); }
struct EpiGlu {
    static constexpr bool HAS_MID = false, HAS_BEGIN = false;
    const bf16_t* yb; const float* bglu; bf16_t* sout; float* sq_s;
    __device__ __forceinline__ void operator()(Acc& acc, const Unit& u, const Ctx& cx, int) const {
        const unsigned l_y = (unsigned)(cx.fr * 512 + cx.fq * 8) * 2u, l_b = (unsigned)(cx.fq * 8) * 4u;
        f32x4 bv[2][2];
#pragma unroll
        for (int bj = 0; bj < 2; ++bj) { const float* bp = lane_ptr(bglu + u.pn * 256 + bj * 128 + cx.wc * 32, l_b); bv[bj][0] = *(const f32x4*)bp; bv[bj][1] = *(const f32x4*)(bp + 4); }
#pragma unroll
        for (int ai = 0; ai < 2; ++ai) { u32x4 yw[4][2];
#pragma unroll
            for (int m = 0; m < 4; ++m)
#pragma unroll
                for (int bj = 0; bj < 2; ++bj) yw[m][bj] = *(const u32x4*)lane_ptr(yb + (size_t)(u.pm * 256 + EP_RU) * 512 + u.pn * 256 + bj * 128 + cx.wc * 32, l_y);
#pragma unroll
            for (int m = 0; m < 4; ++m) { const int rowu = u.pm * 256 + EP_RU; float ss = 0.f;
#pragma unroll
                for (int bj = 0; bj < 2; ++bj) { const int colu = u.pn * 256 + bj * 128 + cx.wc * 32; const u32x4 w = yw[m][bj];
                    const f32x4 z0 = acc[ai][bj][m][0] + bv[bj][0], z1 = acc[ai][bj][m][1] + bv[bj][1];
                    const f32x4 v0 = (f32x4){bf_lo(w.x) * sigm(z0[0]), bf_hi(w.x) * sigm(z0[1]), bf_lo(w.y) * sigm(z0[2]), bf_hi(w.y) * sigm(z0[3])};
                    const f32x4 v1 = (f32x4){bf_lo(w.z) * sigm(z1[0]), bf_hi(w.z) * sigm(z1[1]), bf_lo(w.w) * sigm(z1[2]), bf_hi(w.w) * sigm(z1[3])};
                    ss += sq8(v0, v1); *(u32x4*)lane_ptr(sout + (size_t)rowu * 512 + colu, l_y) = pack8(v0, v1); }
                row_atomic(sq_s + rowu, cx.fr, ss, cx.fq); }
            EP_FENCE;
        }
    }
};
template <bool MIX> struct EpiRes {
    static constexpr bool HAS_MID = MIX, HAS_BEGIN = MIX;
    const float* hin32; float* hout32; bf16_t* hb; float* sq_next; const float* sq_a; const float* sq_s;
    __device__ __forceinline__ void begin(const Unit& u, const Ctx& cx, int ui) const {
        if (cx.tid < 256) { const int row = u.pm * 256 + cx.tid; const float ra = rstd_of(sq_a[row], 1.0f / 512.0f), rsd = rstd_of(sq_s[row], 1.0f / 512.0f);
            ((LAS f32x2*)(cx.lds + XCH_OFF + (ui & 1) * 2048))[cx.tid] = (f32x2){ra / rsd, rsd}; }
    }
    __device__ __forceinline__ void mid(Acc& acc, const Unit&, const Ctx& cx, int ui) const {
        const LAS f32x2* tab = (const LAS f32x2*)(cx.lds + XCH_OFF + (ui & 1) * 2048) + cx.fr;
        EP_FOR_ROWS { const float r = tab[EP_RU].x;
#pragma unroll
            for (int bj = 0; bj < 2; ++bj) { acc[ai][bj][m][0] *= r; acc[ai][bj][m][1] *= r; } }
    }
    __device__ __forceinline__ void operator()(Acc& acc, const Unit& u, const Ctx& cx, int ui) const {
        const LAS f32x2* tab = (const LAS f32x2*)(cx.lds + XCH_OFF + (ui & 1) * 2048) + cx.fr;
        const unsigned l_h = (unsigned)(cx.fr * 1024 + cx.fq * 8) * 4u, l_hb = l_h >> 1;
#pragma unroll
        for (int ai = 0; ai < 2; ++ai) {
            f32x4 pre[4][2][2];
#pragma unroll
            for (int m = 0; m < 4; ++m)
#pragma unroll
                for (int bj = 0; bj < 2; ++bj) { const size_t o = (size_t)(u.pm * 256 + EP_RU) * 1024 + u.pn * 256 + bj * 128 + cx.wc * 32;
                    if (hin32) { const float* hq = lane_ptr(hin32 + o, l_h); pre[m][bj][0] = *(const f32x4*)hq; pre[m][bj][1] = *(const f32x4*)(hq + 4); }
                    else { const u32x4 w = *(const u32x4*)lane_ptr(hb + o, l_hb); pre[m][bj][0] = __builtin_bit_cast(f32x4, w); } }
#pragma unroll
            for (int m = 0; m < 4; ++m) { const int ru = EP_RU, rowu = u.pm * 256 + ru; float sc = 1.0f; if (MIX) sc = tab[ru].y; float ss = 0.f;
#pragma unroll
                for (int bj = 0; bj < 2; ++bj) { const size_t o = (size_t)rowu * 1024 + u.pn * 256 + bj * 128 + cx.wc * 32; f32x4 h0, h1;
                    if (hin32) { h0 = pre[m][bj][0]; h1 = pre[m][bj][1]; }
                    else { const u32x4 w = __builtin_bit_cast(u32x4, pre[m][bj][0]); h0 = (f32x4){bf_lo(w.x), bf_hi(w.x), bf_lo(w.y), bf_hi(w.y)}; h1 = (f32x4){bf_lo(w.z), bf_hi(w.z), bf_lo(w.w), bf_hi(w.w)}; }
                    const f32x4 v0 = h0 + acc[ai][bj][m][0] * sc, v1 = h1 + acc[ai][bj][m][1] * sc;
                    if (hout32) { float* hp = lane_ptr(hout32 + o, l_h); *(f32x4*)hp = v0; *(f32x4*)(hp + 4) = v1; }
                    else *(u32x4*)lane_ptr(hb + o, l_hb) = pack8(v0, v1);
                    ss += sq8(v0, v1); }
                row_atomic(sq_next + rowu, cx.fr, ss, cx.fq); }
            EP_FENCE;
        }
    }
};
struct EpiSoftmax {
    static constexpr bool HAS_MID = false, HAS_BEGIN = false;
    const float* sq_x; bf16_t* pb;
    __device__ __forceinline__ void operator()(Acc& acc, const Unit& u, const Ctx& cx, int) const {
        LAS float* PM = (LAS float*)(cx.lds + XCH_OFF + 4096) + cx.fr * 4; LAS float* PS = (LAS float*)(cx.lds + XCH_OFF + 8192) + cx.fr * 4;
        EP_PRELOAD_RS(rsv, sq_x, 1.0f / 1024.0f)
        EP_FOR_ROWS { const int ru = EP_RU; const float rs = rsv[ai][m]; float mx = -3.0e38f;
#pragma unroll
            for (int bj = 0; bj < 2; ++bj)
#pragma unroll
                for (int n = 0; n < 2; ++n) { f32x4 v = acc[ai][bj][m][n] * rs; acc[ai][bj][m][n] = v; mx = fmaxf(fmaxf(mx, fmaxf(v[0], v[1])), fmaxf(v[2], v[3])); }
            mx = fmaxf(mx, __shfl_xor(mx, 16)); mx = fmaxf(mx, __shfl_xor(mx, 32));
            if (cx.fq == 0) PM[ru * 4 + cx.wc] = mx; EP_FENCE; }
        asm volatile("s_waitcnt lgkmcnt(0)" ::: "memory"); __builtin_amdgcn_s_barrier(); asm volatile("" ::: "memory");
        EP_FOR_ROWS { const int ru = EP_RU; const f32x4 q = *(const LAS f32x4*)(PM + ru * 4); const float mx = fmaxf(fmaxf(q[0], q[1]), fmaxf(q[2], q[3])); float sm = 0.f;
#pragma unroll
            for (int bj = 0; bj < 2; ++bj)
#pragma unroll
                for (int n = 0; n < 2; ++n) { f32x4 v = acc[ai][bj][m][n]; v = (f32x4){__builtin_amdgcn_exp2f(v[0] - mx), __builtin_amdgcn_exp2f(v[1] - mx), __builtin_amdgcn_exp2f(v[2] - mx), __builtin_amdgcn_exp2f(v[3] - mx)};
                    acc[ai][bj][m][n] = v; sm += (v[0] + v[1]) + (v[2] + v[3]); }
            sm += __shfl_xor(sm, 16); sm += __shfl_xor(sm, 32);
            if (cx.fq == 0) PS[ru * 4 + cx.wc] = sm; EP_FENCE; }
        asm volatile("s_waitcnt lgkmcnt(0)" ::: "memory"); __builtin_amdgcn_s_barrier(); asm volatile("" ::: "memory");
        const unsigned l_p = (unsigned)(cx.fr * 1024 + cx.fq * 8) * 2u;
        EP_FOR_ROWS { const int ru = EP_RU, rowu = u.pm * 256 + ru; const f32x4 q = *(const LAS f32x4*)(PS + ru * 4); const float inv = __builtin_amdgcn_rcpf((q[0] + q[1]) + (q[2] + q[3]));
#pragma unroll
            for (int bj = 0; bj < 2; ++bj) *(u32x4*)lane_ptr(pb + (size_t)rowu * 1024 + u.pn * 256 + bj * 128 + cx.wc * 32, l_p) = pack8(acc[ai][bj][m][0] * inv, acc[ai][bj][m][1] * inv);
            EP_FENCE; }
    }
};
struct EpiSwiglu {
    static constexpr bool HAS_MID = false, HAS_BEGIN = false;
    const float* sq_f; bf16_t* hid;
    __device__ __forceinline__ void operator()(Acc& acc, const Unit& u, const Ctx& cx, int) const {
        const unsigned l_h = (unsigned)(cx.fr * FF + cx.fq * 8) * 2u;
        EP_PRELOAD_RS(rsv, sq_f, 1.0f / 1024.0f)
        EP_FOR_ROWS { const int rowu = u.pm * 256 + EP_RU; const float rs = rsv[ai][m]; f32x4 o[2];
#pragma unroll
            for (int n = 0; n < 2; ++n) { const f32x4 g = acc[ai][0][m][n] * rs, up = acc[ai][1][m][n] * rs; o[n] = (f32x4){g[0] * sigm(g[0]) * up[0], g[1] * sigm(g[1]) * up[1], g[2] * sigm(g[2]) * up[2], g[3] * sigm(g[3]) * up[3]}; }
            *(u32x4*)lane_ptr(hid + (size_t)rowu * FF + u.pn * 128 + cx.wc * 32, l_h) = pack8(o[0], o[1]); EP_FENCE; }
    }
};
template <class OutFn> struct EpiStore {
    static constexpr bool HAS_MID = false, HAS_BEGIN = false;
    OutFn of;
    __device__ __forceinline__ void operator()(Acc& acc, const Unit& u, const Ctx& cx, int) const {
        int ld; bf16_t* base = of(u, ld); const unsigned l_o = (unsigned)(cx.fr * ld + cx.fq * 8) * 2u;
        EP_FOR_ROWS { const int ru = EP_RU;
#pragma unroll
            for (int bj = 0; bj < 2; ++bj) *(u32x4*)lane_ptr(base + (size_t)ru * ld + bj * 128 + cx.wc * 32, l_o) = pack8(acc[ai][bj][m][0], acc[ai][bj][m][1]);
            EP_FENCE; }
    }
};
}
namespace att {
constexpr int KSLOT = 12288, VSLOT = 8192, NSLOT = 3;
constexpr int L_K = 0, L_V = NSLOT * KSLOT, L_WS = L_V + NSLOT * VSLOT, L_OST = L_WS + 8 * 256, L_END = L_OST + 8 * 4096;
static_assert(L_END <= RING_BYTES, "attention LDS");
__device__ __forceinline__ int crow(int r, int hi) { return (r & 3) + 8 * (r >> 2) + 4 * hi; }
#define SBAR() __builtin_amdgcn_sched_barrier(0)
__device__ __forceinline__ void cmask(f32x16& p0, f32x16& p1, int jb, int qrel, int hi) {
    const float NEG = -INFINITY; const int kb = 64 * jb + 4 * hi;
#pragma unroll
    for (int r = 0; r < 16; ++r) { const int kv = kb + (r & 3) + 8 * (r >> 2); if (kv > qrel) p0[r] = NEG; if (kv + 32 > qrel) p1[r] = NEG; }
}
__device__ __forceinline__ void glds16(const void* gsrc, unsigned lds_dst) { unsigned keep;
    asm volatile("s_mov_b32 %0, m0\n\ts_mov_b32 m0, %2\n\ts_nop 0\n\tglobal_load_lds_dwordx4 %1, off\n\ts_mov_b32 m0, %0" : "=&s"(keep) : "v"(gsrc), "s"(lds_dst) : "memory"); }
__device__ __forceinline__ float max3f(float a, float b, float c) { float r; asm("v_max3_f32 %0, %1, %2, %3" : "=v"(r) : "v"(a), "v"(b), "v"(c)); return r; }
__device__ __forceinline__ float max2f(float a, float b) { float r; asm("v_max_f32_e32 %0, %1, %2" : "=v"(r) : "v"(a), "v"(b)); return r; }
__device__ __forceinline__ float fadd_s(float a, float b) { float r; asm("v_add_f32_e32 %0, %1, %2" : "=v"(r) : "v"(a), "v"(b)); return r; }
__device__ __forceinline__ float fsub_s(float a, float b) { float r; asm("v_sub_f32_e32 %0, %1, %2" : "=v"(r) : "v"(a), "v"(b)); return r; }
#define WAIT_BAR(N) asm volatile("s_waitcnt vmcnt(" #N ") lgkmcnt(0)\n\ts_barrier" ::: "memory")
typedef LAS const char* lds_cptr;
typedef short v4i16_t __attribute__((ext_vector_type(4)));
__device__ __forceinline__ void qkt(f32x16& p0, f32x16& p1, lds_cptr kb, const bf16x8* qr) { const f32x16 negm = f32x16{};
#pragma unroll
    for (int d0 = 0; d0 < 6; ++d0) { const bf16x8 b0 = *(const LAS bf16x8*)(kb + d0 * 2048), b1 = *(const LAS bf16x8*)(kb + d0 * 2048 + 512);
        if (d0 == 0) { p0 = __builtin_amdgcn_mfma_f32_32x32x16_bf16(b0, qr[0], negm, 0, 0, 0); p1 = __builtin_amdgcn_mfma_f32_32x32x16_bf16(b1, qr[0], negm, 0, 0, 0); }
        else { p0 = __builtin_amdgcn_mfma_f32_32x32x16_bf16(b0, qr[d0], p0, 0, 0, 0); p1 = __builtin_amdgcn_mfma_f32_32x32x16_bf16(b1, qr[d0], p1, 0, 0, 0); } }
}
__device__ __forceinline__ void kload2(bf16x8* kf, lds_cptr kp, int j) { kf[2 * j] = *(const LAS bf16x8*)(kp + j * 2048); kf[2 * j + 1] = *(const LAS bf16x8*)(kp + j * 2048 + 512); }
__device__ __forceinline__ s16x4 vtr(lds_cptr p) { return __builtin_bit_cast(s16x4, __builtin_amdgcn_ds_read_tr16_b64_v4i16((LAS v4i16_t*)p)); }
__device__ __forceinline__ float rowmax(const f32x16& p0, const f32x16& p1) {
    float a = max3f(p0[0], p0[1], p1[0]), b = max3f(p0[2], p0[3], p1[1]); a = max3f(a, p1[2], p1[3]);
#pragma unroll
    for (int r = 4; r < 16; r += 4) { a = max3f(a, p0[r], p0[r + 1]); b = max3f(b, p0[r + 2], p0[r + 3]); a = max3f(a, p1[r], p1[r + 1]); b = max3f(b, p1[r + 2], p1[r + 3]); }
    const float m = max2f(a, b);
    auto rr = __builtin_amdgcn_permlane32_swap(__float_as_uint(m), __float_as_uint(m), false, false);
    return max2f(__uint_as_float(rr[0]), __uint_as_float(rr[1]));
}
__device__ __forceinline__ void pv(f32x16* o, int vb, bf16x8 pa0, bf16x8 pa1, bf16x8 pa2, bf16x8 pa3) {
#pragma unroll
    for (int d0 = 0; d0 < 2; ++d0) { s16x4 lo[4], hi[4];
#pragma unroll
        for (int ks = 0; ks < 4; ++ks) {
            asm volatile("ds_read_b64_tr_b16 %0,%1 offset:%c2" : "=&v"(lo[ks]) : "v"(vb), "i"(d0 * 4096 + ks * 1024) : "memory");
            asm volatile("ds_read_b64_tr_b16 %0,%1 offset:%c2" : "=&v"(hi[ks]) : "v"(vb), "i"(d0 * 4096 + ks * 1024 + 512) : "memory"); }
        asm volatile("s_waitcnt lgkmcnt(0)" ::: "memory"); SBAR();
#define PK(k) (bf16x8){lo[k][0], lo[k][1], lo[k][2], lo[k][3], hi[k][0], hi[k][1], hi[k][2], hi[k][3]}
        o[d0] = __builtin_amdgcn_mfma_f32_32x32x16_bf16(pa0, PK(0), o[d0], 0, 0, 0);
        o[d0] = __builtin_amdgcn_mfma_f32_32x32x16_bf16(pa1, PK(1), o[d0], 0, 0, 0);
        o[d0] = __builtin_amdgcn_mfma_f32_32x32x16_bf16(pa2, PK(2), o[d0], 0, 0, 0);
        o[d0] = __builtin_amdgcn_mfma_f32_32x32x16_bf16(pa3, PK(3), o[d0], 0, 0, 0);
#undef PK
    }
}
template <int THRL>
__device__ __forceinline__ void attn_unit(int b, int h, int qb, const bf16_t* Q, const unsigned char* Kg, const unsigned char* Vg, bf16_t* AO, float* sq_a, LAS unsigned char* lds) {
    int tid_ = threadIdx.x; asm volatile("" : "+v"(tid_));
    const int tid = tid_, lane = tid & 63, r32 = lane & 31, hi = lane >> 5; const int wid = __builtin_amdgcn_readfirstlane(tid >> 6);
    const int q0 = qb * 256; const size_t rowbase = (size_t)b * S;
    const bf16_t* Qw = Q + (rowbase + q0 + wid * 32) * 768;
    const unsigned lds0 = (unsigned)(uintptr_t)lds;
    LAS float* wsf = (LAS float*)(lds + L_WS) + wid * 64;
    const unsigned char* ksrc = Kg + (size_t)(b * 8 + h) * 64 * KSLOT + wid * 1536 + lane * 16; const unsigned char* vsrc = Vg + (size_t)(b * 8 + h) * 64 * VSLOT + wid * 1024 + lane * 16;
    const unsigned kdst = lds0 + L_K + wid * 1536, vdst = lds0 + L_V + wid * 1024;
#define DMA_K(t, sl) do { glds16(ksrc + (size_t)(t) * KSLOT, (unsigned)__builtin_amdgcn_readfirstlane(kdst + (sl) * KSLOT)); \
        if (lane < 32) glds16(ksrc + (size_t)(t) * KSLOT + 1024, (unsigned)__builtin_amdgcn_readfirstlane(kdst + (sl) * KSLOT + 1024)); } while (0)
#define DMA_V(t, sl) glds16(vsrc + (size_t)(t) * VSLOT, (unsigned)__builtin_amdgcn_readfirstlane(vdst + (sl) * VSLOT))
    const int vb0 = (int)(lds0 + L_V) + ((lane >> 4) & 1) * 32 + (lane & 3) * 8 + (4 * hi + ((lane & 15) >> 2)) * 64;
    bf16x8 kf[12];
    const lds_cptr kp0 = (lds_cptr)lds + L_K + hi * 1024 + r32 * 16; const lds_cptr vp0 = (lds_cptr)lds + L_V + ((lane >> 4) & 1) * 32 + (lane & 3) * 8 + (4 * hi + ((lane & 15) >> 2)) * 64;
    const int NT = 4 * (qb + 1);
    DMA_K(0, 0); DMA_V(0, 0); DMA_K(1, 1);
    bf16x8 qr[6];
#pragma unroll
    for (int d0 = 0; d0 < 6; ++d0) qr[d0] = *reinterpret_cast<const bf16x8*>(&Qw[(size_t)r32 * 768 + (d0 < 4 ? h * 64 + d0 * 16 : 512 + h * 32 + (d0 - 4) * 16) + hi * 8]);
    float mhat = 0.f, l_reg = 0.f; f32x16 o[2]; o[0] = f32x16{}; o[1] = f32x16{};
    const int qrel = wid * 32 + r32;
#define CMASK(P0, P1, t) do { int jb_ = (t) - (NT - 4); if (jb_ >= 0) cmask(P0, P1, jb_, qrel, hi); } while (0)
    bool resc = false;
#define START(P0, P1) do { const float rm = rowmax(P0, P1); resc = false; \
    mhat = rm; \
    _Pragma("unroll") for (int r = 0; r < 16; ++r) P0[r] = __builtin_amdgcn_exp2f(P0[r] - mhat); } while (0)
#define RESC() do { if (resc) { asm volatile("s_waitcnt lgkmcnt(0)" ::: "memory"); \
      _Pragma("unroll") for (int d_ = 0; d_ < 2; ++d_) _Pragma("unroll") for (int r = 0; r < 16; ++r) o[d_][r] *= wsf[crow(r, hi)]; } } while (0)
    f32x16 pA0, pA1, pB0, pB1;
    int sp = 0, sc = 0, sn = 1;
#define ROT() do { sp = sc; sc = sn; sn = (sn == NSLOT - 1) ? 0 : sn + 1; } while (0)
    DMA_K(2, 2);
    WAIT_BAR(5);
    qkt(pA0, pA1, kp0, qr); asm volatile("s_nop 15\n\ts_nop 7" : "+v"(pA0), "+v"(pA1)); CMASK(pA0, pA1, 0);
    START(pA0, pA1);
#pragma unroll
    for (int r = 0; r < 16; ++r) pA1[r] = __builtin_amdgcn_exp2f(pA1[r] - mhat);
    WAIT_BAR(0);
    DMA_K(3, 0); DMA_V(1, 1);
    ROT();
#pragma unroll
    for (int j = 0; j < 6; ++j) kload2(kf, kp0 + sc * KSLOT, j);
    WAIT_BAR(3);
    s16x4 vlo[8], vhi[8]; u32x4 pw0, pw1, pw2, pw3;
#define PKW(P, B) cvt_pk_bf16(P[B], P[B + 1])
#define PAF(k) __builtin_bit_cast(bf16x8, pw##k)
#define VFR(i) (bf16x8){vlo[i][0], vlo[i][1], vlo[i][2], vlo[i][3], vhi[i][0], vhi[i][1], vhi[i][2], vhi[i][3]}
#define PIN(x) asm volatile("" : "+v"(x))
#define MX3(a, b, c) __builtin_fmaxf(__builtin_fmaxf((a), (b)), (c))
#define GAPA(MF, A0, A1, A2, A3, W0, W1, PW) do { MF; sacc += A0; sacc += A1; sacc += A2; sacc += A3; PIN(sacc); W0; W1; PIN(PW); SBAR(); } while (0)
#define GAPM(MF) do { MF; SBAR(); } while (0)
#define EX(v) __builtin_amdgcn_exp2f(v)
#define GAPB(MF, X, B) do { MF; X[B] = EX(X[B] - mhat); X[B + 1] = EX(X[B + 1] - mhat); X[B + 2] = EX(X[B + 2] - mhat); X[B + 3] = EX(X[B + 3] - mhat); PIN(X); SBAR(); } while (0)
#define VRD(i) do { vlo[i] = vtr(vp_ + (((i) >> 2) * 4096 + ((i) & 3) * 1024)); vhi[i] = vtr(vp_ + (((i) >> 2) * 4096 + ((i) & 3) * 1024 + 512)); } while (0)
#define KRD(G, j) do { if (G) { kload2(kf, kp0 + sn * KSLOT, j); SBAR(); } } while (0)
#define MF32(A, B, C) __builtin_amdgcn_mfma_f32_32x32x16_bf16(A, B, C, 0, 0, 0)
#define STEP(C0, C1, P0, P1, t, GK, GV, GL) do { SBAR(); const f32x16 zero16 = f32x16{}; \
    const lds_cptr vp_ = vp0 + sp * VSLOT; \
    VRD(0); SBAR(); float sacc = (P0[0] + P0[1]); \
    GAPA(C0 = MF32(kf[0], qr[0], zero16), P0[2], P0[3], P0[4], P0[5],     pw0[0] = PKW(P0, 0), pw0[1] = PKW(P0, 2), pw0); \
    VRD(4); SBAR(); GAPA(C1 = MF32(kf[1], qr[0], zero16), P0[6], P0[7], P0[8], P0[9],     pw0[2] = PKW(P0, 4), pw0[3] = PKW(P0, 6), pw0); \
    VRD(1); SBAR(); GAPA(C0 = MF32(kf[2], qr[1], C0),   P0[10], P0[11], P0[12], P0[13], pw1[0] = PKW(P0, 8), pw1[1] = PKW(P0, 10), pw1); \
    VRD(5); SBAR(); GAPA(C1 = MF32(kf[3], qr[1], C1),   P0[14], P0[15], P1[0], P1[1],   pw1[2] = PKW(P0, 12), pw1[3] = PKW(P0, 14), pw1); \
    VRD(2); SBAR(); GAPA(C0 = MF32(kf[4], qr[2], C0),   P1[2], P1[3], P1[4], P1[5],     pw2[0] = PKW(P1, 0), pw2[1] = PKW(P1, 2), pw2); \
    VRD(6); SBAR(); GAPA(C1 = MF32(kf[5], qr[2], C1),   P1[6], P1[7], P1[8], P1[9],     pw2[2] = PKW(P1, 4), pw2[3] = PKW(P1, 6), pw2); \
    VRD(3); SBAR(); GAPA(C0 = MF32(kf[6], qr[3], C0),   P1[10], P1[11], P1[12], P1[13], pw3[0] = PKW(P1, 8), pw3[1] = PKW(P1, 10), pw3); \
    VRD(7); SBAR(); GAPA(C1 = MF32(kf[7], qr[3], C1),   P1[14], P1[15], 0.f, 0.f,       pw3[2] = PKW(P1, 12), pw3[3] = PKW(P1, 14), pw3); \
    GAPM(C0 = MF32(kf[8], qr[4], C0)); GAPM(C1 = MF32(kf[9], qr[4], C1)); GAPM(C0 = MF32(kf[10], qr[5], C0)); GAPM(C1 = MF32(kf[11], qr[5], C1)); \
    l_reg += sacc; \
    if (GK) { DMA_K((t) + 3, sc); } if (GV) { DMA_V((t) + 1, sn); } \
    CMASK(C0, C1, t); \
    { float a = MX3(C0[0], C0[1], C1[0]), b = MX3(C0[2], C0[3], C1[1]); a = MX3(a, C1[2], C1[3]); \
      _Pragma("unroll") for (int r = 4; r < 16; r += 4) { a = MX3(a, C0[r], C0[r + 1]); b = MX3(b, C0[r + 2], C0[r + 3]); a = MX3(a, C1[r], C1[r + 1]); b = MX3(b, C1[r + 2], C1[r + 3]); } \
      float rm = __builtin_fmaxf(a, b); { auto rr = __builtin_amdgcn_permlane32_swap(__float_as_uint(rm), __float_as_uint(rm), false, false); rm = __builtin_fmaxf(__uint_as_float(rr[0]), __uint_as_float(rr[1])); } \
      resc = false; \
      rm -= mhat; \
      if (__builtin_expect(__any(rm > (float)THRL), 0)) { const float dl = __builtin_fmaxf(rm, 0.f); mhat += dl; \
        const float f = __builtin_amdgcn_exp2f(-dl); l_reg *= f; if (hi == 0) wsf[r32] = f; resc = true; } } \
    SBAR(); \
    GAPB(o[0] = MF32(PAF(0), VFR(0), o[0]), C0, 0); \
    KRD(GL, 0); GAPB(o[1] = MF32(PAF(0), VFR(4), o[1]), C0, 4); \
    KRD(GL, 1); GAPB(o[0] = MF32(PAF(1), VFR(1), o[0]), C0, 8); \
    KRD(GL, 2); GAPB(o[1] = MF32(PAF(1), VFR(5), o[1]), C0, 12); \
    KRD(GL, 3); GAPB(o[0] = MF32(PAF(2), VFR(2), o[0]), C1, 0); \
    KRD(GL, 4); GAPB(o[1] = MF32(PAF(2), VFR(6), o[1]), C1, 4); \
    KRD(GL, 5); GAPB(o[0] = MF32(PAF(3), VFR(3), o[0]), C1, 8); \
    GAPB(o[1] = MF32(PAF(3), VFR(7), o[1]), C1, 12); \
    } while (0)
    int t = 1;
#undef CMASK
#define CMASK(P0, P1, t) do {} while (0)
    for (; t + 5 < NT; t += 2) {
        STEP(pB0, pB1, pA0, pA1, t, true, true, true);     WAIT_BAR(3); RESC(); ROT();
        STEP(pA0, pA1, pB0, pB1, t + 1, true, true, true); WAIT_BAR(3); RESC(); ROT();
    }
#undef CMASK
#define CMASK(P0, P1, t) do { int jb_ = (t) - (NT - 4); if (jb_ >= 0) cmask(P0, P1, jb_, qrel, hi); } while (0)
#define ENDW(tt) do { if ((tt) + 3 < NT) { WAIT_BAR(3); } else if ((tt) + 2 < NT) { WAIT_BAR(1); } else { WAIT_BAR(0); } } while (0)
    for (; t + 1 < NT; t += 2) {
        STEP(pB0, pB1, pA0, pA1, t, (t + 3 < NT), (t + 1 < NT), (t + 1 < NT));     ENDW(t);     RESC(); ROT();
        STEP(pA0, pA1, pB0, pB1, t + 1, (t + 4 < NT), (t + 2 < NT), (t + 2 < NT)); ENDW(t + 1); RESC(); ROT();
    }
    STEP(pB0, pB1, pA0, pA1, NT - 1, false, false, false); RESC();
    { float sacc = pB0[0] + pB0[1];
#pragma unroll
      for (int r = 2; r < 16; ++r) sacc += pB0[r];
#pragma unroll
      for (int r = 0; r < 16; ++r) sacc += pB1[r];
      l_reg += sacc;
      pw0 = (u32x4){PKW(pB0, 0), PKW(pB0, 2), PKW(pB0, 4), PKW(pB0, 6)}; pw1 = (u32x4){PKW(pB0, 8), PKW(pB0, 10), PKW(pB0, 12), PKW(pB0, 14)};
      pw2 = (u32x4){PKW(pB1, 0), PKW(pB1, 2), PKW(pB1, 4), PKW(pB1, 6)}; pw3 = (u32x4){PKW(pB1, 8), PKW(pB1, 10), PKW(pB1, 12), PKW(pB1, 14)};
      SBAR(); pv(o, vb0 + sc * VSLOT, PAF(0), PAF(1), PAF(2), PAF(3)); }
#undef PKW
#undef PAF
#undef VFR
#undef PIN
#undef MX3
#undef GAPA
#undef GAPM
#undef GAPB
#undef EX
#undef VRD
#undef KRD
#undef MF32
#undef STEP
#undef ENDW
#undef DMA_K
#undef DMA_V
#undef CMASK
#undef START
#undef RESC
#undef ROT
    { auto rr = __builtin_amdgcn_permlane32_swap(__float_as_uint(l_reg), __float_as_uint(l_reg), false, false); l_reg = __uint_as_float(rr[0]) + __uint_as_float(rr[1]); }
    if (hi == 0) wsf[32 + r32] = l_reg;
    asm volatile("s_waitcnt lgkmcnt(0)" ::: "memory");
    LAS bf16_t* stg = (LAS bf16_t*)(lds + L_OST) + wid * 2048;
#pragma unroll
    for (int r = 0; r < 16; ++r) { const int orow = crow(r, hi); const float rl = __builtin_amdgcn_rcpf(wsf[32 + orow]);
#pragma unroll
        for (int d0 = 0; d0 < 2; ++d0) stg[orow * 64 + d0 * 32 + r32] = (bf16_t)(cvt_pk_bf16(o[d0][r] * rl, 0.f) & 0xffffu); }
    asm volatile("s_waitcnt lgkmcnt(0)" ::: "memory");
    bf16_t* Ow = AO + (rowbase + q0 + wid * 32) * 512 + h * 64;
#pragma unroll
    for (int i = 0; i < 4; ++i) { const int row = i * 8 + (lane >> 3), ch = lane & 7; const u32x4 v = *(const LAS u32x4*)(stg + row * 64 + ch * 8); *(u32x4*)(Ow + (size_t)row * 512 + ch * 8) = v;
        float ss = (bf_lo(v.x) * bf_lo(v.x) + bf_hi(v.x) * bf_hi(v.x)) + (bf_lo(v.y) * bf_lo(v.y) + bf_hi(v.y) * bf_hi(v.y)) + (bf_lo(v.z) * bf_lo(v.z) + bf_hi(v.z) * bf_hi(v.z)) + (bf_lo(v.w) * bf_lo(v.w) + bf_hi(v.w) * bf_hi(v.w));
        ss += __shfl_xor(ss, 1); ss += __shfl_xor(ss, 2); ss += __shfl_xor(ss, 4);
        if (ch == 0) unsafeAtomicAdd(sq_a + rowbase + q0 + wid * 32 + row, ss); }
    asm volatile("s_waitcnt lgkmcnt(0)\n\ts_barrier" ::: "memory");
}
#undef SBAR
#undef WAIT_BAR
__device__ __forceinline__ void attn_phase(int vcu, int G, const bf16_t* Q, const unsigned char* Kg, const unsigned char* Vg, bf16_t* AO, float* sq_a, LAS unsigned char* lds) {
    for (int v = vcu; v < 256; v += G) { const int bh = v >> 2, s = v & 3;
#pragma unroll 1
        for (int i = 0; i < 4; ++i) { const int qb = (i == 0) ? s : (i == 1) ? 7 - s : (i == 2) ? 8 + s : 15 - s; attn_unit<8>(bh >> 3, bh & 7, qb, Q, Kg, Vg, AO, sq_a, lds); } }
}
}

__device__ __forceinline__ void ssm_scan_phase(int vcu, int G, const float* xloc, const float* aL  , bf16_t* assm) {
    int tid_ = threadIdx.x; asm volatile("" : "+v"(tid_));
    if (tid_ >= 64) return;
    const int p = tid_;
    for (int v = vcu; v < 256; v += G) { const int b = v >> 5, g = v & 31; const float ar = aL[(g * 64 + p) * 2], ai = aL[(g * 64 + p) * 2 + 1];
        float xr = 0.f, xi = 0.f;
        const float* xl = xloc + ((size_t)g * NCH + b * NCHB) * 128; bf16_t* as = assm + ((size_t)g * NCH + b * NCHB) * KS3 + KS1;
#pragma unroll 8
        for (int c = 0; c < NCHB; ++c) { const float lr = xl[(size_t)c * 128 + p], li = xl[(size_t)c * 128 + 64 + p];
            as[(size_t)c * KS3 + p] = (bf16_t)(cvt_pk_bf16(xr, 0.f) & 0xffffu); as[(size_t)c * KS3 + 64 + p] = (bf16_t)(cvt_pk_bf16(xi, 0.f) & 0xffffu);
            const float nr = ar * xr - ai * xi + lr, ni = ar * xi + ai * xr + li; xr = nr; xi = ni; }
    }
}
__device__ __forceinline__ void sincos_d(double a, double& s, double& c) {
    const double k = rint(a * 0.63661977236758134308);
    double y = fma(-k, 1.57079632679489655800e+00, a); y = fma(-k, 6.12323399573676603587e-17, y);
    const double y2 = y * y;
    double sp = -1.0 / 1307674368000.0; sp = fma(sp, y2, 1.0 / 6227020800.0); sp = fma(sp, y2, -1.0 / 39916800.0); sp = fma(sp, y2, 1.0 / 362880.0);
    sp = fma(sp, y2, -1.0 / 5040.0); sp = fma(sp, y2, 1.0 / 120.0); sp = fma(sp, y2, -1.0 / 6.0); sp = fma(sp * y2, y, y);
    double cp = 1.0 / 20922789888000.0; cp = fma(cp, y2, -1.0 / 87178291200.0); cp = fma(cp, y2, 1.0 / 479001600.0); cp = fma(cp, y2, -1.0 / 3628800.0);
    cp = fma(cp, y2, 1.0 / 40320.0); cp = fma(cp, y2, -1.0 / 720.0); cp = fma(cp, y2, 1.0 / 24.0); cp = fma(cp, y2, -0.5); cp = fma(cp, y2, 1.0);
    const int q = (int)((long long)k & 3);
    if (q == 0) { s = sp; c = cp; } else if (q == 1) { s = cp; c = -sp; } else if (q == 2) { s = -sp; c = -cp; } else { s = -cp; c = sp; }
}
__device__ __forceinline__ float wave_sum(float v) {
#pragma unroll
    for (int o = 1; o < 64; o <<= 1) v += __shfl_xor(v, o);
    return v;
}
template <class ColFn, class GainFn>
__device__ __forceinline__ void conv_T(int gw, int NGW, int& base, int lane, LAS float* scr, int Ksrc, int ldw, int Ndst, bf16_t* dst, int ldd, ColFn colp, GainFn gain, float scale) {
    const int nblk = Ndst / 32, nitems = nblk * (Ksrc / 64);
    int first = gw - (base % NGW); if (first < 0) first += NGW;
    base += nitems;
    for (int it = first; it < nitems; it += NGW) { const int kb = it / nblk, nb = it % nblk, k0 = 64 * kb, n0 = 32 * nb;
        const float* cp = colp(n0 + (lane & 31)); float v[32];
        if (cp) { const float* q = cp + (size_t)(k0 + (lane >> 5)) * ldw;
#pragma unroll
            for (int i = 0; i < 32; ++i) v[i] = q[(size_t)(2 * i) * ldw]; }
        else {
#pragma unroll
            for (int i = 0; i < 32; ++i) v[i] = 0.f; }
#pragma unroll
        for (int i = 0; i < 32; ++i) scr[(2 * i + (lane >> 5)) * 33 + (lane & 31)] = v[i];
        asm volatile("s_waitcnt lgkmcnt(0)" ::: "memory");
        const int c = lane & 7; float gk[8];
#pragma unroll
        for (int e = 0; e < 8; ++e) gk[e] = gain(k0 + 8 * c + e) * scale;
#pragma unroll
        for (int j = 0; j < 4; ++j) { const int n = (lane >> 3) + 8 * j; const LAS float* sp = scr + (8 * c) * 33 + n;
            u32x4 o; o.x = cvt_pk_bf16(sp[0 * 33] * gk[0], sp[1 * 33] * gk[1]); o.y = cvt_pk_bf16(sp[2 * 33] * gk[2], sp[3 * 33] * gk[3]); o.z = cvt_pk_bf16(sp[4 * 33] * gk[4], sp[5 * 33] * gk[5]); o.w = cvt_pk_bf16(sp[6 * 33] * gk[6], sp[7 * 33] * gk[7]);
            *(u32x4*)(dst + (size_t)(n0 + n) * ldd + k0 + 8 * c) = o; }
        asm volatile("s_waitcnt lgkmcnt(0)" ::: "memory");
    }
}
struct In {
    const float *x, *mem; const int* pos; const float *norm_mix_g, *w_in, *q_norm_g, *w_uq, *kv_norm_g, *w_ukv, *lam_re, *lam_im, *log_dt, *b_re, *b_im, *c_re, *c_im, *ssm_d, *w_glu, *b_glu,
        *attn_out_g, *ssm_out_g, *w_out, *norm_x_g, *mem_norm_g, *w_xq, *w_xkv, *w_xo, *norm_ffn_g, *w_gate, *w_up, *w_down, *final_g;
};
struct Freqs { double f[16]; };

__device__ __forceinline__ void ssm_mats(const In& in, int l, int g, int q, unsigned char* ws, LAS unsigned char* lds) {
    const int tid = threadIdx.x;
    LAS float* bbr = (LAS float*)lds; LAS float* bbi = bbr + 1024; LAS float* apr = bbi + 1024; LAS float* api = apr + 34 * 64; LAS float* cr = api + 34 * 64; LAS float* ci = cr + 1024;
    LAS float* ktabT = ci + 1024  ; LAS float* aprT = ktabT + 2048  ; LAS float* apiT = aprT + 64 * 35; LAS float* dvs = apiT + 64 * 35;
    const int lg = l * 32 + g;
    if (tid < 128) { const int p = tid & 63; const double lr = in.lam_re[lg * 64 + p], li = in.lam_im[lg * 64 + p], dt = exp((double)in.log_dt[lg]);
        double sn, cn; sincos_d(fabs(li * dt), sn, cn); if (li * dt < 0) sn = -sn;
        const double er = exp(lr * dt), ar = er * cn, ai = er * sn;
        if (tid < 64) {
            double pr = 1.0, pi = 0.0;
            for (int j = 0; j < 34; ++j) { apr[j * 64 + p] = (float)pr; api[j * 64 + p] = (float)pi; aprT[p * 35 + j] = (float)pr; apiT[p * 35 + j] = (float)pi;
                if (j == LC && q == 0) { float* al = (float*)(ws + WS_AL) + (size_t)(lg * 64 + p) * 2; al[0] = (float)pr; al[1] = (float)pi; }
                const double nr = pr * ar - pi * ai, ni = pr * ai + pi * ar; pr = nr; pi = ni; }
        } else {
            const double den = lr * lr + li * li, cfr = ((ar - 1.0) * lr + ai * li) / den, cfi = (ai * lr - (ar - 1.0) * li) / den; const float fr_ = (float)cfr, fi_ = (float)cfi;
            float bre[16], bim[16];
#pragma unroll
            for (int c = 0; c < 16; ++c) { bre[c] = in.b_re[(size_t)(lg * 64 + p) * 16 + c]; bim[c] = in.b_im[(size_t)(lg * 64 + p) * 16 + c]; }
#pragma unroll
            for (int c = 0; c < 16; ++c) { bbr[p * 16 + c] = fr_ * bre[c] - fi_ * bim[c]; bbi[p * 16 + c] = fr_ * bim[c] + fi_ * bre[c]; }
        }
    } else if (tid < 192) { const int p = tid - 128;
#pragma unroll
        for (int c = 0; c < 16; ++c) { cr[c * 64 + p] = in.c_re[(size_t)(lg * 16 + c) * 64 + p]; ci[c * 64 + p] = in.c_im[(size_t)(lg * 16 + c) * 64 + p]; }
    } else if (tid < 208) dvs[tid - 192] = in.ssm_d[l * 512 + g * 16 + (tid - 192)];
    __syncthreads();
    {
      const int j = tid >> 4, c4 = (tid >> 2) & 3, c = 4 * q + c4, c2b = (tid & 3) * 4; f32x4 sum = (f32x4){0.f, 0.f, 0.f, 0.f};
#pragma unroll 4
      for (int p = 0; p < 64; ++p) { const float yr = apr[j * 64 + p], yi = api[j * 64 + p], xr = cr[c * 64 + p], xi = ci[c * 64 + p]; const float car = xr * yr - xi * yi, cai = xr * yi + xi * yr;
          sum += car * *(const LAS f32x4*)(bbr + p * 16 + c2b) - cai * *(const LAS f32x4*)(bbi + p * 16 + c2b); }
#pragma unroll
      for (int y = 0; y < 4; ++y) ktabT[(c4 * 16 + c2b + y) * 32 + j] = sum[y]; }
    __syncthreads();
    bf16_t* bt1 = (bf16_t*)(ws + WS_SSM + (size_t)lg * SSM_G_STRIDE); bf16_t* bt3 = (bf16_t*)(ws + WS_SSM + (size_t)lg * SSM_G_STRIDE + SSM_BT3_OFF);
    for (int idx = tid; idx < 128 * 80; idx += 512) { const int rq = idx / 80, k0 = (idx % 80) * 8, s = rq >> 2, c4 = rq & 3, c = 4 * q + c4, n = s * 16 + c; float v[8];
        if (k0 < KS1) { const int s2 = k0 >> 4, c0 = k0 & 15; const float dvc = (s2 == s) ? dvs[c] : 0.f; const LAS float* kt = ktabT + (c4 * 16 + c0) * 32 + (s2 <= s ? s - s2 : 0);
#pragma unroll
            for (int e = 0; e < 8; ++e) { float t = kt[e * 32]; if (s2 > s) t = 0.f; if (c0 + e == c) t += dvc; v[e] = t; }
        } else { const int pq = k0 - KS1, p0 = pq & 63; const bool im = (pq >> 6) != 0;
            const LAS float* xrp = cr + c * 64 + p0; const LAS float* xip = ci + c * 64 + p0; const LAS float* yrp = apr + (s + 1) * 64 + p0; const LAS float* yip = api + (s + 1) * 64 + p0;
#pragma unroll
            for (int hh = 0; hh < 2; ++hh) { const f32x4 xr = *(const LAS f32x4*)(xrp + 4 * hh), xi = *(const LAS f32x4*)(xip + 4 * hh), yr = *(const LAS f32x4*)(yrp + 4 * hh), yi = *(const LAS f32x4*)(yip + 4 * hh);
                const f32x4 re = xr * yr - xi * yi, mi = -(xr * yi + xi * yr);
#pragma unroll
                for (int e = 0; e < 4; ++e) v[4 * hh + e] = im ? mi[e] : re[e]; }
        }
        u32x4 o; o.x = cvt_pk_bf16(v[0], v[1]); o.y = cvt_pk_bf16(v[2], v[3]); o.z = cvt_pk_bf16(v[4], v[5]); o.w = cvt_pk_bf16(v[6], v[7]);
        *(u32x4*)(bt3 + (size_t)n * KS3 + k0) = o; }
    for (int idx = tid; idx < 64 * 64; idx += 512) { const int rq = idx >> 6, k0 = (idx & 63) * 8, s2 = k0 >> 4, c0 = k0 & 15; float v[8];
        const bool real_row = rq < 32; const int p = 16 * q + (rq & 15); const bool im = (rq >> 4) & 1; const int n = real_row ? (im ? 64 + p : p) : 128 + 32 * q + (rq - 32);
        if (real_row) { const float yr = aprT[p * 35 + (LC - 1 - s2)], yi = apiT[p * 35 + (LC - 1 - s2)];
#pragma unroll
            for (int hh = 0; hh < 2; ++hh) { const f32x4 br = *(const LAS f32x4*)(bbr + p * 16 + c0 + 4 * hh), bi = *(const LAS f32x4*)(bbi + p * 16 + c0 + 4 * hh);
                const f32x4 re = br * yr - bi * yi, mi = bi * yr + br * yi;
#pragma unroll
                for (int e = 0; e < 4; ++e) v[4 * hh + e] = im ? mi[e] : re[e]; }
        } else {
#pragma unroll
            for (int e = 0; e < 8; ++e) v[e] = 0.f; }
        u32x4 o; o.x = cvt_pk_bf16(v[0], v[1]); o.y = cvt_pk_bf16(v[2], v[3]); o.z = cvt_pk_bf16(v[4], v[5]); o.w = cvt_pk_bf16(v[6], v[7]);
        *(u32x4*)(bt1 + (size_t)n * KS1 + k0) = o; }
    __syncthreads();
}

__device__ __forceinline__ void prologue(const In& in, const Freqs& fr, unsigned char* ws, LAS unsigned char* lds, int vcu, int G, int parts) {
    const int tid = threadIdx.x, lane = tid & 63, wave = __builtin_amdgcn_readfirstlane(tid >> 6);
    __syncthreads();
    if (parts & 1) for (int j = vcu; j < 256; j += G) ssm_mats(in, j >> 7, (j >> 2) & 31, j & 3, ws, lds);
    LAS float* scr = (LAS float*)(lds + wave * 16384);
    const int gw = vcu * 8 + wave, NGW = G * 8;
    if (parts & 2) {
    { bf16_t* hb = (bf16_t*)(ws + WS_HB); float* sq0 = (float*)(ws + WS_CTL) + CW_SQ + (size_t)SQ_MIX * T;
      for (int r = gw * 2; r < T; r += NGW * 2) { const f32x4* xr = (const f32x4*)(in.x + (size_t)r * D) + lane; u32x2* hrow = (u32x2*)(hb + (size_t)r * D) + lane; f32x4 v[8];
#pragma unroll
          for (int j = 0; j < 8; ++j) v[j] = xr[64 * j];
          float s0 = 0.f, s1 = 0.f;
#pragma unroll
          for (int j = 0; j < 4; ++j) { s0 += (v[j][0] * v[j][0] + v[j][1] * v[j][1]) + (v[j][2] * v[j][2] + v[j][3] * v[j][3]); s1 += (v[j + 4][0] * v[j + 4][0] + v[j + 4][1] * v[j + 4][1]) + (v[j + 4][2] * v[j + 4][2] + v[j + 4][3] * v[j + 4][3]); }
#pragma unroll
          for (int j = 0; j < 8; ++j) hrow[64 * j] = (u32x2){cvt_pk_bf16(v[j][0], v[j][1]), cvt_pk_bf16(v[j][2], v[j][3])};
          s0 = wave_sum(s0); s1 = wave_sum(s1); if (lane == 0) { sq0[r] = s0; sq0[r + 1] = s1; } } }
    { bf16_t* mn = (bf16_t*)(ws + WS_RA + RA_MEMN);
      for (int r = gw; r < NB * MEMT; r += NGW) { const f32x4* xr = (const f32x4*)(in.mem + (size_t)r * D) + lane; u32x2* mrow = (u32x2*)(mn + (size_t)r * D) + lane; f32x4 v[4]; float s = 0.f;
#pragma unroll
          for (int j = 0; j < 4; ++j) { v[j] = xr[64 * j]; s += (v[j][0] * v[j][0] + v[j][1] * v[j][1]) + (v[j][2] * v[j][2] + v[j][3] * v[j][3]); }
          const float rs = rstd_of(wave_sum(s), 1.0f / 1024.0f);
#pragma unroll
          for (int j = 0; j < 4; ++j) mrow[64 * j] = (u32x2){cvt_pk_bf16(v[j][0] * rs, v[j][1] * rs), cvt_pk_bf16(v[j][2] * rs, v[j][3] * rs)}; } }
    { float* cs = (float*)(ws + WS_CS);
      for (int i = vcu * 512 + tid; i < T * 16; i += G * 512) { const int t = i >> 4, j = i & 15; double s, c; sincos_d((double)in.pos[t] * fr.f[j], s, c); cs[(size_t)t * 32 + j] = (float)c; cs[(size_t)t * 32 + 16 + j] = (float)s; } }
    }
    if (!(parts & 4)) return;
    int cbase = 0;
    for (int l = 0; l < NL; ++l) {
        unsigned char* wl = ws + WS_W + (size_t)l * WL_STRIDE;
        { const float* W = in.w_in + (size_t)l * D * 928; const float* gn = in.norm_mix_g + l * D;
          conv_T(gw, NGW, cbase, lane, scr, D, 928, 1024, (bf16_t*)(wl + WL_IN), 1024,
                 [=](int n) -> const float* { if (n < 384) return W + n; if (n < 416) { const int i = n - 384; return W + ((i & 1) ? 400 + (i >> 1) : 384 + (i >> 1)); } if (n < 512) return nullptr; return W + 416 + (n - 512); },
                 [=](int k) { return gn[k]; }, 1.0f); }
        { const float* W = in.w_uq + (size_t)l * 256 * 768; const float* gn = in.q_norm_g + l * 256;
          conv_T(gw, NGW, cbase, lane, scr, 256, 768, 768, (bf16_t*)(wl + WL_UP), 256,
                 [=](int n) -> const float* { if (n < 512) return W + (n >> 6) * 96 + (n & 63); const int h = (n - 512) >> 5, i = (n - 512) & 31; return W + h * 96 + ((i & 1) ? 80 + (i >> 1) : 64 + (i >> 1)); },
                 [=](int k) { return gn[k]; }, 0.10206207261596575f * LOG2E); }
        { const float* W = in.w_ukv + (size_t)l * 128 * 1024; const float* gn = in.kv_norm_g + l * 128; bf16_t* dst = (bf16_t*)(wl + WL_UP) + (size_t)768 * 256;
          conv_T(gw, NGW, cbase, lane, scr, 128, 1024, 1024, dst, 256, [=](int n) -> const float* { return W + n; }, [=](int k) { return gn[k]; }, 1.0f);
          for (int i = vcu * 512 + tid; i < 1024 * 16; i += G * 512) *(u32x4*)(dst + (size_t)(i >> 4) * 256 + 128 + (i & 15) * 8) = (u32x4){0u, 0u, 0u, 0u}; }
        { const float* W = in.w_glu + (size_t)l * 512 * 512;
          conv_T(gw, NGW, cbase, lane, scr, 512, 512, 512, (bf16_t*)(wl + WL_GLU), 512, [=](int n) -> const float* { return W + n; }, [=](int) { return 1.0f; }, 1.0f); }
        { const float* W = in.w_out + (size_t)l * D * D; const float* ga = in.attn_out_g + l * 512; const float* gs = in.ssm_out_g + l * 512;
          conv_T(gw, NGW, cbase, lane, scr, D, D, D, (bf16_t*)(wl + WL_OUT), D, [=](int n) -> const float* { return W + n; }, [=](int k) { return k < 512 ? ga[k] : gs[k - 512]; }, 1.0f); }
        { const float* W = in.w_xkv + (size_t)l * D * 2048; const float* gn = in.mem_norm_g + l * D;
          conv_T(gw, NGW, cbase, lane, scr, D, 2048, 2048, (bf16_t*)(ws + WS_WXKV) + (size_t)l * 2048 * D, D, [=](int n) -> const float* { return W + n; }, [=](int k) { return gn[k]; }, 1.0f); }
        { const float* W = in.w_xo + (size_t)l * D * D;
          conv_T(gw, NGW, cbase, lane, scr, D, D, D, (bf16_t*)(ws + WS_WXO) + (size_t)l * D * D, D, [=](int n) -> const float* { return W + n; }, [=](int) { return 1.0f; }, 1.0f); }
        { const float* Wg = in.w_gate + (size_t)l * D * FF; const float* Wu = in.w_up + (size_t)l * D * FF; const float* gn = in.norm_ffn_g + l * D;
          conv_T(gw, NGW, cbase, lane, scr, D, FF, 2 * FF, (bf16_t*)(wl + WL_GU), D,
                 [=](int n) -> const float* { const int tl = n >> 8, r = n & 255; return r < 128 ? Wg + tl * 128 + r : Wu + tl * 128 + (r - 128); }, [=](int k) { return gn[k]; }, 1.0f); }
        { const float* W = in.w_down + (size_t)l * FF * D;
          conv_T(gw, NGW, cbase, lane, scr, FF, D, D, (bf16_t*)(wl + WL_DN), FF, [=](int n) -> const float* { return W + n; }, [=](int) { return 1.0f; }, 1.0f); }
        { const float* W = in.w_xq + (size_t)l * D * D; const float* gn = in.norm_x_g + l * D; bf16_t* dst = (bf16_t*)(wl + WL_XQ);
          for (int i = vcu * 512 + tid; i < D * D / 8; i += G * 512) { const int k = i >> 7; const float sc = gn[k] * (0.0625f * LOG2E); const f32x4 a = *(const f32x4*)(W + (size_t)i * 8) * sc, b = *(const f32x4*)(W + (size_t)i * 8 + 4) * sc;
              *(u32x4*)(dst + (size_t)i * 8) = ep::pack8(a, b); } }
    }
}
struct Args { In in; float* out; unsigned char* ws; Freqs fr; int ph_hi; int pad; };

template <class F> struct PanelFn { F f; __device__ __forceinline__ void operator()(const pg8::Unit& u, const char*& a, const char*& b) const { f(u, a, b); } };
template <class F> __device__ __forceinline__ PanelFn<F> make_panel(F f) { return PanelFn<F>{f}; }
template <class F> struct OutFnT { F f; __device__ __forceinline__ bf16_t* operator()(const pg8::Unit& u, int& ld) const { return f(u, ld); } };
template <class F> __device__ __forceinline__ ep::EpiStore<OutFnT<F>> make_store(F f) { return ep::EpiStore<OutFnT<F>>{OutFnT<F>{f}}; }

__global__ void __launch_bounds__(512, 2) mk_fwd(Args a) {
    extern __shared__ __attribute__((aligned(16))) unsigned char lds_raw[];
    LAS unsigned char* lds = (LAS unsigned char*)lds_raw;
    const int tid = threadIdx.x, lane = tid & 63, wave = __builtin_amdgcn_readfirstlane(tid >> 6);
    const int G = gridDim.x, bx = blockIdx.x, vcu = (G % 8 == 0) ? (bx % 8) * (G / 8) + bx / 8 : bx;
    unsigned char* ws = a.ws; float* out = a.out;
    unsigned* ctl = (unsigned*)(ws + WS_CTL);
    for (int u = tid; u < (LDS_BYTES - LDSCTL_OFF) / 4; u += 512) ((LAS unsigned*)(lds + LDSCTL_OFF))[u] = 0u;
    __syncthreads();
    XcdBarrier bar = xcd_barrier_post(ctl + CW_BAR, (volatile LAS unsigned*)(lds + LDSCTL_OFF));
    int ph = 0;
#ifndef MK_MASK
#define MK_MASK 0xffff
#endif
#ifdef MK_TSET
    unsigned long long t_prev = __builtin_amdgcn_s_memrealtime(), t_acc = 0ull; int id_prev = -1;
#define T_STAMP(id) { const unsigned long long t_now = __builtin_amdgcn_s_memrealtime(); if (id_prev >= 0 && ((MK_TSET >> id_prev) & 1)) t_acc += t_now - t_prev; t_prev = t_now; id_prev = (id); }
#ifdef MK_TBAR
#define GRID_BAR { const unsigned long long tb0 = __builtin_amdgcn_s_memrealtime(); xcd_barrier(bar); t_acc += __builtin_amdgcn_s_memrealtime() - tb0; }
#else
#define GRID_BAR xcd_barrier(bar)
#endif
#else
#define T_STAMP(id)
#define GRID_BAR xcd_barrier(bar)
#endif
#define PHASE_BEGIN(id) if (ph++ >= a.ph_hi) return; T_STAMP(id) if ((MK_MASK >> (id)) & 1)
    float* sqb = (float*)ctl + CW_SQ;
#define SQ(l, id) (sqb + (size_t)((l) * SQ_PER_LAYER + (id)) * T)
    bf16_t* hb = (bf16_t*)(ws + WS_HB); bf16_t* assm = (bf16_t*)(ws + WS_ASSM); const float* cs = (const float*)(ws + WS_CS);
    unsigned char* ra = ws + WS_RA;
    pg8::StaticOrder SO;
    const long NEVER = 1 << 30;

#ifndef MK_REP_PRO
#define MK_REP_PRO 1
#define MK_REP_PARTS 7
#define MK_REP_ATTN 1
#define MK_REP_P9 1
#endif
    PHASE_BEGIN(0) { for (int rep = 0; rep < MK_REP_PRO; ++rep) prologue(a.in, a.fr, ws, lds, vcu, G, rep ? MK_REP_PARTS : 7); } GRID_BAR;
    PHASE_BEGIN(1) {
        const char* A0 = (const char*)(ra + RA_MEMN); const char* B0 = (const char*)(ws + WS_WXKV); bf16_t* kvm = (bf16_t*)(ra + RA_KVM);
        SO.init(8, 16, G, bx);
        auto PN = make_panel([=](const pg8::Unit& u, const char*& pa, const char*& pb) { pa = A0 + (size_t)u.pm * 256 * 1024 * 2; pb = B0 + (size_t)u.pn * 256 * 1024 * 2; });
        auto E = make_store([=](const pg8::Unit& u, int& ld) -> bf16_t* { ld = 2048; return kvm + ((size_t)(u.pn >> 3) * 2048 + u.pm * 256) * 2048 + (u.pn & 7) * 256; });
        pg8::gemm_phase(lds, pg8::GemmArgs{1024, 1024, 1024, (int)NEVER, 0}, SO, PN, E);
    } GRID_BAR;
    PHASE_BEGIN(2) {
        const char* kvm = (const char*)(ra + RA_KVM); bf16_t* wkvw = (bf16_t*)(ws + WS_WKVW);
        { SO.init(64, 4, G, bx);
          const char* wx = (const char*)(ws + WS_W + WL_XQ);
          auto PN = make_panel([=](const pg8::Unit& u, const char*& pa, const char*& pb) { const int l = u.pm >> 5, b = (u.pm >> 2) & 7, h = u.pm & 3;
              pa = kvm + (((size_t)l * 2048 + b * 256) * 2048 + h * 256) * 2; pb = wx + (size_t)l * WL_STRIDE + ((size_t)u.pn * 256 * 1024 + h * 256) * 2; });
          auto E = make_store([=](const pg8::Unit& u, int& ld) -> bf16_t* { const int l = u.pm >> 5, b = (u.pm >> 2) & 7, h = u.pm & 3; ld = 1024;
              return wkvw + ((size_t)(l * 16 + b) << 20) + (size_t)(h * 256) * 1024 + u.pn * 256; });
          pg8::gemm_phase(lds, pg8::GemmArgs{256, 2048, 1024, (int)NEVER, 0}, SO, PN, E); }
        { SO.init(256, 1, G, bx);
          const char* wo = (const char*)(ws + WS_WXO);
          auto PN = make_panel([=](const pg8::Unit& u, const char*& pa, const char*& pb) { const int rt = u.pm & 3, h = (u.pm >> 2) & 3, b = (u.pm >> 4) & 7, l = u.pm >> 7;
              pa = wo + (((size_t)l * 1024 + rt * 256) * 1024 + h * 256) * 2; pb = kvm + (((size_t)l * 2048 + b * 256) * 2048 + 1024 + h * 256) * 2; });
          auto E = make_store([=](const pg8::Unit& u, int& ld) -> bf16_t* { const int rt = u.pm & 3, h = (u.pm >> 2) & 3, b = (u.pm >> 4) & 7, l = u.pm >> 7; ld = 1024;
              return wkvw + ((size_t)(l * 16 + 8 + b) << 20) + (size_t)(rt * 256) * 1024 + h * 256; });
          pg8::gemm_phase(lds, pg8::GemmArgs{256, 1024, 2048, (int)NEVER, 0}, SO, PN, E); }
    } GRID_BAR;

    for (int l = 0; l < NL; ++l) {
        const char* wl = (const char*)(ws + WS_W + (size_t)l * WL_STRIDE);
        PHASE_BEGIN(3) {
            SO.init(128, 4, G, bx);
            auto PN = make_panel([=](const pg8::Unit& u, const char*& pa, const char*& pb) { pa = (const char*)hb + (size_t)u.pm * 256 * 1024 * 2; pb = wl + WL_IN + (size_t)u.pn * 256 * 1024 * 2; });
            ep::EpiProj E{SQ(l, SQ_MIX), SQ(l, SQ_CQ), SQ(l, SQ_CKV), (bf16_t*)(ra + RA_PROJB), assm, ra + RA_K, cs};
            pg8::gemm_phase(lds, pg8::GemmArgs{1024, 1024, 1024, (int)NEVER, 0}, SO, PN, E);
        } GRID_BAR;
        PHASE_BEGIN(4) {
            const char* pj = (const char*)(ra + RA_PROJB);
            { SO.init(128, 3, G, bx);
              auto PN = make_panel([=](const pg8::Unit& u, const char*& pa, const char*& pb) { pa = pj + (size_t)u.pm * 256 * 512 * 2; pb = wl + WL_UP + (size_t)u.pn * 256 * 256 * 2; });
              ep::EpiQ E{SQ(l, SQ_CQ), (bf16_t*)(ra + RA_Q), cs};
              pg8::gemm_phase(lds, pg8::GemmArgs{256, 512, 256, (int)NEVER, 0}, SO, PN, E); }
            { SO.init(128, 4, G, bx);
              auto PN = make_panel([=](const pg8::Unit& u, const char*& pa, const char*& pb) { pa = pj + (size_t)u.pm * 256 * 512 * 2 + 512; pb = wl + WL_UP + (size_t)(u.pn + 3) * 256 * 256 * 2; });
              ep::EpiKV E{SQ(l, SQ_CKV), ra + RA_K, ra + RA_V};
              pg8::gemm_phase(lds, pg8::GemmArgs{256, 512, 256, (int)NEVER, 0}, SO, PN, E); }
            { SO.init(128, 1, G, (bx + G / 2) % G);
              const char* bt = (const char*)(ws + WS_SSM) + (size_t)l * 32 * SSM_G_STRIDE;
              auto PN = make_panel([=](const pg8::Unit& u, const char*& pa, const char*& pb) { pa = (const char*)assm + (size_t)u.pm * 256 * KS3 * 2; pb = bt + (size_t)(u.pm >> 2) * SSM_G_STRIDE; });
              ep::EpiXloc E{(float*)(ra + RA_XLOC)};
              pg8::gemm_phase(lds, pg8::GemmArgs{KS1, KS3, KS1, (int)NEVER, 0}, SO, PN, E); }
        } GRID_BAR;
        PHASE_BEGIN(5) {
            ssm_scan_phase(vcu, G, (const float*)(ra + RA_XLOC), (const float*)(ws + WS_AL) + (size_t)l * 32 * 64 * 2, assm);
            for (int rep = 0; rep < MK_REP_ATTN; ++rep) att::attn_phase(vcu, G, (const bf16_t*)(ra + RA_Q), ra + RA_K, ra + RA_V, (bf16_t*)(ra + RA_AO), rep ? SQ(2, 1) : SQ(l, SQ_A), lds);
        } GRID_BAR;
        PHASE_BEGIN(6) {
            SO.init(128, 2, G, bx);
            const char* bt = (const char*)(ws + WS_SSM) + (size_t)l * 32 * SSM_G_STRIDE + SSM_BT3_OFF;
            auto PN = make_panel([=](const pg8::Unit& u, const char*& pa, const char*& pb) { pa = (const char*)assm + (size_t)u.pm * 256 * KS3 * 2; pb = bt + (size_t)(u.pm >> 2) * SSM_G_STRIDE + (size_t)u.pn * 256 * KS3 * 2; });
            ep::EpiY E{(bf16_t*)(ra + RA_Y), (bf16_t*)(ra + RA_G)};
            pg8::gemm_phase(lds, pg8::GemmArgs{KS3, KS3, KS3, (int)NEVER, 0}, SO, PN, E);
        } GRID_BAR;
        PHASE_BEGIN(7) {
            SO.init(128, 2, G, bx);
            const char* gb = (const char*)(ra + RA_G);
            auto PN = make_panel([=](const pg8::Unit& u, const char*& pa, const char*& pb) { pa = gb + (size_t)u.pm * 256 * 512 * 2; pb = wl + WL_GLU + (size_t)u.pn * 256 * 512 * 2; });
            ep::EpiGlu E{(const bf16_t*)(ra + RA_Y), a.in.b_glu + l * 512, (bf16_t*)(ra + RA_SOUT), SQ(l, SQ_S)};
            pg8::gemm_phase(lds, pg8::GemmArgs{512, 512, 512, (int)NEVER, 0}, SO, PN, E);
        } GRID_BAR;
        PHASE_BEGIN(8) {
            SO.init(128, 4, G, bx);
            const char* ao = (const char*)(ra + RA_AO);
            auto PN = make_panel([=](const pg8::Unit& u, const char*& pa, const char*& pb) { pa = ao + (size_t)u.pm * 256 * 512 * 2; pb = wl + WL_OUT + (size_t)u.pn * 256 * 1024 * 2; });
            ep::EpiRes<true> E{l == 0 ? a.in.x : nullptr, nullptr, hb, SQ(l, SQ_X), SQ(l, SQ_A), SQ(l, SQ_S)};
            pg8::gemm_phase(lds, pg8::GemmArgs{1024, 512, 1024, 8, (long)(RA_SOUT - RA_AO) - 8 * 128}, SO, PN, E);
        } GRID_BAR;
        PHASE_BEGIN(9) {
            SO.init(128, 4, G, bx);
            const char* wk = (const char*)(ws + WS_WKVW) + ((size_t)(l * 16) << 21);
            auto PN = make_panel([=](const pg8::Unit& u, const char*& pa, const char*& pb) { pa = (const char*)hb + (size_t)u.pm * 256 * 1024 * 2; pb = wk + ((size_t)(u.pm >> 4) << 21) + (size_t)u.pn * 256 * 1024 * 2; });
            ep::EpiSoftmax E{SQ(l, SQ_X), (bf16_t*)(ra + RA_P)};
            pg8::gemm_phase(lds, pg8::GemmArgs{1024, 1024, 1024, (int)NEVER, 0}, SO, PN, E);
        } GRID_BAR;
        PHASE_BEGIN(10) {
            SO.init(128, 4, G, bx);
            const char* vw = (const char*)(ws + WS_WKVW) + ((size_t)(l * 16 + 8) << 21); const char* pp = (const char*)(ra + RA_P);
            auto PN = make_panel([=](const pg8::Unit& u, const char*& pa, const char*& pb) { pa = pp + (size_t)u.pm * 256 * 1024 * 2; pb = vw + ((size_t)(u.pm >> 4) << 21) + (size_t)u.pn * 256 * 1024 * 2; });
            ep::EpiRes<false> E{nullptr, nullptr, hb, SQ(l, SQ_FFN), nullptr, nullptr};
            pg8::gemm_phase(lds, pg8::GemmArgs{1024, 1024, 1024, (int)NEVER, 0}, SO, PN, E);
        } GRID_BAR;
        PHASE_BEGIN(11) {
            SO.init(128, 22, G, bx);
            auto PN = make_panel([=](const pg8::Unit& u, const char*& pa, const char*& pb) { pa = (const char*)hb + (size_t)u.pm * 256 * 1024 * 2; pb = wl + WL_GU + (size_t)u.pn * 256 * 1024 * 2; });
            ep::EpiSwiglu E{SQ(l, SQ_FFN), (bf16_t*)(ra + RA_HID)};
            for (int rep = 0; rep < MK_REP_P9; ++rep) pg8::gemm_phase(lds, pg8::GemmArgs{1024, 1024, 1024, (int)NEVER, 0}, SO, PN, E);
        } GRID_BAR;
        PHASE_BEGIN(12) {
            SO.init(128, 4, G, bx);
            const char* hd = (const char*)(ra + RA_HID);
            auto PN = make_panel([=](const pg8::Unit& u, const char*& pa, const char*& pb) { pa = hd + (size_t)u.pm * 256 * FF * 2; pb = wl + WL_DN + (size_t)u.pn * 256 * FF * 2; });
            ep::EpiRes<false> E{nullptr, l == NL - 1 ? out : nullptr, hb, SQ(l + 1, SQ_MIX), nullptr, nullptr};
            pg8::gemm_phase(lds, pg8::GemmArgs{FF, FF, FF, (int)NEVER, 0}, SO, PN, E);
        } GRID_BAR;
    }
    PHASE_BEGIN(13) {
        const float* sqf = SQ(NL, SQ_MIX); const float* gf = a.in.final_g;
        for (int r = vcu * 8 + wave; r < T; r += G * 8) { const float rs = rstd_of(sqf[r], 1.0f / 1024.0f); f32x4* orow = (f32x4*)(out + (size_t)r * D) + lane; const f32x4* gr = (const f32x4*)gf + lane;
#pragma unroll
            for (int j = 0; j < 4; ++j) orow[64 * j] = orow[64 * j] * rs * gr[64 * j]; }
    }
#ifdef MK_TSET
    T_STAMP(14)
    if (blockIdx.x == 0) { const unsigned long long t_end = __builtin_amdgcn_s_memrealtime(); while (__builtin_amdgcn_s_memrealtime() - t_end < t_acc) __builtin_amdgcn_s_sleep(8); }
#endif
#undef PHASE_BEGIN
#undef GRID_BAR
#undef SQ
}

extern "C" void kernel_launch(void* const* d_in, const int* in_sizes, int n_in, void* d_out, int out_size, void* d_ws, size_t ws_size, hipStream_t stream) {
    static int grid = 0;
    if (grid == 0) {
        if (n_in != 32 || out_size != T * D || ws_size < WS_END) { fprintf(stderr, "kernel_launch: unexpected shapes (n_in %d out %d ws %zu)\n", n_in, out_size, ws_size); grid = -1; return; }
        int dev = 0, cus = 0, per_cu = 0;
        if (hipGetDevice(&dev) != hipSuccess || hipDeviceGetAttribute(&cus, hipDeviceAttributeMultiprocessorCount, dev) != hipSuccess) { grid = -1; return; }
        if (hipFuncSetAttribute((const void*)mk_fwd, hipFuncAttributeMaxDynamicSharedMemorySize, LDS_BYTES) != hipSuccess) { fprintf(stderr, "kernel_launch: hipFuncSetAttribute failed\n"); grid = -1; return; }
        if (hipOccupancyMaxActiveBlocksPerMultiprocessor(&per_cu, (const void*)mk_fwd, 512, LDS_BYTES) != hipSuccess || per_cu < 1) { fprintf(stderr, "kernel_launch: occupancy query says %d\n", per_cu); per_cu = 1; }
        (void)hipGetLastError();
        grid = cus;
    }
    if (grid < 0) return;
    if (hipMemsetAsync((char*)d_ws + WS_CTL, 0, CTL_ZERO_BYTES, stream) != hipSuccess) return;
    Args a{};
    const void** ip = (const void**)&a.in;
    for (int i = 0; i < 32; ++i) ip[i] = d_in[i];
    a.out = (float*)d_out; a.ws = (unsigned char*)d_ws;
    for (int i = 0; i < 16; ++i) a.fr.f[i] = std::pow(10000.0, -(double)i / 16.0);
#ifndef MK_PH_HI
#define MK_PH_HI 1000
#endif
    a.ph_hi = MK_PH_HI; a.pad = 0;
    void* args[] = {&a};
    hipError_t e = hipLaunchCooperativeKernel((const void*)mk_fwd, dim3(grid), dim3(512), args, LDS_BYTES, stream);
    if (e != hipSuccess) fprintf(stderr, "kernel_launch: cooperative launch failed: %s (grid %d)\n", hipGetErrorString(e), grid);
}
```

```cpp
#include <hip/hip_runtime.h>
#include <hip/hip_bf16.h>
#include <cstdint>
#include <cstdio>
#include <cmath>

#define LAS __attribute__((address_space(3)))
typedef unsigned short bf16_t;
typedef short bf16x8 __attribute__((ext_vector_type(8)));
typedef short s16x4 __attribute__((ext_vector_type(4)));
typedef float f32x4 __attribute__((ext_vector_type(4)));
typedef float f32x2 __attribute__((ext_vector_type(2)));
typedef float f32x16 __attribute__((ext_vector_type(16)));
typedef unsigned u32x4 __attribute__((ext_vector_type(4)));
typedef unsigned u32x2 __attribute__((ext_vector_type(2)));

constexpr int D = 1024, NB = 8, S = 4096, T = NB * S, NL = 2, FF = 2816;
constexpr int NH = 8, QKD = 96, HD = 64;
constexpr int LC = 32, KS1 = 16 * LC  , KS3 = KS1 + 128  , NCHB = S / LC  , NCH = T / LC  ;
constexpr int MEMT = 256;
constexpr float EPS = 1e-6f;
constexpr float LOG2E = 1.4426950408889634f;

constexpr size_t MiB = 1u << 20;
constexpr size_t WS_CTL = 0, CTL_ZERO_BYTES = 4 * MiB;
constexpr size_t WS_CS = 4 * MiB;
constexpr size_t WS_W = 8 * MiB;
constexpr size_t WL_IN = 0, WL_UP = 2 * MiB, WL_GLU = 3 * MiB, WL_OUT = 3 * MiB + 512 * 1024, WL_XQ = 5 * MiB + 512 * 1024, WL_GU = 7 * MiB + 512 * 1024, WL_DN = 18 * MiB + 512 * 1024, WL_STRIDE = 24 * MiB + 512 * 1024;
constexpr size_t WS_WXKV = WS_W + 2 * WL_STRIDE;
constexpr size_t WS_WXO = WS_WXKV + 8 * MiB;
constexpr size_t WS_SSM = 70 * MiB;
constexpr size_t SSM_G_STRIDE = 896 * 1024, SSM_BT3_OFF = 256 * 1024;
constexpr size_t WS_AL = 126 * MiB;
constexpr size_t WS_WKVW = 128 * MiB;
constexpr size_t WS_HB = 192 * MiB;
constexpr size_t WS_ASSM = 256 * MiB;
constexpr size_t WS_RA = 296 * MiB;
constexpr size_t WS_END = WS_RA + 176 * MiB;
constexpr size_t RA_PROJB = 0, RA_AO = 0, RA_Q = 32 * MiB, RA_K = 80 * MiB, RA_V = 128 * MiB, RA_XLOC = 160 * MiB;
constexpr size_t RA_Y = 32 * MiB, RA_G = 64 * MiB, RA_SOUT = 96 * MiB;
constexpr size_t RA_P = 0, RA_HID = 0, RA_MEMN = 0, RA_KVM = 4 * MiB;
constexpr int CW_BAR = 4096;
constexpr int CW_SQ = 65536;
enum SqId { SQ_MIX = 0, SQ_CQ = 1, SQ_CKV = 2, SQ_A = 3, SQ_S = 4, SQ_X = 5, SQ_FFN = 6, SQ_PER_LAYER = 7 };
static_assert((size_t)(CW_SQ + 16 * T) * 4 <= CTL_ZERO_BYTES, "ctl");

constexpr int RING_BYTES = 131072, XCH_OFF = RING_BYTES  , LDSCTL_OFF = XCH_OFF + 12288, LDS_BYTES = 147456;

__device__ __forceinline__ unsigned cvt_pk_bf16(float lo, float hi) { typedef __bf16 bf2 __attribute__((ext_vector_type(2))); f32x2 v = {lo, hi}; bf2 b = __builtin_convertvector(v, bf2); return __builtin_bit_cast(unsigned, b); }
__device__ __forceinline__ float bf_lo(unsigned w) { return __uint_as_float(w << 16); }
__device__ __forceinline__ float bf_hi(unsigned w) { return __uint_as_float(w & 0xffff0000u); }
__device__ __forceinline__ float rstd_of(float sq, float inv_n) { return rsqrtf(sq * inv_n + EPS); }

#define XB_TMO      128
#define XB_XCNT(j)  (256  + 64 * (j))
#define XB_XSUB(j)  (1280 + 64 * (j))
#define XB_XGEN(j)  (2304 + 64 * (j))
#define XB_TOP      3328
#define XB_TOPGEN   3392
#define XCD_BAR_WORDS 3456
#define XB_SPIN_CAP (1u << 20)
__device__ __forceinline__ unsigned xb_ld(unsigned* p)              { return __hip_atomic_load(p, __ATOMIC_RELAXED, __HIP_MEMORY_SCOPE_AGENT); }
__device__ __forceinline__ unsigned xb_add(unsigned* p, unsigned v) { return __hip_atomic_fetch_add(p, v, __ATOMIC_RELAXED, __HIP_MEMORY_SCOPE_AGENT); }
__device__ __forceinline__ unsigned xb_xcc_id() { return (unsigned)__builtin_amdgcn_s_getreg((3 << 11) | 20) & 0xFu; }
#define XB_SPIN(cond, bar) do { unsigned _sp = 0; while (cond) { __builtin_amdgcn_s_sleep(1); \
    if ((++_sp & 255u) == 0u) { if (xb_ld(&(bar)[XB_TMO])) break; if (_sp > XB_SPIN_CAP) { atomicAdd(&(bar)[XB_TMO], 1u); break; } } } } while (0)
struct XcdBarrier { unsigned* bar; unsigned x; volatile LAS unsigned* st; };
__device__ __forceinline__ XcdBarrier xcd_barrier_post(unsigned* bar, volatile LAS unsigned* st) {
    XcdBarrier b; b.bar = bar; b.x = xb_xcc_id(); b.st = st;
    if (threadIdx.x == 0) (void)xb_add(&bar[XB_XCNT(b.x)], 1u);
    return b;
}
__device__ __forceinline__ void xcd_barrier_complete(unsigned* bar, unsigned x, unsigned& nloc, unsigned& nx) {
    const unsigned G = gridDim.x * gridDim.y * gridDim.z;
    unsigned sum, cnt, mine, sp = 0u;
    for (;;) {
        sum = 0u; cnt = 0u; mine = 0u;
#pragma unroll
        for (unsigned j = 0; j < 16; ++j) { const unsigned c = xb_ld(&bar[XB_XCNT(j)]); sum += c; cnt += (c > 0u) ? 1u : 0u; mine = (j == x) ? c : mine; }
        if (sum == G) break;
        __builtin_amdgcn_s_sleep(1);
        if ((++sp & 255u) == 0u) { if (xb_ld(&bar[XB_TMO])) break; if (sp > XB_SPIN_CAP) { atomicAdd(&bar[XB_TMO], 1u); break; } }
    }
    nloc = mine > 0u ? mine : 1u; nx = cnt > 0u ? cnt : 1u;
}
__device__ __forceinline__ void xcd_barrier(const XcdBarrier& b) {
    asm volatile("s_waitcnt vmcnt(0)" ::: "memory");
    __syncthreads();
    if (threadIdx.x == 0) {
        unsigned* bar = b.bar; asm volatile("" : "+s"(bar));
        __builtin_amdgcn_s_waitcnt(0);
        unsigned nloc = b.st[0], nx = b.st[1];
        if (nloc == 0u) { xcd_barrier_complete(bar, b.x, nloc, nx); b.st[0] = nloc; b.st[1] = nx; }
        const unsigned old = xb_add(&bar[XB_XSUB(b.x)], 1u);
        const unsigned gen = old / nloc;
        if (old + 1u == (gen + 1u) * nloc) {
            __builtin_amdgcn_fence(__ATOMIC_RELEASE, "agent");
            asm volatile("s_waitcnt vmcnt(0)" ::: "memory");
            const unsigned og = xb_add(&bar[XB_TOP], 1u);
            const unsigned tg = og / nx;
            if (og + 1u == (tg + 1u) * nx) xb_add(&bar[XB_TOPGEN], 1u);
            else XB_SPIN(xb_ld(&bar[XB_TOPGEN]) == tg, bar);
            __builtin_amdgcn_fence(__ATOMIC_ACQUIRE, "agent");
            xb_add(&bar[XB_XGEN(b.x)], 1u);
            asm volatile("s_waitcnt vmcnt(0)" ::: "memory");
        } else {
            XB_SPIN(xb_ld(&bar[XB_XGEN(b.x)]) == gen, bar);
            __builtin_amdgcn_fence(__ATOMIC_ACQUIRE, "agent");
            asm volatile("s_waitcnt vmcnt(0)" ::: "memory");
        }
    }
    __syncthreads();
}

namespace pg8 {
constexpr int BM = 256, BK = 64, HALF = 128, HTB = HALF * BK * 2, STAGE_BYTES = 8 * HTB, NXCD = 8, WGM = 8;
__host__ __device__ __forceinline__ int lds_byte(int r, int c) { const int st = (r >> 4) * 2 + (c >> 5), rr = r & 15, cc = c & 31, ob = rr * 64 + cc * 2; return st * 1024 + (ob ^ (((ob >> 9) & 1) << 5)); }
__host__ __device__ __forceinline__ void stage_rc(int b, int& R, int& C) { const int st = b / 1024, sb = b % 1024, swz = sb ^ (((sb >> 9) & 1) << 5); R = (st >> 1) * 16 + swz / 64; C = (st & 1) * 32 + (swz % 64) / 2; }
__host__ __device__ __forceinline__ int perm32(int rho) { const int n = rho >> 4, i = rho & 15; return 8 * (i >> 2) + 4 * n + (i & 3); }
struct Unit { int pm, pn; };
struct StaticOrder {
    int nM, nN, nwg, G, c;
    __device__ void init(int nM_, int nN_, int G_, int c_) { nM = nM_; nN = nN_; nwg = nM * nN; G = G_; c = c_; }
    __device__ bool next(int i, Unit& u) const {
        const long L = (long)i * G + c; if (L >= nwg) return false;
        int wgid = (int)L; { const int q = nwg / NXCD, r = nwg % NXCD, xcd = wgid % NXCD, off = wgid / NXCD; wgid = (xcd < r ? xcd * (q + 1) : r * (q + 1) + (xcd - r) * q) + off; }
        const int nig = WGM * nN, gid = wgid / nig, fm = gid * WGM, gsz = (nM - fm) < WGM ? (nM - fm) : WGM;
        u.pm = fm + ((wgid % nig) % gsz); u.pn = (wgid % nig) / gsz; return true;
    }
};
struct Ctx { int wr, wc, fr, fq, wid, lane, tid; LAS unsigned char* lds; };
typedef f32x4 Acc[2][2][4][2];

struct GemmArgs { int K, lda, ldb, tsplit; long a_delta; };

template <class Epi, class Panel>
__device__ __forceinline__ void gemm_phase(LAS unsigned char* lds, const GemmArgs g, const StaticOrder& S, const Panel& PN, const Epi& E) {
    int tid_ = threadIdx.x; asm volatile("" : "+v"(tid_));
    const int tid = tid_, wid = __builtin_amdgcn_readfirstlane(tid >> 6), lane = tid & 63, wr = wid >> 2, wc = wid & 3, fr = lane & 15, fq = lane >> 4;
    const int nt = g.K / BK;
    Ctx cx{wr, wc, fr, fq, wid, lane, tid, lds};
    unsigned voffA[2], voffB[2];
#pragma unroll
    for (int i = 0; i < 2; ++i) { int R, C; stage_rc(tid * 16 + i * 8192, R, C); const int Rb = (R & ~31) + perm32(R & 31);
        voffA[i] = (unsigned)(R * g.lda + C) * 2u; voffB[i] = (unsigned)(Rb * g.ldb + C) * 2u; }
    const size_t kstep = (size_t)(BK * 2);
    const size_t hstepA = (size_t)HALF * g.lda * 2, hstepB = (size_t)HALF * g.ldb * 2;
    const unsigned ldsw = (unsigned)wid * 1024u;
    const int aoff = lds_byte(wr * 64 + fr, fq * 8), boff = lds_byte(wc * 32 + fr, fq * 8);
#define PG8_SA(b, h) (((b) * 2 + (h)) * HTB)
#define PG8_SB(b, h) ((4 + (b) * 2 + (h)) * HTB)
#define PG8_STAGE(bufoff, gbase, voff) do { _Pragma("unroll") for (int _i = 0; _i < 2; ++_i) \
        __builtin_amdgcn_global_load_lds((const unsigned*)((const char*)(gbase) + (voff)[_i]), (LAS unsigned*)(lds + (bufoff) + ldsw + _i * 8192), 16, 0, 0); } while (0)
#define PG8_LDA(dst, b, h) do { _Pragma("unroll") for (int m = 0; m < 4; ++m) _Pragma("unroll") for (int k = 0; k < 2; ++k) dst[m][k] = *(const LAS bf16x8*)(lds + PG8_SA(b, h) + aoff + m * 2048 + k * 1024); } while (0)
#define PG8_LDB(dst, b, h) do { _Pragma("unroll") for (int n = 0; n < 2; ++n) _Pragma("unroll") for (int k = 0; k < 2; ++k) dst[n][k] = *(const LAS bf16x8*)(lds + PG8_SB(b, h) + boff + n * 2048 + k * 1024); } while (0)
#define PG8_MMA(ai, bj, At, Bt) do { __builtin_amdgcn_s_setprio(1); _Pragma("unroll") for (int m = 0; m < 4; ++m) _Pragma("unroll") for (int n = 0; n < 2; ++n) _Pragma("unroll") for (int k = 0; k < 2; ++k) \
        acc[ai][bj][m][n] = __builtin_amdgcn_mfma_f32_16x16x32_bf16(Bt[n][k], At[m][k], acc[ai][bj][m][n], 0, 0, 0); __builtin_amdgcn_s_setprio(0); } while (0)
#define PG8_WAIT_V(n) asm volatile("s_waitcnt vmcnt(" #n ")" ::: "memory")
#define PG8_WAIT_L(n) asm volatile("s_waitcnt lgkmcnt(" #n ")" ::: "memory")
#define PG8_BAR __builtin_amdgcn_s_barrier()
#define PG8_SCHED __builtin_amdgcn_sched_barrier(0)
#define PG8_AP(base, tt) ((base) + (size_t)(tt) * kstep + (((tt) >= g.tsplit) ? g.a_delta : 0l))
    Unit cur, nxt; int ui = 0;
    if (!S.next(0, cur)) return;
    Acc acc;
#pragma unroll
    for (int a = 0; a < 2; ++a)
#pragma unroll
        for (int b = 0; b < 2; ++b)
#pragma unroll
            for (int m = 0; m < 4; ++m)
#pragma unroll
                for (int n = 0; n < 2; ++n) acc[a][b][m][n] = (f32x4){0.f, 0.f, 0.f, 0.f};
    bf16x8 At[4][2], B0[2][2], B1[2][2];
    const char* cA; const char* cB; PN(cur, cA, cB);
    if constexpr (Epi::HAS_BEGIN) E.begin(cur, cx, ui);
    PG8_STAGE(PG8_SB(0, 0), cB, voffB); PG8_STAGE(PG8_SB(0, 1), cB + hstepB, voffB); PG8_STAGE(PG8_SA(0, 0), cA, voffA); PG8_STAGE(PG8_SA(0, 1), cA + hstepA, voffA);
    if (wr == 1) PG8_BAR;
    PG8_WAIT_V(2); PG8_BAR;
    PG8_STAGE(PG8_SB(1, 0), cB + kstep, voffB); PG8_STAGE(PG8_SA(1, 0), cA + kstep, voffA); PG8_STAGE(PG8_SB(1, 1), cB + hstepB + kstep, voffB);
    PG8_WAIT_V(6); PG8_BAR;
    for (;;) {
        const bool has_next = S.next(ui + 1, nxt);
        const char* nA = cA; const char* nB = cB; if (has_next) PN(nxt, nA, nB);
#pragma unroll 1
        for (int t = 0; t < nt; t += 2) {
            const bool last = (t == nt - 2);
            if constexpr (Epi::HAS_MID) { if (t == g.tsplit) E.mid(acc, cur, cx, ui); }
            const char* a1 = PG8_AP(cA, t + 1);
            const char* a2 = last ? nA : PG8_AP(cA, t + 2); const char* b2 = last ? nB : cB + (size_t)(t + 2) * kstep;
            const char* a3 = last ? nA + kstep : PG8_AP(cA, t + 3); const char* b3 = b2 + kstep;
            PG8_LDB(B0, 0, 0); PG8_LDB(B1, 0, 1); PG8_SCHED; PG8_LDA(At, 0, 0); PG8_STAGE(PG8_SA(1, 1), a1 + hstepA, voffA);
            PG8_WAIT_V(8); PG8_WAIT_L(0); PG8_BAR; PG8_MMA(0, 0, At, B0); PG8_MMA(0, 1, At, B1); PG8_BAR; PG8_SCHED;
            PG8_LDA(At, 0, 1); PG8_STAGE(PG8_SB(0, 0), b2, voffB); PG8_STAGE(PG8_SB(0, 1), b2 + hstepB, voffB); PG8_STAGE(PG8_SA(0, 0), a2, voffA);
            PG8_WAIT_V(8); PG8_WAIT_L(0); PG8_BAR; PG8_MMA(1, 0, At, B0); PG8_MMA(1, 1, At, B1); PG8_BAR; PG8_SCHED;
            PG8_LDB(B0, 1, 0); PG8_LDB(B1, 1, 1); PG8_SCHED; PG8_LDA(At, 1, 0); PG8_STAGE(PG8_SA(0, 1), a2 + hstepA, voffA);
            PG8_WAIT_V(8); PG8_WAIT_L(0); PG8_BAR; PG8_MMA(0, 0, At, B0); PG8_MMA(0, 1, At, B1); PG8_BAR; PG8_SCHED;
            PG8_LDA(At, 1, 1); PG8_STAGE(PG8_SB(1, 0), b3, voffB); PG8_STAGE(PG8_SB(1, 1), b3 + hstepB, voffB); PG8_STAGE(PG8_SA(1, 0), a3, voffA);
            PG8_WAIT_V(8); PG8_WAIT_L(0); PG8_BAR; PG8_MMA(1, 0, At, B0); PG8_MMA(1, 1, At, B1); PG8_BAR; PG8_SCHED;
        }
        if (wr == 0) PG8_BAR;
        E(acc, cur, cx, ui);
        if (!has_next) break;
#pragma unroll
        for (int a = 0; a < 2; ++a)
#pragma unroll
            for (int b = 0; b < 2; ++b)
#pragma unroll
                for (int m = 0; m < 4; ++m)
#pragma unroll
                    for (int n = 0; n < 2; ++n) acc[a][b][m][n] = (f32x4){0.f, 0.f, 0.f, 0.f};
        cur = nxt; cA = nA; cB = nB; ++ui;
        if constexpr (Epi::HAS_BEGIN) E.begin(cur, cx, ui);
        if (wr == 1) PG8_BAR;
    }
    PG8_WAIT_V(0);
    PG8_BAR;
    asm volatile("" ::: "memory");
#undef PG8_SA
#undef PG8_SB
#undef PG8_STAGE
#undef PG8_LDA
#undef PG8_LDB
#undef PG8_MMA
#undef PG8_WAIT_V
#undef PG8_WAIT_L
#undef PG8_BAR
#undef PG8_SCHED
#undef PG8_AP
}
}
namespace ep {
using pg8::Acc; using pg8::Ctx; using pg8::Unit;
#define EP_FOR_ROWS _Pragma("unroll") for (int ai = 0; ai < 2; ++ai) _Pragma("unroll") for (int m = 0; m < 4; ++m)
#define EP_RU (ai * 128 + cx.wr * 64 + m * 16)
#define EP_FENCE asm volatile("" ::: "memory")
#define EP_PRELOAD_RS(name, sqp, invn) float name[2][4]; EP_FOR_ROWS name[ai][m] = (sqp)[u.pm * 256 + EP_RU + cx.fr]; EP_FOR_ROWS name[ai][m] = rstd_of(name[ai][m], invn);
__device__ __forceinline__ u32x4 pack8(const f32x4 a, const f32x4 b) { u32x4 w; w.x = cvt_pk_bf16(a[0], a[1]); w.y = cvt_pk_bf16(a[2], a[3]); w.z = cvt_pk_bf16(b[0], b[1]); w.w = cvt_pk_bf16(b[2], b[3]); return w; }
__device__ __forceinline__ float sq8(const f32x4 a, const f32x4 b) { return (a[0] * a[0] + a[1] * a[1]) + (a[2] * a[2] + a[3] * a[3]) + (b[0] * b[0] + b[1] * b[1]) + (b[2] * b[2] + b[3] * b[3]); }
__device__ __forceinline__ void row_atomic(float* sq_u, int fr, float ss, int fq) { ss += __shfl_xor(ss, 16); ss += __shfl_xor(ss, 32); if (fq == 0) unsafeAtomicAdd(sq_u + fr, ss); }
template <class TT> __device__ __forceinline__ TT* lane_ptr(TT* uni, unsigned lane_bytes) { return (TT*)((char*)uni + lane_bytes); }
template <class TT> __device__ __forceinline__ const TT* lane_ptr(const TT* uni, unsigned lane_bytes) { return (const TT*)((const char*)uni + lane_bytes); }
__device__ __forceinline__ void rope8(f32x4& a, f32x4& b, const f32x4 c4, const f32x4 s4) {
    const f32x4 a0 = a, b0 = b;
    a[0] = a0[0] * c4[0] - a0[1] * s4[0]; a[1] = a0[1] * c4[0] + a0[0] * s4[0]; a[2] = a0[2] * c4[1] - a0[3] * s4[1]; a[3] = a0[3] * c4[1] + a0[2] * s4[1];
    b[0] = b0[0] * c4[2] - b0[1] * s4[2]; b[1] = b0[1] * c4[2] + b0[0] * s4[2]; b[2] = b0[2] * c4[3] - b0[3] * s4[3]; b[3] = b0[3] * c4[3] + b0[2] * s4[3];
}
__device__ __forceinline__ size_t koff_u(int b, int h, int s16, int chunk) { return ((((size_t)(b * 8 + h) * 64 + (s16 >> 6)) * 12 + chunk) * 64 + (s16 & 63)) * 16; }
__device__ __forceinline__ size_t voff_u(int b, int h, int s16, int dh) { return ((((size_t)(b * 8 + h) * 64 + (s16 >> 6)) * 2 + dh) * 64 + (s16 & 63)) * 64; }

struct EpiProj {
    static constexpr bool HAS_MID = false, HAS_BEGIN = false;
    const float* sq_in; float* sq_cq; float* sq_ckv; bf16_t* projb; bf16_t* assm; unsigned char* kb; const float* cs;
    __device__ __forceinline__ void operator()(Acc& acc, const Unit& u, const Ctx& cx, int) const {
        const unsigned l_pj = (unsigned)(cx.fr * 512 + cx.fq * 8) * 2u, l_cs = (unsigned)(cx.fr * 32 + cx.fq * 4) * 4u, l_k = (unsigned)cx.fr * 16u, l_as = (unsigned)(cx.fr * 16) * 2u;
        EP_PRELOAD_RS(rsv, sq_in, 1.0f / 1024.0f)
        EP_FOR_ROWS { const int rowu = u.pm * 256 + EP_RU; const float rs = rsv[ai][m];
            if (u.pn == 0) { float ss = 0.f;
#pragma unroll
                for (int bj = 0; bj < 2; ++bj) { const f32x4 v0 = acc[ai][bj][m][0] * rs, v1 = acc[ai][bj][m][1] * rs; ss += sq8(v0, v1);
                    *(u32x4*)lane_ptr(projb + (size_t)rowu * 512 + bj * 128 + cx.wc * 32, l_pj) = pack8(v0, v1); }
                row_atomic(sq_cq + rowu, cx.fr, ss, cx.fq);
            } else if (u.pn == 1) {
                { const f32x4 v0 = acc[ai][0][m][0] * rs, v1 = acc[ai][0][m][1] * rs; *(u32x4*)lane_ptr(projb + (size_t)rowu * 512 + 256 + cx.wc * 32, l_pj) = pack8(v0, v1); row_atomic(sq_ckv + rowu, cx.fr, sq8(v0, v1), cx.fq); }
                f32x4 v0 = acc[ai][1][m][0] * rs, v1 = acc[ai][1][m][1] * rs;
                if (cx.wc != 0) { v0 = (f32x4){0.f, 0.f, 0.f, 0.f}; v1 = v0; }
                *(u32x4*)lane_ptr(projb + (size_t)rowu * 512 + 384 + cx.wc * 32, l_pj) = pack8(v0, v1);
                if (cx.wc == 0) { const float* cp = lane_ptr(cs + (size_t)rowu * 32, l_cs); const f32x4 c4 = *(const f32x4*)cp, s4 = *(const f32x4*)(cp + 16);
                    rope8(v0, v1, c4, s4); const u32x4 w = pack8(v0, v1); const int b = rowu >> 12, s16 = rowu & 4095;
#pragma unroll
                    for (int h = 0; h < 8; ++h) *(u32x4*)lane_ptr(kb + koff_u(b, h, s16, 8) , l_k + (unsigned)cx.fq * 1024u) = w; }
            } else {
#pragma unroll
                for (int bj = 0; bj < 2; ++bj) { const f32x4 v0 = acc[ai][bj][m][0] * rs, v1 = acc[ai][bj][m][1] * rs; const int chu = (u.pn - 2) * 256 + bj * 128 + cx.wc * 32;
                    *(u32x4*)lane_ptr(assm + ((size_t)(chu >> 4) * NCH + (rowu >> 5)) * KS3 + (rowu & 31) * 16, l_as + (unsigned)(cx.fq >> 1) * (unsigned)(NCH * KS3 * 2) + (unsigned)(cx.fq & 1) * 16u) = pack8(v0, v1); }
            }
            EP_FENCE;
        }
    }
};
struct EpiQ {
    static constexpr bool HAS_MID = false, HAS_BEGIN = false;
    const float* sq_cq; bf16_t* qb; const float* cs;
    __device__ __forceinline__ void operator()(Acc& acc, const Unit& u, const Ctx& cx, int) const {
        const unsigned l_q = (unsigned)(cx.fr * 768 + cx.fq * 8) * 2u, l_cs = (unsigned)(cx.fr * 32 + cx.fq * 4) * 4u;
        EP_PRELOAD_RS(rsv, sq_cq, 1.0f / 256.0f)
        EP_FOR_ROWS { const int rowu = u.pm * 256 + EP_RU; const float rs = rsv[ai][m];
            f32x4 c4 = (f32x4){1.f, 1.f, 1.f, 1.f}, s4 = (f32x4){0.f, 0.f, 0.f, 0.f}; if (u.pn == 2) { const float* cp = lane_ptr(cs + (size_t)rowu * 32, l_cs); c4 = *(const f32x4*)cp; s4 = *(const f32x4*)(cp + 16); }
#pragma unroll
            for (int bj = 0; bj < 2; ++bj) { f32x4 v0 = acc[ai][bj][m][0] * rs, v1 = acc[ai][bj][m][1] * rs;
                if (u.pn == 2) rope8(v0, v1, c4, s4);
                *(u32x4*)lane_ptr(qb + (size_t)rowu * 768 + u.pn * 256 + bj * 128 + cx.wc * 32, l_q) = pack8(v0, v1); }
            EP_FENCE; }
    }
};
struct EpiKV {
    static constexpr bool HAS_MID = false, HAS_BEGIN = false;
    const float* sq_ckv; unsigned char* kb; unsigned char* vb;
    __device__ __forceinline__ void operator()(Acc& acc, const Unit& u, const Ctx& cx, int) const {
        const unsigned l_kv = (cx.wc < 2) ? (unsigned)cx.fr * 16u + (unsigned)cx.fq * 1024u : (unsigned)cx.fr * 64u + (unsigned)cx.fq * 16u;
        EP_PRELOAD_RS(rsv, sq_ckv, 1.0f / 128.0f)
        EP_FOR_ROWS { const int rowu = u.pm * 256 + EP_RU; const float rs = rsv[ai][m]; const int b = rowu >> 12, s16 = rowu & 4095;
#pragma unroll
            for (int bj = 0; bj < 2; ++bj) { const f32x4 v0 = acc[ai][bj][m][0] * rs, v1 = acc[ai][bj][m][1] * rs; const int h = 2 * u.pn + bj;
                unsigned char* dst = (cx.wc < 2) ? kb + koff_u(b, h, s16, cx.wc * 4) : vb + voff_u(b, h, s16, cx.wc - 2);
                *(u32x4*)lane_ptr(dst, l_kv) = pack8(v0, v1); }
            EP_FENCE; }
    }
};
struct EpiXloc {
    static constexpr bool HAS_MID = false, HAS_BEGIN = false;
    float* xloc;
    __device__ __forceinline__ void operator()(Acc& acc, const Unit& u, const Ctx& cx, int) const {
        const unsigned l_x = (unsigned)(cx.fr * 128 + cx.fq * 8) * 4u;
        EP_FOR_ROWS { const int rowu = u.pm * 256 + EP_RU; float* o = lane_ptr(xloc + (size_t)rowu * 128 + cx.wc * 32, l_x); *(f32x4*)o = acc[ai][0][m][0]; *(f32x4*)(o + 4) = acc[ai][0][m][1]; EP_FENCE; }
    }
};
__device__ __forceinline__ float gelu_tanh_f(float x) { const float z = 0.7978845608028654f * (x + 0.044715f * x * x * x); return x * __builtin_amdgcn_rcpf(1.0f + __builtin_amdgcn_exp2f(-2.0f * LOG2E * z)); }
__device__ __forceinline__ f32x4 gelu4(const f32x4 v) { return (f32x4){gelu_tanh_f(v[0]), gelu_tanh_f(v[1]), gelu_tanh_f(v[2]), gelu_tanh_f(v[3])}; }
struct EpiY {
    static constexpr bool HAS_MID = false, HAS_BEGIN = false;
    bf16_t* yb; bf16_t* gb;
    __device__ __forceinline__ void operator()(Acc& acc, const Unit& u, const Ctx& cx, int) const {
        const unsigned l_y = (unsigned)((cx.fr * 32 + (cx.fq >> 1)) * 512 + (cx.fq & 1) * 8) * 2u;
        EP_FOR_ROWS { const int rowu = u.pm * 256 + EP_RU, g = rowu >> 10, chunku = rowu & 1023;
#pragma unroll
            for (int bj = 0; bj < 2; ++bj) { const int colu = u.pn * 256 + bj * 128 + cx.wc * 32; const size_t o = ((size_t)chunku * 32 + (colu >> 4)) * 512 + g * 16;
                const f32x4 v0 = acc[ai][bj][m][0], v1 = acc[ai][bj][m][1]; *(u32x4*)lane_ptr(yb + o, l_y) = pack8(v0, v1); *(u32x4*)lane_ptr(gb + o, l_y) = pack8(gelu4(v0), gelu4(v1)); }
            EP_FENCE;
        }
    }
};
__device__ __forceinline__ float sigm(float z) { return __builtin_amdgcn_rcpf(1.0f + __builtin_amdgcn_exp2f(-LOG2E * z)); }
struct EpiGlu {
    static constexpr bool HAS_MID = false, HAS_BEGIN = false;
    const bf16_t* yb; const float* bglu; bf16_t* sout; float* sq_s;
    __device__ __forceinline__ void operator()(Acc& acc, const Unit& u, const Ctx& cx, int) const {
        const unsigned l_y = (unsigned)(cx.fr * 512 + cx.fq * 8) * 2u, l_b = (unsigned)(cx.fq * 8) * 4u;
        f32x4 bv[2][2];
#pragma unroll
        for (int bj = 0; bj < 2; ++bj) { const float* bp = lane_ptr(bglu + u.pn * 256 + bj * 128 + cx.wc * 32, l_b); bv[bj][0] = *(const f32x4*)bp; bv[bj][1] = *(const f32x4*)(bp + 4); }
#pragma unroll
        for (int ai = 0; ai < 2; ++ai) { u32x4 yw[4][2];
#pragma unroll
            for (int m = 0; m < 4; ++m)
#pragma unroll
                for (int bj = 0; bj < 2; ++bj) yw[m][bj] = *(const u32x4*)lane_ptr(yb + (size_t)(u.pm * 256 + EP_RU) * 512 + u.pn * 256 + bj * 128 + cx.wc * 32, l_y);
#pragma unroll
            for (int m = 0; m < 4; ++m) { const int rowu = u.pm * 256 + EP_RU; float ss = 0.f;
#pragma unroll
                for (int bj = 0; bj < 2; ++bj) { const int colu = u.pn * 256 + bj * 128 + cx.wc * 32; const u32x4 w = yw[m][bj];
                    const f32x4 z0 = acc[ai][bj][m][0] + bv[bj][0], z1 = acc[ai][bj][m][1] + bv[bj][1];
                    const f32x4 v0 = (f32x4){bf_lo(w.x) * sigm(z0[0]), bf_hi(w.x) * sigm(z0[1]), bf_lo(w.y) * sigm(z0[2]), bf_hi(w.y) * sigm(z0[3])};
                    const f32x4 v1 = (f32x4){bf_lo(w.z) * sigm(z1[0]), bf_hi(w.z) * sigm(z1[1]), bf_lo(w.w) * sigm(z1[2]), bf_hi(w.w) * sigm(z1[3])};
                    ss += sq8(v0, v1); *(u32x4*)lane_ptr(sout + (size_t)rowu * 512 + colu, l_y) = pack8(v0, v1); }
                row_atomic(sq_s + rowu, cx.fr, ss, cx.fq); }
            EP_FENCE;
        }
    }
};
template <bool MIX> struct EpiRes {
    static constexpr bool HAS_MID = MIX, HAS_BEGIN = MIX;
    const float* hin32; float* hout32; bf16_t* hb; float* sq_next; const float* sq_a; const float* sq_s;
    __device__ __forceinline__ void begin(const Unit& u, const Ctx& cx, int ui) const {
        if (cx.tid < 256) { const int row = u.pm * 256 + cx.tid; const float ra = rstd_of(sq_a[row], 1.0f / 512.0f), rsd = rstd_of(sq_s[row], 1.0f / 512.0f);
            ((LAS f32x2*)(cx.lds + XCH_OFF + (ui & 1) * 2048))[cx.tid] = (f32x2){ra / rsd, rsd}; }
    }
    __device__ __forceinline__ void mid(Acc& acc, const Unit&, const Ctx& cx, int ui) const {
        const LAS f32x2* tab = (const LAS f32x2*)(cx.lds + XCH_OFF + (ui & 1) * 2048) + cx.fr;
        EP_FOR_ROWS { const float r = tab[EP_RU].x;
#pragma unroll
            for (int bj = 0; bj < 2; ++bj) { acc[ai][bj][m][0] *= r; acc[ai][bj][m][1] *= r; } }
    }
    __device__ __forceinline__ void operator()(Acc& acc, const Unit& u, const Ctx& cx, int ui) const {
        const LAS f32x2* tab = (const LAS f32x2*)(cx.lds + XCH_OFF + (ui & 1) * 2048) + cx.fr;
        const unsigned l_h = (unsigned)(cx.fr * 1024 + cx.fq * 8) * 4u, l_hb = l_h >> 1;
#pragma unroll
        for (int ai = 0; ai < 2; ++ai) {
            f32x4 pre[4][2][2];
#pragma unroll
            for (int m = 0; m < 4; ++m)
#pragma unroll
                for (int bj = 0; bj < 2; ++bj) { const size_t o = (size_t)(u.pm * 256 + EP_RU) * 1024 + u.pn * 256 + bj * 128 + cx.wc * 32;
                    if (hin32) { const float* hq = lane_ptr(hin32 + o, l_h); pre[m][bj][0] = *(const f32x4*)hq; pre[m][bj][1] = *(const f32x4*)(hq + 4); }
                    else { const u32x4 w = *(const u32x4*)lane_ptr(hb + o, l_hb); pre[m][bj][0] = __builtin_bit_cast(f32x4, w); } }
#pragma unroll
            for (int m = 0; m < 4; ++m) { const int ru = EP_RU, rowu = u.pm * 256 + ru; float sc = 1.0f; if (MIX) sc = tab[ru].y; float ss = 0.f;
#pragma unroll
                for (int bj = 0; bj < 2; ++bj) { const size_t o = (size_t)rowu * 1024 + u.pn * 256 + bj * 128 + cx.wc * 32; f32x4 h0, h1;
                    if (hin32) { h0 = pre[m][bj][0]; h1 = pre[m][bj][1]; }
                    else { const u32x4 w = __builtin_bit_cast(u32x4, pre[m][bj][0]); h0 = (f32x4){bf_lo(w.x), bf_hi(w.x), bf_lo(w.y), bf_hi(w.y)}; h1 = (f32x4){bf_lo(w.z), bf_hi(w.z), bf_lo(w.w), bf_hi(w.w)}; }
                    const f32x4 v0 = h0 + acc[ai][bj][m][0] * sc, v1 = h1 + acc[ai][bj][m][1] * sc;
                    if (hout32) { float* hp = lane_ptr(hout32 + o, l_h); *(f32x4*)hp = v0; *(f32x4*)(hp + 4) = v1; }
                    else *(u32x4*)lane_ptr(hb + o, l_hb) = pack8(v0, v1);
                    ss += sq8(v0, v1); }
                row_atomic(sq_next + rowu, cx.fr, ss, cx.fq); }
            EP_FENCE;
        }
    }
};
struct EpiSoftmax {
    static constexpr bool HAS_MID = false, HAS_BEGIN = false;
    const float* sq_x; bf16_t* pb;
    __device__ __forceinline__ void operator()(Acc& acc, const Unit& u, const Ctx& cx, int) const {
        LAS float* PM = (LAS float*)(cx.lds + XCH_OFF + 4096) + cx.fr * 4; LAS float* PS = (LAS float*)(cx.lds + XCH_OFF + 8192) + cx.fr * 4;
        EP_PRELOAD_RS(rsv, sq_x, 1.0f / 1024.0f)
        EP_FOR_ROWS { const int ru = EP_RU; const float rs = rsv[ai][m]; float mx = -3.0e38f;
#pragma unroll
            for (int bj = 0; bj < 2; ++bj)
#pragma unroll
                for (int n = 0; n < 2; ++n) { f32x4 v = acc[ai][bj][m][n] * rs; acc[ai][bj][m][n] = v; mx = fmaxf(fmaxf(mx, fmaxf(v[0], v[1])), fmaxf(v[2], v[3])); }
            mx = fmaxf(mx, __shfl_xor(mx, 16)); mx = fmaxf(mx, __shfl_xor(mx, 32));
            if (cx.fq == 0) PM[ru * 4 + cx.wc] = mx; EP_FENCE; }
        asm volatile("s_waitcnt lgkmcnt(0)" ::: "memory"); __builtin_amdgcn_s_barrier(); asm volatile("" ::: "memory");
        EP_FOR_ROWS { const int ru = EP_RU; const f32x4 q = *(const LAS f32x4*)(PM + ru * 4); const float mx = fmaxf(fmaxf(q[0], q[1]), fmaxf(q[2], q[3])); float sm = 0.f;
#pragma unroll
            for (int bj = 0; bj < 2; ++bj)
#pragma unroll
                for (int n = 0; n < 2; ++n) { f32x4 v = acc[ai][bj][m][n]; v = (f32x4){__builtin_amdgcn_exp2f(v[0] - mx), __builtin_amdgcn_exp2f(v[1] - mx), __builtin_amdgcn_exp2f(v[2] - mx), __builtin_amdgcn_exp2f(v[3] - mx)};
                    acc[ai][bj][m][n] = v; sm += (v[0] + v[1]) + (v[2] + v[3]); }
            sm += __shfl_xor(sm, 16); sm += __shfl_xor(sm, 32);
            if (cx.fq == 0) PS[ru * 4 + cx.wc] = sm; EP_FENCE; }
        asm volatile("s_waitcnt lgkmcnt(0)" ::: "memory"); __builtin_amdgcn_s_barrier(); asm volatile("" ::: "memory");
        const unsigned l_p = (unsigned)(cx.fr * 1024 + cx.fq * 8) * 2u;
        EP_FOR_ROWS { const int ru = EP_RU, rowu = u.pm * 256 + ru; const f32x4 q = *(const LAS f32x4*)(PS + ru * 4); const float inv = __builtin_amdgcn_rcpf((q[0] + q[1]) + (q[2] + q[3]));
#pragma unroll
            for (int bj = 0; bj < 2; ++bj) *(u32x4*)lane_ptr(pb + (size_t)rowu * 1024 + u.pn * 256 + bj * 128 + cx.wc * 32, l_p) = pack8(acc[ai][bj][m][0] * inv, acc[ai][bj][m][1] * inv);
            EP_FENCE; }
    }
};
struct EpiSwiglu {
    static constexpr bool HAS_MID = false, HAS_BEGIN = false;
    const float* sq_f; bf16_t* hid;
    __device__ __forceinline__ void operator()(Acc& acc, const Unit& u, const Ctx& cx, int) const {
        const unsigned l_h = (unsigned)(cx.fr * FF + cx.fq * 8) * 2u;
        EP_PRELOAD_RS(rsv, sq_f, 1.0f / 1024.0f)
        EP_FOR_ROWS { const int rowu = u.pm * 256 + EP_RU; const float rs = rsv[ai][m]; f32x4 o[2];
#pragma unroll
            for (int n = 0; n < 2; ++n) { const f32x4 g = acc[ai][0][m][n] * rs, up = acc[ai][1][m][n] * rs; o[n] = (f32x4){g[0] * sigm(g[0]) * up[0], g[1] * sigm(g[1]) * up[1], g[2] * sigm(g[2]) * up[2], g[3] * sigm(g[3]) * up[3]}; }
            *(u32x4*)lane_ptr(hid + (size_t)rowu * FF + u.pn * 128 + cx.wc * 32, l_h) = pack8(o[0], o[1]); EP_FENCE; }
    }
};
template <class OutFn> struct EpiStore {
    static constexpr bool HAS_MID = false, HAS_BEGIN = false;
    OutFn of;
    __device__ __forceinline__ void operator()(Acc& acc, const Unit& u, const Ctx& cx, int) const {
        int ld; bf16_t* base = of(u, ld); const unsigned l_o = (unsigned)(cx.fr * ld + cx.fq * 8) * 2u;
        EP_FOR_ROWS { const int ru = EP_RU;
#pragma unroll
            for (int bj = 0; bj < 2; ++bj) *(u32x4*)lane_ptr(base + (size_t)ru * ld + bj * 128 + cx.wc * 32, l_o) = pack8(acc[ai][bj][m][0], acc[ai][bj][m][1]);
            EP_FENCE; }
    }
};
}
namespace att {
constexpr int KSLOT = 12288, VSLOT = 8192, NSLOT = 3;
constexpr int L_K = 0, L_V = NSLOT * KSLOT, L_WS = L_V + NSLOT * VSLOT, L_OST = L_WS + 8 * 256, L_END = L_OST + 8 * 4096;
static_assert(L_END <= RING_BYTES, "attention LDS");
__device__ __forceinline__ int crow(int r, int hi) { return (r & 3) + 8 * (r >> 2) + 4 * hi; }
#define SBAR() __builtin_amdgcn_sched_barrier(0)
__device__ __forceinline__ void cmask(f32x16& p0, f32x16& p1, int jb, int qrel, int hi) {
    const float NEG = -INFINITY; const int kb = 64 * jb + 4 * hi;
#pragma unroll
    for (int r = 0; r < 16; ++r) { const int kv = kb + (r & 3) + 8 * (r >> 2); if (kv > qrel) p0[r] = NEG; if (kv + 32 > qrel) p1[r] = NEG; }
}
__device__ __forceinline__ void glds16(const void* gsrc, unsigned lds_dst) { unsigned keep;
    asm volatile("s_mov_b32 %0, m0\n\ts_mov_b32 m0, %2\n\ts_nop 0\n\tglobal_load_lds_dwordx4 %1, off\n\ts_mov_b32 m0, %0" : "=&s"(keep) : "v"(gsrc), "s"(lds_dst) : "memory"); }
__device__ __forceinline__ float max3f(float a, float b, float c) { float r; asm("v_max3_f32 %0, %1, %2, %3" : "=v"(r) : "v"(a), "v"(b), "v"(c)); return r; }
__device__ __forceinline__ float max2f(float a, float b) { float r; asm("v_max_f32_e32 %0, %1, %2" : "=v"(r) : "v"(a), "v"(b)); return r; }
__device__ __forceinline__ float fadd_s(float a, float b) { float r; asm("v_add_f32_e32 %0, %1, %2" : "=v"(r) : "v"(a), "v"(b)); return r; }
__device__ __forceinline__ float fsub_s(float a, float b) { float r; asm("v_sub_f32_e32 %0, %1, %2" : "=v"(r) : "v"(a), "v"(b)); return r; }
#define WAIT_BAR(N) asm volatile("s_waitcnt vmcnt(" #N ") lgkmcnt(0)\n\ts_barrier" ::: "memory")
typedef LAS const char* lds_cptr;
typedef short v4i16_t __attribute__((ext_vector_type(4)));
__device__ __forceinline__ void qkt(f32x16& p0, f32x16& p1, lds_cptr kb, const bf16x8* qr) { const f32x16 negm = f32x16{};
#pragma unroll
    for (int d0 = 0; d0 < 6; ++d0) { const bf16x8 b0 = *(const LAS bf16x8*)(kb + d0 * 2048), b1 = *(const LAS bf16x8*)(kb + d0 * 2048 + 512);
        if (d0 == 0) { p0 = __builtin_amdgcn_mfma_f32_32x32x16_bf16(b0, qr[0], negm, 0, 0, 0); p1 = __builtin_amdgcn_mfma_f32_32x32x16_bf16(b1, qr[0], negm, 0, 0, 0); }
        else { p0 = __builtin_amdgcn_mfma_f32_32x32x16_bf16(b0, qr[d0], p0, 0, 0, 0); p1 = __builtin_amdgcn_mfma_f32_32x32x16_bf16(b1, qr[d0], p1, 0, 0, 0); } }
}
__device__ __forceinline__ void kload2(bf16x8* kf, lds_cptr kp, int j) { kf[2 * j] = *(const LAS bf16x8*)(kp + j * 2048); kf[2 * j + 1] = *(const LAS bf16x8*)(kp + j * 2048 + 512); }
__device__ __forceinline__ s16x4 vtr(lds_cptr p) { return __builtin_bit_cast(s16x4, __builtin_amdgcn_ds_read_tr16_b64_v4i16((LAS v4i16_t*)p)); }
__device__ __forceinline__ float rowmax(const f32x16& p0, const f32x16& p1) {
    float a = max3f(p0[0], p0[1], p1[0]), b = max3f(p0[2], p0[3], p1[1]); a = max3f(a, p1[2], p1[3]);
#pragma unroll
    for (int r = 4; r < 16; r += 4) { a = max3f(a, p0[r], p0[r + 1]); b = max3f(b, p0[r + 2], p0[r + 3]); a = max3f(a, p1[r], p1[r + 1]); b = max3f(b, p1[r + 2], p1[r + 3]); }
    const float m = max2f(a, b);
    auto rr = __builtin_amdgcn_permlane32_swap(__float_as_uint(m), __float_as_uint(m), false, false);
    return max2f(__uint_as_float(rr[0]), __uint_as_float(rr[1]));
}
__device__ __forceinline__ void pv(f32x16* o, int vb, bf16x8 pa0, bf16x8 pa1, bf16x8 pa2, bf16x8 pa3) {
#pragma unroll
    for (int d0 = 0; d0 < 2; ++d0) { s16x4 lo[4], hi[4];
#pragma unroll
        for (int ks = 0; ks < 4; ++ks) {
            asm volatile("ds_read_b64_tr_b16 %0,%1 offset:%c2" : "=&v"(lo[ks]) : "v"(vb), "i"(d0 * 4096 + ks * 1024) : "memory");
            asm volatile("ds_read_b64_tr_b16 %0,%1 offset:%c2" : "=&v"(hi[ks]) : "v"(vb), "i"(d0 * 4096 + ks * 1024 + 512) : "memory"); }
        asm volatile("s_waitcnt lgkmcnt(0)" ::: "memory"); SBAR();
#define PK(k) (bf16x8){lo[k][0], lo[k][1], lo[k][2], lo[k][3], hi[k][0], hi[k][1], hi[k][2], hi[k][3]}
        o[d0] = __builtin_amdgcn_mfma_f32_32x32x16_bf16(pa0, PK(0), o[d0], 0, 0, 0);
        o[d0] = __builtin_amdgcn_mfma_f32_32x32x16_bf16(pa1, PK(1), o[d0], 0, 0, 0);
        o[d0] = __builtin_amdgcn_mfma_f32_32x32x16_bf16(pa2, PK(2), o[d0], 0, 0, 0);
        o[d0] = __builtin_amdgcn_mfma_f32_32x32x16_bf16(pa3, PK(3), o[d0], 0, 0, 0);
#undef PK
    }
}
template <int THRL>
__device__ __forceinline__ void attn_unit(int b, int h, int qb, const bf16_t* Q, const unsigned char* Kg, const unsigned char* Vg, bf16_t* AO, float* sq_a, LAS unsigned char* lds) {
    int tid_ = threadIdx.x; asm volatile("" : "+v"(tid_));
    const int tid = tid_, lane = tid & 63, r32 = lane & 31, hi = lane >> 5; const int wid = __builtin_amdgcn_readfirstlane(tid >> 6);
    const int q0 = qb * 256; const size_t rowbase = (size_t)b * S;
    const bf16_t* Qw = Q + (rowbase + q0 + wid * 32) * 768;
    const unsigned lds0 = (unsigned)(uintptr_t)lds;
    LAS float* wsf = (LAS float*)(lds + L_WS) + wid * 64;
    const unsigned char* ksrc = Kg + (size_t)(b * 8 + h) * 64 * KSLOT + wid * 1536 + lane * 16; const unsigned char* vsrc = Vg + (size_t)(b * 8 + h) * 64 * VSLOT + wid * 1024 + lane * 16;
    const unsigned kdst = lds0 + L_K + wid * 1536, vdst = lds0 + L_V + wid * 1024;
#define DMA_K(t, sl) do { glds16(ksrc + (size_t)(t) * KSLOT, (unsigned)__builtin_amdgcn_readfirstlane(kdst + (sl) * KSLOT)); \
        if (lane < 32) glds16(ksrc + (size_t)(t) * KSLOT + 1024, (unsigned)__builtin_amdgcn_readfirstlane(kdst + (sl) * KSLOT + 1024)); } while (0)
#define DMA_V(t, sl) glds16(vsrc + (size_t)(t) * VSLOT, (unsigned)__builtin_amdgcn_readfirstlane(vdst + (sl) * VSLOT))
    const int vb0 = (int)(lds0 + L_V) + ((lane >> 4) & 1) * 32 + (lane & 3) * 8 + (4 * hi + ((lane & 15) >> 2)) * 64;
    bf16x8 kf[12];
    const lds_cptr kp0 = (lds_cptr)lds + L_K + hi * 1024 + r32 * 16; const lds_cptr vp0 = (lds_cptr)lds + L_V + ((lane >> 4) & 1) * 32 + (lane & 3) * 8 + (4 * hi + ((lane & 15) >> 2)) * 64;
    const int NT = 4 * (qb + 1);
    DMA_K(0, 0); DMA_V(0, 0); DMA_K(1, 1);
    bf16x8 qr[6];
#pragma unroll
    for (int d0 = 0; d0 < 6; ++d0) qr[d0] = *reinterpret_cast<const bf16x8*>(&Qw[(size_t)r32 * 768 + (d0 < 4 ? h * 64 + d0 * 16 : 512 + h * 32 + (d0 - 4) * 16) + hi * 8]);
    float mhat = 0.f, l_reg = 0.f; f32x16 o[2]; o[0] = f32x16{}; o[1] = f32x16{};
    const int qrel = wid * 32 + r32;
#define CMASK(P0, P1, t) do { int jb_ = (t) - (NT - 4); if (jb_ >= 0) cmask(P0, P1, jb_, qrel, hi); } while (0)
    bool resc = false;
#define START(P0, P1) do { const float rm = rowmax(P0, P1); resc = false; \
    mhat = rm; \
    _Pragma("unroll") for (int r = 0; r < 16; ++r) P0[r] = __builtin_amdgcn_exp2f(P0[r] - mhat); } while (0)
#define RESC() do { if (resc) { asm volatile("s_waitcnt lgkmcnt(0)" ::: "memory"); \
      _Pragma("unroll") for (int d_ = 0; d_ < 2; ++d_) _Pragma("unroll") for (int r = 0; r < 16; ++r) o[d_][r] *= wsf[crow(r, hi)]; } } while (0)
    f32x16 pA0, pA1, pB0, pB1;
    int sp = 0, sc = 0, sn = 1;
#define ROT() do { sp = sc; sc = sn; sn = (sn == NSLOT - 1) ? 0 : sn + 1; } while (0)
    DMA_K(2, 2);
    WAIT_BAR(5);
    qkt(pA0, pA1, kp0, qr); asm volatile("s_nop 15\n\ts_nop 7" : "+v"(pA0), "+v"(pA1)); CMASK(pA0, pA1, 0);
    START(pA0, pA1);
#pragma unroll
    for (int r = 0; r < 16; ++r) pA1[r] = __builtin_amdgcn_exp2f(pA1[r] - mhat);
    WAIT_BAR(0);
    DMA_K(3, 0); DMA_V(1, 1);
    ROT();
#pragma unroll
    for (int j = 0; j < 6; ++j) kload2(kf, kp0 + sc * KSLOT, j);
    WAIT_BAR(3);
    s16x4 vlo[8], vhi[8]; u32x4 pw0, pw1, pw2, pw3;
#define PKW(P, B) cvt_pk_bf16(P[B], P[B + 1])
#define PAF(k) __builtin_bit_cast(bf16x8, pw##k)
#define VFR(i) (bf16x8){vlo[i][0], vlo[i][1], vlo[i][2], vlo[i][3], vhi[i][0], vhi[i][1], vhi[i][2], vhi[i][3]}
#define PIN(x) asm volatile("" : "+v"(x))
#define MX3(a, b, c) __builtin_fmaxf(__builtin_fmaxf((a), (b)), (c))
#define GAPA(MF, A0, A1, A2, A3, W0, W1, PW) do { MF; sacc += A0; sacc += A1; sacc += A2; sacc += A3; PIN(sacc); W0; W1; PIN(PW); SBAR(); } while (0)
#define GAPM(MF) do { MF; SBAR(); } while (0)
#define EX(v) __builtin_amdgcn_exp2f(v)
#define GAPB(MF, X, B) do { MF; X[B] = EX(X[B] - mhat); X[B + 1] = EX(X[B + 1] - mhat); X[B + 2] = EX(X[B + 2] - mhat); X[B + 3] = EX(X[B + 3] - mhat); PIN(X); SBAR(); } while (0)
#define VRD(i) do { vlo[i] = vtr(vp_ + (((i) >> 2) * 4096 + ((i) & 3) * 1024)); vhi[i] = vtr(vp_ + (((i) >> 2) * 4096 + ((i) & 3) * 1024 + 512)); } while (0)
#define KRD(G, j) do { if (G) { kload2(kf, kp0 + sn * KSLOT, j); SBAR(); } } while (0)
#define MF32(A, B, C) __builtin_amdgcn_mfma_f32_32x32x16_bf16(A, B, C, 0, 0, 0)
#define STEP(C0, C1, P0, P1, t, GK, GV, GL) do { SBAR(); const f32x16 zero16 = f32x16{}; \
    const lds_cptr vp_ = vp0 + sp * VSLOT; \
    VRD(0); SBAR(); float sacc = (P0[0] + P0[1]); \
    GAPA(C0 = MF32(kf[0], qr[0], zero16), P0[2], P0[3], P0[4], P0[5],     pw0[0] = PKW(P0, 0), pw0[1] = PKW(P0, 2), pw0); \
    VRD(4); SBAR(); GAPA(C1 = MF32(kf[1], qr[0], zero16), P0[6], P0[7], P0[8], P0[9],     pw0[2] = PKW(P0, 4), pw0[3] = PKW(P0, 6), pw0); \
    VRD(1); SBAR(); GAPA(C0 = MF32(kf[2], qr[1], C0),   P0[10], P0[11], P0[12], P0[13], pw1[0] = PKW(P0, 8), pw1[1] = PKW(P0, 10), pw1); \
    VRD(5); SBAR(); GAPA(C1 = MF32(kf[3], qr[1], C1),   P0[14], P0[15], P1[0], P1[1],   pw1[2] = PKW(P0, 12), pw1[3] = PKW(P0, 14), pw1); \
    VRD(2); SBAR(); GAPA(C0 = MF32(kf[4], qr[2], C0),   P1[2], P1[3], P1[4], P1[5],     pw2[0] = PKW(P1, 0), pw2[1] = PKW(P1, 2), pw2); \
    VRD(6); SBAR(); GAPA(C1 = MF32(kf[5], qr[2], C1),   P1[6], P1[7], P1[8], P1[9],     pw2[2] = PKW(P1, 4), pw2[3] = PKW(P1, 6), pw2); \
    VRD(3); SBAR(); GAPA(C0 = MF32(kf[6], qr[3], C0),   P1[10], P1[11], P1[12], P1[13], pw3[0] = PKW(P1, 8), pw3[1] = PKW(P1, 10), pw3); \
    VRD(7); SBAR(); GAPA(C1 = MF32(kf[7], qr[3], C1),   P1[14], P1[15], 0.f, 0.f,       pw3[2] = PKW(P1, 12), pw3[3] = PKW(P1, 14), pw3); \
    GAPM(C0 = MF32(kf[8], qr[4], C0)); GAPM(C1 = MF32(kf[9], qr[4], C1)); GAPM(C0 = MF32(kf[10], qr[5], C0)); GAPM(C1 = MF32(kf[11], qr[5], C1)); \
    l_reg += sacc; \
    if (GK) { DMA_K((t) + 3, sc); } if (GV) { DMA_V((t) + 1, sn); } \
    CMASK(C0, C1, t); \
    { float a = MX3(C0[0], C0[1], C1[0]), b = MX3(C0[2], C0[3], C1[1]); a = MX3(a, C1[2], C1[3]); \
      _Pragma("unroll") for (int r = 4; r < 16; r += 4) { a = MX3(a, C0[r], C0[r + 1]); b = MX3(b, C0[r + 2], C0[r + 3]); a = MX3(a, C1[r], C1[r + 1]); b = MX3(b, C1[r + 2], C1[r + 3]); } \
      float rm = __builtin_fmaxf(a, b); { auto rr = __builtin_amdgcn_permlane32_swap(__float_as_uint(rm), __float_as_uint(rm), false, false); rm = __builtin_fmaxf(__uint_as_float(rr[0]), __uint_as_float(rr[1])); } \
      resc = false; \
      rm -= mhat; \
      if (__builtin_expect(__any(rm > (float)THRL), 0)) { const float dl = __builtin_fmaxf(rm, 0.f); mhat += dl; \
        const float f = __builtin_amdgcn_exp2f(-dl); l_reg *= f; if (hi == 0) wsf[r32] = f; resc = true; } } \
    SBAR(); \
    GAPB(o[0] = MF32(PAF(0), VFR(0), o[0]), C0, 0); \
    KRD(GL, 0); GAPB(o[1] = MF32(PAF(0), VFR(4), o[1]), C0, 4); \
    KRD(GL, 1); GAPB(o[0] = MF32(PAF(1), VFR(1), o[0]), C0, 8); \
    KRD(GL, 2); GAPB(o[1] = MF32(PAF(1), VFR(5), o[1]), C0, 12); \
    KRD(GL, 3); GAPB(o[0] = MF32(PAF(2), VFR(2), o[0]), C1, 0); \
    KRD(GL, 4); GAPB(o[1] = MF32(PAF(2), VFR(6), o[1]), C1, 4); \
    KRD(GL, 5); GAPB(o[0] = MF32(PAF(3), VFR(3), o[0]), C1, 8); \
    GAPB(o[1] = MF32(PAF(3), VFR(7), o[1]), C1, 12); \
    } while (0)
    int t = 1;
#undef CMASK
#define CMASK(P0, P1, t) do {} while (0)
    for (; t + 5 < NT; t += 2) {
        STEP(pB0, pB1, pA0, pA1, t, true, true, true);     WAIT_BAR(3); RESC(); ROT();
        STEP(pA0, pA1, pB0, pB1, t + 1, true, true, true); WAIT_BAR(3); RESC(); ROT();
    }
#undef CMASK
#define CMASK(P0, P1, t) do { int jb_ = (t) - (NT - 4); if (jb_ >= 0) cmask(P0, P1, jb_, qrel, hi); } while (0)
#define ENDW(tt) do { if ((tt) + 3 < NT) { WAIT_BAR(3); } else if ((tt) + 2 < NT) { WAIT_BAR(1); } else { WAIT_BAR(0); } } while (0)
    for (; t + 1 < NT; t += 2) {
        STEP(pB0, pB1, pA0, pA1, t, (t + 3 < NT), (t + 1 < NT), (t + 1 < NT));     ENDW(t);     RESC(); ROT();
        STEP(pA0, pA1, pB0, pB1, t + 1, (t + 4 < NT), (t + 2 < NT), (t + 2 < NT)); ENDW(t + 1); RESC(); ROT();
    }
    STEP(pB0, pB1, pA0, pA1, NT - 1, false, false, false); RESC();
    { float sacc = pB0[0] + pB0[1];
#pragma unroll
      for (int r = 2; r < 16; ++r) sacc += pB0[r];
#pragma unroll
      for (int r = 0; r < 16; ++r) sacc += pB1[r];
      l_reg += sacc;
      pw0 = (u32x4){PKW(pB0, 0), PKW(pB0, 2), PKW(pB0, 4), PKW(pB0, 6)}; pw1 = (u32x4){PKW(pB0, 8), PKW(pB0, 10), PKW(pB0, 12), PKW(pB0, 14)};
      pw2 = (u32x4){PKW(pB1, 0), PKW(pB1, 2), PKW(pB1, 4), PKW(pB1, 6)}; pw3 = (u32x4){PKW(pB1, 8), PKW(pB1, 10), PKW(pB1, 12), PKW(pB1, 14)};
      SBAR(); pv(o, vb0 + sc * VSLOT, PAF(0), PAF(1), PAF(2), PAF(3)); }
#undef PKW
#undef PAF
#undef VFR
#undef PIN
#undef MX3
#undef GAPA
#undef GAPM
#undef GAPB
#undef EX
#undef VRD
#undef KRD
#undef MF32
#undef STEP
#undef ENDW
#undef DMA_K
#undef DMA_V
#undef CMASK
#undef START
#undef RESC
#undef ROT
    { auto rr = __builtin_amdgcn_permlane32_swap(__float_as_uint(l_reg), __float_as_uint(l_reg), false, false); l_reg = __uint_as_float(rr[0]) + __uint_as_float(rr[1]); }
    if (hi == 0) wsf[32 + r32] = l_reg;
    asm volatile("s_waitcnt lgkmcnt(0)" ::: "memory");
    LAS bf16_t* stg = (LAS bf16_t*)(lds + L_OST) + wid * 2048;
#pragma unroll
    for (int r = 0; r < 16; ++r) { const int orow = crow(r, hi); const float rl = __builtin_amdgcn_rcpf(wsf[32 + orow]);
#pragma unroll
        for (int d0 = 0; d0 < 2; ++d0) stg[orow * 64 + d0 * 32 + r32] = (bf16_t)(cvt_pk_bf16(o[d0][r] * rl, 0.f) & 0xffffu); }
    asm volatile("s_waitcnt lgkmcnt(0)" ::: "memory");
    bf16_t* Ow = AO + (rowbase + q0 + wid * 32) * 512 + h * 64;
#pragma unroll
    for (int i = 0; i < 4; ++i) { const int row = i * 8 + (lane >> 3), ch = lane & 7; const u32x4 v = *(const LAS u32x4*)(stg + row * 64 + ch * 8); *(u32x4*)(Ow + (size_t)row * 512 + ch * 8) = v;
        float ss = (bf_lo(v.x) * bf_lo(v.x) + bf_hi(v.x) * bf_hi(v.x)) + (bf_lo(v.y) * bf_lo(v.y) + bf_hi(v.y) * bf_hi(v.y)) + (bf_lo(v.z) * bf_lo(v.z) + bf_hi(v.z) * bf_hi(v.z)) + (bf_lo(v.w) * bf_lo(v.w) + bf_hi(v.w) * bf_hi(v.w));
        ss += __shfl_xor(ss, 1); ss += __shfl_xor(ss, 2); ss += __shfl_xor(ss, 4);
        if (ch == 0) unsafeAtomicAdd(sq_a + rowbase + q0 + wid * 32 + row, ss); }
    asm volatile("s_waitcnt lgkmcnt(0)\n\ts_barrier" ::: "memory");
}
#undef SBAR
#undef WAIT_BAR
__device__ __forceinline__ void attn_phase(int vcu, int G, const bf16_t* Q, const unsigned char* Kg, const unsigned char* Vg, bf16_t* AO, float* sq_a, LAS unsigned char* lds) {
    for (int v = vcu; v < 256; v += G) { const int bh = v >> 2, s = v & 3;
#pragma unroll 1
        for (int i = 0; i < 4; ++i) { const int qb = (i == 0) ? s : (i == 1) ? 7 - s : (i == 2) ? 8 + s : 15 - s; attn_unit<8>(bh >> 3, bh & 7, qb, Q, Kg, Vg, AO, sq_a, lds); } }
}
}

__device__ __forceinline__ void ssm_scan_phase(int vcu, int G, const float* xloc, const float* aL  , bf16_t* assm, LAS unsigned char* lds) {
    int tid_ = threadIdx.x; asm volatile("" : "+v"(tid_));
    const int p = tid_ & 63, wave = __builtin_amdgcn_readfirstlane(tid_ >> 6);
    LAS float* ends = (LAS float*)lds;
    for (int v = vcu; v < 256; v += G) { const int b = v >> 5, g = v & 31; const float ar = aL[(g * 64 + p) * 2], ai = aL[(g * 64 + p) * 2 + 1];
        const int c0 = wave * 16;
        const float* xl = xloc + ((size_t)g * NCH + b * NCHB + c0) * 128; bf16_t* as = assm + ((size_t)g * NCH + b * NCHB + c0) * KS3 + KS1;
        float lr[16], li[16];
#pragma unroll
        for (int k = 0; k < 16; ++k) { lr[k] = xl[(size_t)k * 128 + p]; li[k] = xl[(size_t)k * 128 + 64 + p]; }
        float xr = 0.f, xi = 0.f, pr_[16], pi_[16];
#pragma unroll
        for (int k = 0; k < 16; ++k) { pr_[k] = xr; pi_[k] = xi; const float nr = ar * xr - ai * xi + lr[k], ni = ar * xi + ai * xr + li[k]; xr = nr; xi = ni; }
        ends[(wave * 64 + p) * 2] = xr; ends[(wave * 64 + p) * 2 + 1] = xi;
        float a16r = ar, a16i = ai;
#pragma unroll
        for (int q = 0; q < 4; ++q) { const float nr = a16r * a16r - a16i * a16i, ni = 2.f * a16r * a16i; a16r = nr; a16i = ni; }
        __syncthreads();
        float sr = 0.f, si = 0.f;
        for (int w = 0; w < wave; ++w) { const float er = ends[(w * 64 + p) * 2], ei = ends[(w * 64 + p) * 2 + 1]; const float nr = a16r * sr - a16i * si + er, ni = a16r * si + a16i * sr + ei; sr = nr; si = ni; }
        float wr_ = sr, wi_ = si;
#pragma unroll
        for (int k = 0; k < 16; ++k) { const float orr = pr_[k] + wr_, oii = pi_[k] + wi_;
            as[(size_t)k * KS3 + p] = (bf16_t)(cvt_pk_bf16(orr, 0.f) & 0xffffu); as[(size_t)k * KS3 + 64 + p] = (bf16_t)(cvt_pk_bf16(oii, 0.f) & 0xffffu);
            const float nr = ar * wr_ - ai * wi_, ni = ar * wi_ + ai * wr_; wr_ = nr; wi_ = ni; }
        __syncthreads();
    }
}
__device__ __forceinline__ void sincos_d(double a, double& s, double& c) {
    const double k = rint(a * 0.63661977236758134308);
    double y = fma(-k, 1.57079632679489655800e+00, a); y = fma(-k, 6.12323399573676603587e-17, y);
    const double y2 = y * y;
    double sp = -1.0 / 1307674368000.0; sp = fma(sp, y2, 1.0 / 6227020800.0); sp = fma(sp, y2, -1.0 / 39916800.0); sp = fma(sp, y2, 1.0 / 362880.0);
    sp = fma(sp, y2, -1.0 / 5040.0); sp = fma(sp, y2, 1.0 / 120.0); sp = fma(sp, y2, -1.0 / 6.0); sp = fma(sp * y2, y, y);
    double cp = 1.0 / 20922789888000.0; cp = fma(cp, y2, -1.0 / 87178291200.0); cp = fma(cp, y2, 1.0 / 479001600.0); cp = fma(cp, y2, -1.0 / 3628800.0);
    cp = fma(cp, y2, 1.0 / 40320.0); cp = fma(cp, y2, -1.0 / 720.0); cp = fma(cp, y2, 1.0 / 24.0); cp = fma(cp, y2, -0.5); cp = fma(cp, y2, 1.0);
    const int q = (int)((long long)k & 3);
    if (q == 0) { s = sp; c = cp; } else if (q == 1) { s = cp; c = -sp; } else if (q == 2) { s = -sp; c = -cp; } else { s = -cp; c = sp; }
}
__device__ __forceinline__ float wave_sum(float v) {
#pragma unroll
    for (int o = 1; o < 64; o <<= 1) v += __shfl_xor(v, o);
    return v;
}
template <class ColFn, class GainFn>
__device__ __forceinline__ void conv_T(int gw, int NGW, int& base, int lane, LAS float* scr, int Ksrc, int ldw, int Ndst, bf16_t* dst, int ldd, ColFn colp, GainFn gain, float scale) {
    const int nblk = Ndst / 32, nitems = nblk * (Ksrc / 64);
    int first = gw - (base % NGW); if (first < 0) first += NGW;
    base += nitems;
    for (int it = first; it < nitems; it += NGW) { const int kb = it / nblk, nb = it % nblk, k0 = 64 * kb, n0 = 32 * nb;
        const float* cp = colp(n0 + (lane & 31)); float v[32];
        if (cp) { const float* q = cp + (size_t)(k0 + (lane >> 5)) * ldw;
#pragma unroll
            for (int i = 0; i < 32; ++i) v[i] = q[(size_t)(2 * i) * ldw]; }
        else {
#pragma unroll
            for (int i = 0; i < 32; ++i) v[i] = 0.f; }
#pragma unroll
        for (int i = 0; i < 32; ++i) scr[(2 * i + (lane >> 5)) * 33 + (lane & 31)] = v[i];
        asm volatile("s_waitcnt lgkmcnt(0)" ::: "memory");
        const int c = lane & 7; float gk[8];
#pragma unroll
        for (int e = 0; e < 8; ++e) gk[e] = gain(k0 + 8 * c + e) * scale;
#pragma unroll
        for (int j = 0; j < 4; ++j) { const int n = (lane >> 3) + 8 * j; const LAS float* sp = scr + (8 * c) * 33 + n;
            u32x4 o; o.x = cvt_pk_bf16(sp[0 * 33] * gk[0], sp[1 * 33] * gk[1]); o.y = cvt_pk_bf16(sp[2 * 33] * gk[2], sp[3 * 33] * gk[3]); o.z = cvt_pk_bf16(sp[4 * 33] * gk[4], sp[5 * 33] * gk[5]); o.w = cvt_pk_bf16(sp[6 * 33] * gk[6], sp[7 * 33] * gk[7]);
            *(u32x4*)(dst + (size_t)(n0 + n) * ldd + k0 + 8 * c) = o; }
        asm volatile("s_waitcnt lgkmcnt(0)" ::: "memory");
    }
}
struct In {
    const float *x, *mem; const int* pos; const float *norm_mix_g, *w_in, *q_norm_g, *w_uq, *kv_norm_g, *w_ukv, *lam_re, *lam_im, *log_dt, *b_re, *b_im, *c_re, *c_im, *ssm_d, *w_glu, *b_glu,
        *attn_out_g, *ssm_out_g, *w_out, *norm_x_g, *mem_norm_g, *w_xq, *w_xkv, *w_xo, *norm_ffn_g, *w_gate, *w_up, *w_down, *final_g;
};
struct Freqs { double f[16]; };

__device__ __forceinline__ void ssm_mats(const In& in, int l, int g, int q, unsigned char* ws, LAS unsigned char* lds) {
    const int tid = threadIdx.x;
    LAS float* bbr = (LAS float*)lds; LAS float* bbi = bbr + 1024; LAS float* apr = bbi + 1024; LAS float* api = apr + 34 * 64; LAS float* cr = api + 34 * 64; LAS float* ci = cr + 1024;
    LAS float* ktabT = ci + 1024  ; LAS float* aprT = ktabT + 2048  ; LAS float* apiT = aprT + 64 * 35; LAS float* dvs = apiT + 64 * 35;
    const int lg = l * 32 + g;
    if (tid < 128) { const int p = tid & 63; const double lr = in.lam_re[lg * 64 + p], li = in.lam_im[lg * 64 + p], dt = exp((double)in.log_dt[lg]);
        double sn, cn; sincos_d(fabs(li * dt), sn, cn); if (li * dt < 0) sn = -sn;
        const double er = exp(lr * dt), ar = er * cn, ai = er * sn;
        if (tid < 64) {
            double pr = 1.0, pi = 0.0;
            for (int j = 0; j < 34; ++j) { apr[j * 64 + p] = (float)pr; api[j * 64 + p] = (float)pi; aprT[p * 35 + j] = (float)pr; apiT[p * 35 + j] = (float)pi;
                if (j == LC && q == 0) { float* al = (float*)(ws + WS_AL) + (size_t)(lg * 64 + p) * 2; al[0] = (float)pr; al[1] = (float)pi; }
                const double nr = pr * ar - pi * ai, ni = pr * ai + pi * ar; pr = nr; pi = ni; }
        } else {
            const double den = lr * lr + li * li, cfr = ((ar - 1.0) * lr + ai * li) / den, cfi = (ai * lr - (ar - 1.0) * li) / den; const float fr_ = (float)cfr, fi_ = (float)cfi;
            float bre[16], bim[16];
#pragma unroll
            for (int c = 0; c < 16; ++c) { bre[c] = in.b_re[(size_t)(lg * 64 + p) * 16 + c]; bim[c] = in.b_im[(size_t)(lg * 64 + p) * 16 + c]; }
#pragma unroll
            for (int c = 0; c < 16; ++c) { bbr[p * 16 + c] = fr_ * bre[c] - fi_ * bim[c]; bbi[p * 16 + c] = fr_ * bim[c] + fi_ * bre[c]; }
        }
    } else if (tid < 192) { const int p = tid - 128;
#pragma unroll
        for (int c = 0; c < 16; ++c) { cr[c * 64 + p] = in.c_re[(size_t)(lg * 16 + c) * 64 + p]; ci[c * 64 + p] = in.c_im[(size_t)(lg * 16 + c) * 64 + p]; }
    } else if (tid < 208) dvs[tid - 192] = in.ssm_d[l * 512 + g * 16 + (tid - 192)];
    __syncthreads();
    {
      const int j = tid >> 4, c4 = (tid >> 2) & 3, c = 4 * q + c4, c2b = (tid & 3) * 4; f32x4 sum = (f32x4){0.f, 0.f, 0.f, 0.f};
#pragma unroll 4
      for (int p = 0; p < 64; ++p) { const float yr = apr[j * 64 + p], yi = api[j * 64 + p], xr = cr[c * 64 + p], xi = ci[c * 64 + p]; const float car = xr * yr - xi * yi, cai = xr * yi + xi * yr;
          sum += car * *(const LAS f32x4*)(bbr + p * 16 + c2b) - cai * *(const LAS f32x4*)(bbi + p * 16 + c2b); }
#pragma unroll
      for (int y = 0; y < 4; ++y) ktabT[(c4 * 16 + c2b + y) * 32 + j] = sum[y]; }
    __syncthreads();
    bf16_t* bt1 = (bf16_t*)(ws + WS_SSM + (size_t)lg * SSM_G_STRIDE); bf16_t* bt3 = (bf16_t*)(ws + WS_SSM + (size_t)lg * SSM_G_STRIDE + SSM_BT3_OFF);
    for (int idx = tid; idx < 128 * 80; idx += 512) { const int rq = idx / 80, k0 = (idx % 80) * 8, s = rq >> 2, c4 = rq & 3, c = 4 * q + c4, n = s * 16 + c; float v[8];
        if (k0 < KS1) { const int s2 = k0 >> 4, c0 = k0 & 15; const float dvc = (s2 == s) ? dvs[c] : 0.f; const LAS float* kt = ktabT + (c4 * 16 + c0) * 32 + (s2 <= s ? s - s2 : 0);
#pragma unroll
            for (int e = 0; e < 8; ++e) { float t = kt[e * 32]; if (s2 > s) t = 0.f; if (c0 + e == c) t += dvc; v[e] = t; }
        } else { const int pq = k0 - KS1, p0 = pq & 63; const bool im = (pq >> 6) != 0;
            const LAS float* xrp = cr + c * 64 + p0; const LAS float* xip = ci + c * 64 + p0; const LAS float* yrp = apr + (s + 1) * 64 + p0; const LAS float* yip = api + (s + 1) * 64 + p0;
#pragma unroll
            for (int hh = 0; hh < 2; ++hh) { const f32x4 xr = *(const LAS f32x4*)(xrp + 4 * hh), xi = *(const LAS f32x4*)(xip + 4 * hh), yr = *(const LAS f32x4*)(yrp + 4 * hh), yi = *(const LAS f32x4*)(yip + 4 * hh);
                const f32x4 re = xr * yr - xi * yi, mi = -(xr * yi + xi * yr);
#pragma unroll
                for (int e = 0; e < 4; ++e) v[4 * hh + e] = im ? mi[e] : re[e]; }
        }
        u32x4 o; o.x = cvt_pk_bf16(v[0], v[1]); o.y = cvt_pk_bf16(v[2], v[3]); o.z = cvt_pk_bf16(v[4], v[5]); o.w = cvt_pk_bf16(v[6], v[7]);
        *(u32x4*)(bt3 + (size_t)n * KS3 + k0) = o; }
    for (int idx = tid; idx < 64 * 64; idx += 512) { const int rq = idx >> 6, k0 = (idx & 63) * 8, s2 = k0 >> 4, c0 = k0 & 15; float v[8];
        const bool real_row = rq < 32; const int p = 16 * q + (rq & 15); const bool im = (rq >> 4) & 1; const int n = real_row ? (im ? 64 + p : p) : 128 + 32 * q + (rq - 32);
        if (real_row) { const float yr = aprT[p * 35 + (LC - 1 - s2)], yi = apiT[p * 35 + (LC - 1 - s2)];
#pragma unroll
            for (int hh = 0; hh < 2; ++hh) { const f32x4 br = *(const LAS f32x4*)(bbr + p * 16 + c0 + 4 * hh), bi = *(const LAS f32x4*)(bbi + p * 16 + c0 + 4 * hh);
                const f32x4 re = br * yr - bi * yi, mi = bi * yr + br * yi;
#pragma unroll
                for (int e = 0; e < 4; ++e) v[4 * hh + e] = im ? mi[e] : re[e]; }
        } else {
#pragma unroll
            for (int e = 0; e < 8; ++e) v[e] = 0.f; }
        u32x4 o; o.x = cvt_pk_bf16(v[0], v[1]); o.y = cvt_pk_bf16(v[2], v[3]); o.z = cvt_pk_bf16(v[4], v[5]); o.w = cvt_pk_bf16(v[6], v[7]);
        *(u32x4*)(bt1 + (size_t)n * KS1 + k0) = o; }
    __syncthreads();
}

__device__ __forceinline__ void prologue(const In& in, const Freqs& fr, unsigned char* ws, LAS unsigned char* lds, int vcu, int G, int parts) {
    const int tid = threadIdx.x, lane = tid & 63, wave = __builtin_amdgcn_readfirstlane(tid >> 6);
    __syncthreads();
    if (parts & 1) for (int j = vcu; j < 256; j += G) ssm_mats(in, j >> 7, (j >> 2) & 31, j & 3, ws, lds);
    LAS float* scr = (LAS float*)(lds + wave * 16384);
    const int gw = vcu * 8 + wave, NGW = G * 8;
    if (parts & 2) {
    { bf16_t* hb = (bf16_t*)(ws + WS_HB); float* sq0 = (float*)(ws + WS_CTL) + CW_SQ + (size_t)SQ_MIX * T;
      for (int r = gw * 2; r < T; r += NGW * 2) { const f32x4* xr = (const f32x4*)(in.x + (size_t)r * D) + lane; u32x2* hrow = (u32x2*)(hb + (size_t)r * D) + lane; f32x4 v[8];
#pragma unroll
          for (int j = 0; j < 8; ++j) v[j] = xr[64 * j];
          float s0 = 0.f, s1 = 0.f;
#pragma unroll
          for (int j = 0; j < 4; ++j) { s0 += (v[j][0] * v[j][0] + v[j][1] * v[j][1]) + (v[j][2] * v[j][2] + v[j][3] * v[j][3]); s1 += (v[j + 4][0] * v[j + 4][0] + v[j + 4][1] * v[j + 4][1]) + (v[j + 4][2] * v[j + 4][2] + v[j + 4][3] * v[j + 4][3]); }
#pragma unroll
          for (int j = 0; j < 8; ++j) hrow[64 * j] = (u32x2){cvt_pk_bf16(v[j][0], v[j][1]), cvt_pk_bf16(v[j][2], v[j][3])};
          s0 = wave_sum(s0); s1 = wave_sum(s1); if (lane == 0) { sq0[r] = s0; sq0[r + 1] = s1; } } }
    { bf16_t* mn = (bf16_t*)(ws + WS_RA + RA_MEMN);
      for (int r = gw; r < NB * MEMT; r += NGW) { const f32x4* xr = (const f32x4*)(in.mem + (size_t)r * D) + lane; u32x2* mrow = (u32x2*)(mn + (size_t)r * D) + lane; f32x4 v[4]; float s = 0.f;
#pragma unroll
          for (int j = 0; j < 4; ++j) { v[j] = xr[64 * j]; s += (v[j][0] * v[j][0] + v[j][1] * v[j][1]) + (v[j][2] * v[j][2] + v[j][3] * v[j][3]); }
          const float rs = rstd_of(wave_sum(s), 1.0f / 1024.0f);
#pragma unroll
          for (int j = 0; j < 4; ++j) mrow[64 * j] = (u32x2){cvt_pk_bf16(v[j][0] * rs, v[j][1] * rs), cvt_pk_bf16(v[j][2] * rs, v[j][3] * rs)}; } }
    { float* cs = (float*)(ws + WS_CS);
      for (int i = vcu * 512 + tid; i < T * 16; i += G * 512) { const int t = i >> 4, j = i & 15; double s, c; sincos_d((double)in.pos[t] * fr.f[j], s, c); cs[(size_t)t * 32 + j] = (float)c; cs[(size_t)t * 32 + 16 + j] = (float)s; } }
    }
    if (!(parts & 4)) return;
    int cbase = 0;
    for (int l = 0; l < NL; ++l) {
        unsigned char* wl = ws + WS_W + (size_t)l * WL_STRIDE;
        { const float* W = in.w_in + (size_t)l * D * 928; const float* gn = in.norm_mix_g + l * D;
          conv_T(gw, NGW, cbase, lane, scr, D, 928, 1024, (bf16_t*)(wl + WL_IN), 1024,
                 [=](int n) -> const float* { if (n < 384) return W + n; if (n < 416) { const int i = n - 384; return W + ((i & 1) ? 400 + (i >> 1) : 384 + (i >> 1)); } if (n < 512) return nullptr; return W + 416 + (n - 512); },
                 [=](int k) { return gn[k]; }, 1.0f); }
        { const float* W = in.w_uq + (size_t)l * 256 * 768; const float* gn = in.q_norm_g + l * 256;
          conv_T(gw, NGW, cbase, lane, scr, 256, 768, 768, (bf16_t*)(wl + WL_UP), 256,
                 [=](int n) -> const float* { if (n < 512) return W + (n >> 6) * 96 + (n & 63); const int h = (n - 512) >> 5, i = (n - 512) & 31; return W + h * 96 + ((i & 1) ? 80 + (i >> 1) : 64 + (i >> 1)); },
                 [=](int k) { return gn[k]; }, 0.10206207261596575f * LOG2E); }
        { const float* W = in.w_ukv + (size_t)l * 128 * 1024; const float* gn = in.kv_norm_g + l * 128; bf16_t* dst = (bf16_t*)(wl + WL_UP) + (size_t)768 * 256;
          conv_T(gw, NGW, cbase, lane, scr, 128, 1024, 1024, dst, 256, [=](int n) -> const float* { return W + n; }, [=](int k) { return gn[k]; }, 1.0f);
          for (int i = vcu * 512 + tid; i < 1024 * 16; i += G * 512) *(u32x4*)(dst + (size_t)(i >> 4) * 256 + 128 + (i & 15) * 8) = (u32x4){0u, 0u, 0u, 0u}; }
        { const float* W = in.w_glu + (size_t)l * 512 * 512;
          conv_T(gw, NGW, cbase, lane, scr, 512, 512, 512, (bf16_t*)(wl + WL_GLU), 512, [=](int n) -> const float* { return W + n; }, [=](int) { return 1.0f; }, 1.0f); }
        { const float* W = in.w_out + (size_t)l * D * D; const float* ga = in.attn_out_g + l * 512; const float* gs = in.ssm_out_g + l * 512;
          conv_T(gw, NGW, cbase, lane, scr, D, D, D, (bf16_t*)(wl + WL_OUT), D, [=](int n) -> const float* { return W + n; }, [=](int k) { return k < 512 ? ga[k] : gs[k - 512]; }, 1.0f); }
        { const float* W = in.w_xkv + (size_t)l * D * 2048; const float* gn = in.mem_norm_g + l * D;
          conv_T(gw, NGW, cbase, lane, scr, D, 2048, 2048, (bf16_t*)(ws + WS_WXKV) + (size_t)l * 2048 * D, D, [=](int n) -> const float* { return W + n; }, [=](int k) { return gn[k]; }, 1.0f); }
        { const float* W = in.w_xo + (size_t)l * D * D;
          conv_T(gw, NGW, cbase, lane, scr, D, D, D, (bf16_t*)(ws + WS_WXO) + (size_t)l * D * D, D, [=](int n) -> const float* { return W + n; }, [=](int) { return 1.0f; }, 1.0f); }
        { const float* Wg = in.w_gate + (size_t)l * D * FF; const float* Wu = in.w_up + (size_t)l * D * FF; const float* gn = in.norm_ffn_g + l * D;
          conv_T(gw, NGW, cbase, lane, scr, D, FF, 2 * FF, (bf16_t*)(wl + WL_GU), D,
                 [=](int n) -> const float* { const int tl = n >> 8, r = n & 255; return r < 128 ? Wg + tl * 128 + r : Wu + tl * 128 + (r - 128); }, [=](int k) { return gn[k]; }, 1.0f); }
        { const float* W = in.w_down + (size_t)l * FF * D;
          conv_T(gw, NGW, cbase, lane, scr, FF, D, D, (bf16_t*)(wl + WL_DN), FF, [=](int n) -> const float* { return W + n; }, [=](int) { return 1.0f; }, 1.0f); }
        { const float* W = in.w_xq + (size_t)l * D * D; const float* gn = in.norm_x_g + l * D; bf16_t* dst = (bf16_t*)(wl + WL_XQ);
          for (int i = vcu * 512 + tid; i < D * D / 8; i += G * 512) { const int k = i >> 7; const float sc = gn[k] * (0.0625f * LOG2E); const f32x4 a = *(const f32x4*)(W + (size_t)i * 8) * sc, b = *(const f32x4*)(W + (size_t)i * 8 + 4) * sc;
              *(u32x4*)(dst + (size_t)i * 8) = ep::pack8(a, b); } }
    }
}
struct Args { In in; float* out; unsigned char* ws; Freqs fr; int ph_hi; int pad; };

template <class F> struct PanelFn { F f; __device__ __forceinline__ void operator()(const pg8::Unit& u, const char*& a, const char*& b) const { f(u, a, b); } };
template <class F> __device__ __forceinline__ PanelFn<F> make_panel(F f) { return PanelFn<F>{f}; }
template <class F> struct OutFnT { F f; __device__ __forceinline__ bf16_t* operator()(const pg8::Unit& u, int& ld) const { return f(u, ld); } };
template <class F> __device__ __forceinline__ ep::EpiStore<OutFnT<F>> make_store(F f) { return ep::EpiStore<OutFnT<F>>{OutFnT<F>{f}}; }

__global__ void __launch_bounds__(512, 2) mk_fwd(Args a) {
    extern __shared__ __attribute__((aligned(16))) unsigned char lds_raw[];
    LAS unsigned char* lds = (LAS unsigned char*)lds_raw;
    const int tid = threadIdx.x, lane = tid & 63, wave = __builtin_amdgcn_readfirstlane(tid >> 6);
    const int G = gridDim.x, bx = blockIdx.x, vcu = (G % 8 == 0) ? (bx % 8) * (G / 8) + bx / 8 : bx;
    unsigned char* ws = a.ws; float* out = a.out;
    unsigned* ctl = (unsigned*)(ws + WS_CTL);
    for (int u = tid; u < (LDS_BYTES - LDSCTL_OFF) / 4; u += 512) ((LAS unsigned*)(lds + LDSCTL_OFF))[u] = 0u;
    __syncthreads();
    XcdBarrier bar = xcd_barrier_post(ctl + CW_BAR, (volatile LAS unsigned*)(lds + LDSCTL_OFF));
    int ph = 0;
#ifndef MK_MASK
#define MK_MASK 0xffff
#endif
#ifdef MK_TSET
    unsigned long long t_prev = __builtin_amdgcn_s_memrealtime(), t_acc = 0ull; int id_prev = -1;
#define T_STAMP(id) { const unsigned long long t_now = __builtin_amdgcn_s_memrealtime(); if (id_prev >= 0 && ((MK_TSET >> id_prev) & 1)) t_acc += t_now - t_prev; t_prev = t_now; id_prev = (id); }
#ifdef MK_TBAR
#define GRID_BAR { const unsigned long long tb0 = __builtin_amdgcn_s_memrealtime(); xcd_barrier(bar); t_acc += __builtin_amdgcn_s_memrealtime() - tb0; }
#else
#define GRID_BAR xcd_barrier(bar)
#endif
#else
#define T_STAMP(id)
#ifdef MK_DBLBAR
#define GRID_BAR { xcd_barrier(bar); xcd_barrier(bar); }
#else
#define GRID_BAR xcd_barrier(bar)
#endif
#endif
#define PHASE_BEGIN(id) if (ph++ >= a.ph_hi) return; T_STAMP(id) if ((MK_MASK >> (id)) & 1)
    float* sqb = (float*)ctl + CW_SQ;
#define SQ(l, id) (sqb + (size_t)((l) * SQ_PER_LAYER + (id)) * T)
    bf16_t* hb = (bf16_t*)(ws + WS_HB); bf16_t* assm = (bf16_t*)(ws + WS_ASSM); const float* cs = (const float*)(ws + WS_CS);
    unsigned char* ra = ws + WS_RA;
    pg8::StaticOrder SO;
#ifdef MK_CLKPROBE
    unsigned clk_mhz = 0;
#endif
    const long NEVER = 1 << 30;

#ifndef MK_REP_PRO
#define MK_REP_PRO 1
#define MK_REP_PARTS 7
#define MK_REP_ATTN 1
#define MK_REP_P9 1
#endif
    PHASE_BEGIN(0) { for (int rep = 0; rep < MK_REP_PRO; ++rep) prologue(a.in, a.fr, ws, lds, vcu, G, rep ? MK_REP_PARTS : 7); } GRID_BAR;
    PHASE_BEGIN(1) {
        const char* A0 = (const char*)(ra + RA_MEMN); const char* B0 = (const char*)(ws + WS_WXKV); bf16_t* kvm = (bf16_t*)(ra + RA_KVM);
        SO.init(8, 16, G, bx);
        auto PN = make_panel([=](const pg8::Unit& u, const char*& pa, const char*& pb) { pa = A0 + (size_t)u.pm * 256 * 1024 * 2; pb = B0 + (size_t)u.pn * 256 * 1024 * 2; });
        auto E = make_store([=](const pg8::Unit& u, int& ld) -> bf16_t* { ld = 2048; return kvm + ((size_t)(u.pn >> 3) * 2048 + u.pm * 256) * 2048 + (u.pn & 7) * 256; });
        pg8::gemm_phase(lds, pg8::GemmArgs{1024, 1024, 1024, (int)NEVER, 0}, SO, PN, E);
    } GRID_BAR;
    PHASE_BEGIN(2) {
        const char* kvm = (const char*)(ra + RA_KVM); bf16_t* wkvw = (bf16_t*)(ws + WS_WKVW);
        { SO.init(64, 4, G, bx);
          const char* wx = (const char*)(ws + WS_W + WL_XQ);
          auto PN = make_panel([=](const pg8::Unit& u, const char*& pa, const char*& pb) { const int l = u.pm >> 5, b = (u.pm >> 2) & 7, h = u.pm & 3;
              pa = kvm + (((size_t)l * 2048 + b * 256) * 2048 + h * 256) * 2; pb = wx + (size_t)l * WL_STRIDE + ((size_t)u.pn * 256 * 1024 + h * 256) * 2; });
          auto E = make_store([=](const pg8::Unit& u, int& ld) -> bf16_t* { const int l = u.pm >> 5, b = (u.pm >> 2) & 7, h = u.pm & 3; ld = 1024;
              return wkvw + ((size_t)(l * 16 + b) << 20) + (size_t)(h * 256) * 1024 + u.pn * 256; });
          pg8::gemm_phase(lds, pg8::GemmArgs{256, 2048, 1024, (int)NEVER, 0}, SO, PN, E); }
        { SO.init(256, 1, G, bx);
          const char* wo = (const char*)(ws + WS_WXO);
          auto PN = make_panel([=](const pg8::Unit& u, const char*& pa, const char*& pb) { const int rt = u.pm & 3, h = (u.pm >> 2) & 3, b = (u.pm >> 4) & 7, l = u.pm >> 7;
              pa = wo + (((size_t)l * 1024 + rt * 256) * 1024 + h * 256) * 2; pb = kvm + (((size_t)l * 2048 + b * 256) * 2048 + 1024 + h * 256) * 2; });
          auto E = make_store([=](const pg8::Unit& u, int& ld) -> bf16_t* { const int rt = u.pm & 3, h = (u.pm >> 2) & 3, b = (u.pm >> 4) & 7, l = u.pm >> 7; ld = 1024;
              return wkvw + ((size_t)(l * 16 + 8 + b) << 20) + (size_t)(rt * 256) * 1024 + h * 256; });
          pg8::gemm_phase(lds, pg8::GemmArgs{256, 1024, 2048, (int)NEVER, 0}, SO, PN, E); }
    } GRID_BAR;

    for (int l = 0; l < NL; ++l) {
        const char* wl = (const char*)(ws + WS_W + (size_t)l * WL_STRIDE);
        PHASE_BEGIN(3) {
            SO.init(128, 4, G, bx);
            auto PN = make_panel([=](const pg8::Unit& u, const char*& pa, const char*& pb) { pa = (const char*)hb + (size_t)u.pm * 256 * 1024 * 2; pb = wl + WL_IN + (size_t)u.pn * 256 * 1024 * 2; });
            ep::EpiProj E{SQ(l, SQ_MIX), SQ(l, SQ_CQ), SQ(l, SQ_CKV), (bf16_t*)(ra + RA_PROJB), assm, ra + RA_K, cs};
            pg8::gemm_phase(lds, pg8::GemmArgs{1024, 1024, 1024, (int)NEVER, 0}, SO, PN, E);
        } GRID_BAR;
        PHASE_BEGIN(4) {
            const char* pj = (const char*)(ra + RA_PROJB);
            { SO.init(128, 3, G, bx);
              auto PN = make_panel([=](const pg8::Unit& u, const char*& pa, const char*& pb) { pa = pj + (size_t)u.pm * 256 * 512 * 2; pb = wl + WL_UP + (size_t)u.pn * 256 * 256 * 2; });
              ep::EpiQ E{SQ(l, SQ_CQ), (bf16_t*)(ra + RA_Q), cs};
              pg8::gemm_phase(lds, pg8::GemmArgs{256, 512, 256, (int)NEVER, 0}, SO, PN, E); }
            { SO.init(128, 4, G, bx);
              auto PN = make_panel([=](const pg8::Unit& u, const char*& pa, const char*& pb) { pa = pj + (size_t)u.pm * 256 * 512 * 2 + 512; pb = wl + WL_UP + (size_t)(u.pn + 3) * 256 * 256 * 2; });
              ep::EpiKV E{SQ(l, SQ_CKV), ra + RA_K, ra + RA_V};
              pg8::gemm_phase(lds, pg8::GemmArgs{256, 512, 256, (int)NEVER, 0}, SO, PN, E); }
            { SO.init(128, 1, G, (bx + G / 2) % G);
              const char* bt = (const char*)(ws + WS_SSM) + (size_t)l * 32 * SSM_G_STRIDE;
              auto PN = make_panel([=](const pg8::Unit& u, const char*& pa, const char*& pb) { pa = (const char*)assm + (size_t)u.pm * 256 * KS3 * 2; pb = bt + (size_t)(u.pm >> 2) * SSM_G_STRIDE; });
              ep::EpiXloc E{(float*)(ra + RA_XLOC)};
              pg8::gemm_phase(lds, pg8::GemmArgs{KS1, KS3, KS1, (int)NEVER, 0}, SO, PN, E); }
        } GRID_BAR;
        PHASE_BEGIN(5) {
            ssm_scan_phase(vcu, G, (const float*)(ra + RA_XLOC), (const float*)(ws + WS_AL) + (size_t)l * 32 * 64 * 2, assm, lds);
            for (int rep = 0; rep < MK_REP_ATTN; ++rep) att::attn_phase(vcu, G, (const bf16_t*)(ra + RA_Q), ra + RA_K, ra + RA_V, (bf16_t*)(ra + RA_AO), rep ? SQ(2, 1) : SQ(l, SQ_A), lds);
        } GRID_BAR;
        PHASE_BEGIN(6) {
            SO.init(128, 2, G, bx);
            const char* bt = (const char*)(ws + WS_SSM) + (size_t)l * 32 * SSM_G_STRIDE + SSM_BT3_OFF;
            auto PN = make_panel([=](const pg8::Unit& u, const char*& pa, const char*& pb) { pa = (const char*)assm + (size_t)u.pm * 256 * KS3 * 2; pb = bt + (size_t)(u.pm >> 2) * SSM_G_STRIDE + (size_t)u.pn * 256 * KS3 * 2; });
            ep::EpiY E{(bf16_t*)(ra + RA_Y), (bf16_t*)(ra + RA_G)};
            pg8::gemm_phase(lds, pg8::GemmArgs{KS3, KS3, KS3, (int)NEVER, 0}, SO, PN, E);
        } GRID_BAR;
        PHASE_BEGIN(7) {
            SO.init(128, 2, G, bx);
            const char* gb = (const char*)(ra + RA_G);
            auto PN = make_panel([=](const pg8::Unit& u, const char*& pa, const char*& pb) { pa = gb + (size_t)u.pm * 256 * 512 * 2; pb = wl + WL_GLU + (size_t)u.pn * 256 * 512 * 2; });
            ep::EpiGlu E{(const bf16_t*)(ra + RA_Y), a.in.b_glu + l * 512, (bf16_t*)(ra + RA_SOUT), SQ(l, SQ_S)};
            pg8::gemm_phase(lds, pg8::GemmArgs{512, 512, 512, (int)NEVER, 0}, SO, PN, E);
        } GRID_BAR;
        PHASE_BEGIN(8) {
            SO.init(128, 4, G, bx);
            const char* ao = (const char*)(ra + RA_AO);
            auto PN = make_panel([=](const pg8::Unit& u, const char*& pa, const char*& pb) { pa = ao + (size_t)u.pm * 256 * 512 * 2; pb = wl + WL_OUT + (size_t)u.pn * 256 * 1024 * 2; });
            ep::EpiRes<true> E{l == 0 ? a.in.x : nullptr, nullptr, hb, SQ(l, SQ_X), SQ(l, SQ_A), SQ(l, SQ_S)};
            pg8::gemm_phase(lds, pg8::GemmArgs{1024, 512, 1024, 8, (long)(RA_SOUT - RA_AO) - 8 * 128}, SO, PN, E);
        } GRID_BAR;
        PHASE_BEGIN(9) {
            SO.init(128, 4, G, bx);
            const char* wk = (const char*)(ws + WS_WKVW) + ((size_t)(l * 16) << 21);
            auto PN = make_panel([=](const pg8::Unit& u, const char*& pa, const char*& pb) { pa = (const char*)hb + (size_t)u.pm * 256 * 1024 * 2; pb = wk + ((size_t)(u.pm >> 4) << 21) + (size_t)u.pn * 256 * 1024 * 2; });
            ep::EpiSoftmax E{SQ(l, SQ_X), (bf16_t*)(ra + RA_P)};
            pg8::gemm_phase(lds, pg8::GemmArgs{1024, 1024, 1024, (int)NEVER, 0}, SO, PN, E);
        } GRID_BAR;
        PHASE_BEGIN(10) {
            SO.init(128, 4, G, bx);
            const char* vw = (const char*)(ws + WS_WKVW) + ((size_t)(l * 16 + 8) << 21); const char* pp = (const char*)(ra + RA_P);
            auto PN = make_panel([=](const pg8::Unit& u, const char*& pa, const char*& pb) { pa = pp + (size_t)u.pm * 256 * 1024 * 2; pb = vw + ((size_t)(u.pm >> 4) << 21) + (size_t)u.pn * 256 * 1024 * 2; });
            ep::EpiRes<false> E{nullptr, nullptr, hb, SQ(l, SQ_FFN), nullptr, nullptr};
            pg8::gemm_phase(lds, pg8::GemmArgs{1024, 1024, 1024, (int)NEVER, 0}, SO, PN, E);
        } GRID_BAR;
#ifdef MK_CLKPROBE
        unsigned long long ck0 = __builtin_amdgcn_s_memtime(), rk0 = __builtin_amdgcn_s_memrealtime();
#endif
        PHASE_BEGIN(11) {
            SO.init(128, 22, G, bx);
            auto PN = make_panel([=](const pg8::Unit& u, const char*& pa, const char*& pb) { pa = (const char*)hb + (size_t)u.pm * 256 * 1024 * 2; pb = wl + WL_GU + (size_t)u.pn * 256 * 1024 * 2; });
            ep::EpiSwiglu E{SQ(l, SQ_FFN), (bf16_t*)(ra + RA_HID)};
            for (int rep = 0; rep < MK_REP_P9; ++rep) pg8::gemm_phase(lds, pg8::GemmArgs{1024, 1024, 1024, (int)NEVER, 0}, SO, PN, E);
        } GRID_BAR;
#ifdef MK_CLKPROBE
        if (l == 0) { const unsigned long long ck1 = __builtin_amdgcn_s_memtime(), rk1 = __builtin_amdgcn_s_memrealtime(); clk_mhz = (unsigned)(((ck1 - ck0) * 100ull) / (rk1 - rk0)); }
#endif
        PHASE_BEGIN(12) {
            SO.init(128, 4, G, bx);
            const char* hd = (const char*)(ra + RA_HID);
            auto PN = make_panel([=](const pg8::Unit& u, const char*& pa, const char*& pb) { pa = hd + (size_t)u.pm * 256 * FF * 2; pb = wl + WL_DN + (size_t)u.pn * 256 * FF * 2; });
            ep::EpiRes<false> E{nullptr, l == NL - 1 ? out : nullptr, hb, SQ(l + 1, SQ_MIX), nullptr, nullptr};
            pg8::gemm_phase(lds, pg8::GemmArgs{FF, FF, FF, (int)NEVER, 0}, SO, PN, E);
        } GRID_BAR;
    }
    PHASE_BEGIN(13) {
        const float* sqf = SQ(NL, SQ_MIX); const float* gf = a.in.final_g;
        for (int r = vcu * 8 + wave; r < T; r += G * 8) { const float rs = rstd_of(sqf[r], 1.0f / 1024.0f); f32x4* orow = (f32x4*)(out + (size_t)r * D) + lane; const f32x4* gr = (const f32x4*)gf + lane;
#pragma unroll
            for (int j = 0; j < 4; ++j) orow[64 * j] = orow[64 * j] * rs * gr[64 * j]; }
    }
#ifdef MK_CLKPROBE
    if (blockIdx.x == 0) { const unsigned long long t_end = __builtin_amdgcn_s_memrealtime(); while (__builtin_amdgcn_s_memrealtime() - t_end < (unsigned long long)clk_mhz * 50ull) __builtin_amdgcn_s_sleep(8); }
#endif
#ifdef MK_TSET
    T_STAMP(14)
    if (blockIdx.x == 0) { const unsigned long long t_end = __builtin_amdgcn_s_memrealtime(); while (__builtin_amdgcn_s_memrealtime() - t_end < t_acc) __builtin_amdgcn_s_sleep(8); }
#endif
#undef PHASE_BEGIN
#undef GRID_BAR
#undef SQ
}

extern "C" void kernel_launch(void* const* d_in, const int* in_sizes, int n_in, void* d_out, int out_size, void* d_ws, size_t ws_size, hipStream_t stream) {
    static int grid = 0;
    if (grid == 0) {
        if (n_in != 32 || out_size != T * D || ws_size < WS_END) { fprintf(stderr, "kernel_launch: unexpected shapes (n_in %d out %d ws %zu)\n", n_in, out_size, ws_size); grid = -1; return; }
        int dev = 0, cus = 0, per_cu = 0;
        if (hipGetDevice(&dev) != hipSuccess || hipDeviceGetAttribute(&cus, hipDeviceAttributeMultiprocessorCount, dev) != hipSuccess) { grid = -1; return; }
        if (hipFuncSetAttribute((const void*)mk_fwd, hipFuncAttributeMaxDynamicSharedMemorySize, LDS_BYTES) != hipSuccess) { fprintf(stderr, "kernel_launch: hipFuncSetAttribute failed\n"); grid = -1; return; }
        if (hipOccupancyMaxActiveBlocksPerMultiprocessor(&per_cu, (const void*)mk_fwd, 512, LDS_BYTES) != hipSuccess || per_cu < 1) { fprintf(stderr, "kernel_launch: occupancy query says %d\n", per_cu); per_cu = 1; }
        (void)hipGetLastError();
        grid = cus;
    }
    if (grid < 0) return;
    if (hipMemsetAsync((char*)d_ws + WS_CTL, 0, CTL_ZERO_BYTES, stream) != hipSuccess) return;
    Args a{};
    const void** ip = (const void**)&a.in;
    for (int i = 0; i < 32; ++i) ip[i] = d_in[i];
    a.out = (float*)d_out; a.ws = (unsigned char*)d_ws;
    for (int i = 0; i < 16; ++i) a.fr.f[i] = std::pow(10000.0, -(double)i / 16.0);
#ifndef MK_PH_HI
#define MK_PH_HI 1000
#endif
    a.ph_hi = MK_PH_HI; a.pad = 0;
    void* args[] = {&a};
    hipError_t e = hipLaunchCooperativeKernel((const void*)mk_fwd, dim3(grid), dim3(512), args, LDS_BYTES, stream);
    if (e != hipSuccess) fprintf(stderr, "kernel_launch: cooperative launch failed: %s (grid %d)\n", hipGetErrorString(e), grid);
}
```

```cpp
#include <hip/hip_runtime.h>
#include <hip/hip_bf16.h>
#include <cstdint>
#include <cstdio>
#include <cmath>

#define LAS __attribute__((address_space(3)))
typedef unsigned short bf16_t;
typedef short bf16x8 __attribute__((ext_vector_type(8)));
typedef short s16x4 __attribute__((ext_vector_type(4)));
typedef float f32x4 __attribute__((ext_vector_type(4)));
typedef float f32x2 __attribute__((ext_vector_type(2)));
typedef float f32x16 __attribute__((ext_vector_type(16)));
typedef unsigned u32x4 __attribute__((ext_vector_type(4)));
typedef unsigned u32x2 __attribute__((ext_vector_type(2)));

constexpr int D = 1024, NB = 8, S = 4096, T = NB * S, NL = 2, FF = 2816;
constexpr int NH = 8, QKD = 96, HD = 64;
constexpr int LC = 32, KS1 = 16 * LC  , KS3 = KS1 + 128  , NCHB = S / LC  , NCH = T / LC  ;
constexpr int MEMT = 256;
constexpr float EPS = 1e-6f;
constexpr float LOG2E = 1.4426950408889634f;

constexpr size_t MiB = 1u << 20;
constexpr size_t WS_CTL = 0, CTL_ZERO_BYTES = 4 * MiB;
constexpr size_t WS_CS = 4 * MiB;
constexpr size_t WS_W = 8 * MiB;
constexpr size_t WL_IN = 0, WL_UP = 2 * MiB, WL_GLU = 3 * MiB, WL_OUT = 3 * MiB + 512 * 1024, WL_XQ = 5 * MiB + 512 * 1024, WL_GU = 7 * MiB + 512 * 1024, WL_DN = 18 * MiB + 512 * 1024, WL_STRIDE = 24 * MiB + 512 * 1024;
constexpr size_t WS_WXKV = WS_W + 2 * WL_STRIDE;
constexpr size_t WS_WXO = WS_WXKV + 8 * MiB;
constexpr size_t WS_SSM = 70 * MiB;
constexpr size_t SSM_G_STRIDE = 896 * 1024, SSM_BT3_OFF = 256 * 1024;
constexpr size_t WS_AL = 126 * MiB;
constexpr size_t WS_WKVW = 128 * MiB;
constexpr size_t WS_HB = 192 * MiB;
constexpr size_t WS_ASSM = 256 * MiB;
constexpr size_t WS_RA = 296 * MiB;
constexpr size_t WS_END = WS_RA + 176 * MiB;
constexpr size_t RA_PROJB = 0, RA_AO = 0, RA_Q = 32 * MiB, RA_K = 80 * MiB, RA_V = 128 * MiB, RA_XLOC = 160 * MiB;
constexpr size_t RA_Y = 32 * MiB, RA_G = 64 * MiB, RA_SOUT = 96 * MiB;
constexpr size_t RA_P = 0, RA_HID = 0, RA_MEMN = 0, RA_KVM = 4 * MiB;
constexpr int CW_BAR = 4096;
constexpr int CW_SQ = 65536;
enum SqId { SQ_MIX = 0, SQ_CQ = 1, SQ_CKV = 2, SQ_A = 3, SQ_S = 4, SQ_X = 5, SQ_FFN = 6, SQ_PER_LAYER = 7 };
static_assert((size_t)(CW_SQ + 16 * T) * 4 <= CTL_ZERO_BYTES, "ctl");

constexpr int RING_BYTES = 131072, XCH_OFF = RING_BYTES  , LDSCTL_OFF = XCH_OFF + 12288, LDS_BYTES = 147456;

__device__ __forceinline__ unsigned cvt_pk_bf16(float lo, float hi) { typedef __bf16 bf2 __attribute__((ext_vector_type(2))); f32x2 v = {lo, hi}; bf2 b = __builtin_convertvector(v, bf2); return __builtin_bit_cast(unsigned, b); }
__device__ __forceinline__ float bf_lo(unsigned w) { return __uint_as_float(w << 16); }
__device__ __forceinline__ float bf_hi(unsigned w) { return __uint_as_float(w & 0xffff0000u); }
__device__ __forceinline__ float rstd_of(float sq, float inv_n) { return rsqrtf(sq * inv_n + EPS); }

#define XB_TMO      128
#define XB_XCNT(j)  (256  + 64 * (j))
#define XB_XSUB(j)  (1280 + 64 * (j))
#define XB_XGEN(j)  (2304 + 64 * (j))
#define XB_TOP      3328
#define XB_TOPGEN   3392
#define XCD_BAR_WORDS 3456
#define XB_SPIN_CAP (1u << 20)
__device__ __forceinline__ unsigned xb_ld(unsigned* p)              { return __hip_atomic_load(p, __ATOMIC_RELAXED, __HIP_MEMORY_SCOPE_AGENT); }
__device__ __forceinline__ unsigned xb_add(unsigned* p, unsigned v) { return __hip_atomic_fetch_add(p, v, __ATOMIC_RELAXED, __HIP_MEMORY_SCOPE_AGENT); }
__device__ __forceinline__ unsigned xb_xcc_id() { return (unsigned)__builtin_amdgcn_s_getreg((3 << 11) | 20) & 0xFu; }
#define XB_SPIN(cond, bar) do { unsigned _sp = 0; while (cond) { __builtin_amdgcn_s_sleep(1); \
    if ((++_sp & 255u) == 0u) { if (xb_ld(&(bar)[XB_TMO])) break; if (_sp > XB_SPIN_CAP) { atomicAdd(&(bar)[XB_TMO], 1u); break; } } } } while (0)
struct XcdBarrier { unsigned* bar; unsigned x; volatile LAS unsigned* st; };
__device__ __forceinline__ XcdBarrier xcd_barrier_post(unsigned* bar, volatile LAS unsigned* st) {
    XcdBarrier b; b.bar = bar; b.x = xb_xcc_id(); b.st = st;
    if (threadIdx.x == 0) (void)xb_add(&bar[XB_XCNT(b.x)], 1u);
    return b;
}
__device__ __forceinline__ void xcd_barrier_complete(unsigned* bar, unsigned x, unsigned& nloc, unsigned& nx) {
    const unsigned G = gridDim.x * gridDim.y * gridDim.z;
    unsigned sum, cnt, mine, sp = 0u;
    for (;;) {
        sum = 0u; cnt = 0u; mine = 0u;
#pragma unroll
        for (unsigned j = 0; j < 16; ++j) { const unsigned c = xb_ld(&bar[XB_XCNT(j)]); sum += c; cnt += (c > 0u) ? 1u : 0u; mine = (j == x) ? c : mine; }
        if (sum == G) break;
        __builtin_amdgcn_s_sleep(1);
        if ((++sp & 255u) == 0u) { if (xb_ld(&bar[XB_TMO])) break; if (sp > XB_SPIN_CAP) { atomicAdd(&bar[XB_TMO], 1u); break; } }
    }
    nloc = mine > 0u ? mine : 1u; nx = cnt > 0u ? cnt : 1u;
}
__device__ __forceinline__ void xcd_barrier(const XcdBarrier& b) {
    asm volatile("s_waitcnt vmcnt(0)" ::: "memory");
    __syncthreads();
    if (threadIdx.x == 0) {
        unsigned* bar = b.bar; asm volatile("" : "+s"(bar));
        __builtin_amdgcn_s_waitcnt(0);
        unsigned nloc = b.st[0], nx = b.st[1];
        if (nloc == 0u) { xcd_barrier_complete(bar, b.x, nloc, nx); b.st[0] = nloc; b.st[1] = nx; }
        const unsigned old = xb_add(&bar[XB_XSUB(b.x)], 1u);
        const unsigned gen = old / nloc;
        if (old + 1u == (gen + 1u) * nloc) {
            __builtin_amdgcn_fence(__ATOMIC_RELEASE, "agent");
            asm volatile("s_waitcnt vmcnt(0)" ::: "memory");
            const unsigned og = xb_add(&bar[XB_TOP], 1u);
            const unsigned tg = og / nx;
            if (og + 1u == (tg + 1u) * nx) xb_add(&bar[XB_TOPGEN], 1u);
            else XB_SPIN(xb_ld(&bar[XB_TOPGEN]) == tg, bar);
            __builtin_amdgcn_fence(__ATOMIC_ACQUIRE, "agent");
            xb_add(&bar[XB_XGEN(b.x)], 1u);
            asm volatile("s_waitcnt vmcnt(0)" ::: "memory");
        } else {
            XB_SPIN(xb_ld(&bar[XB_XGEN(b.x)]) == gen, bar);
            __builtin_amdgcn_fence(__ATOMIC_ACQUIRE, "agent");
            asm volatile("s_waitcnt vmcnt(0)" ::: "memory");
        }
    }
    __syncthreads();
}

namespace pg8 {
constexpr int BM = 256, BK = 64, HALF = 128, HTB = HALF * BK * 2, STAGE_BYTES = 8 * HTB, NXCD = 8, WGM = 8;
__host__ __device__ __forceinline__ int lds_byte(int r, int c) { const int st = (r >> 4) * 2 + (c >> 5), rr = r & 15, cc = c & 31, ob = rr * 64 + cc * 2; return st * 1024 + (ob ^ (((ob >> 9) & 1) << 5)); }
__host__ __device__ __forceinline__ void stage_rc(int b, int& R, int& C) { const int st = b / 1024, sb = b % 1024, swz = sb ^ (((sb >> 9) & 1) << 5); R = (st >> 1) * 16 + swz / 64; C = (st & 1) * 32 + (swz % 64) / 2; }
__host__ __device__ __forceinline__ int perm32(int rho) { const int n = rho >> 4, i = rho & 15; return 8 * (i >> 2) + 4 * n + (i & 3); }
struct Unit { int pm, pn; };
struct StaticOrder {
    int nM, nN, nwg, G, c;
    __device__ void init(int nM_, int nN_, int G_, int c_) { nM = nM_; nN = nN_; nwg = nM * nN; G = G_; c = c_; }
    __device__ bool next(int i, Unit& u) const {
        const long L = (long)i * G + c; if (L >= nwg) return false;
        int wgid = (int)L; { const int q = nwg / NXCD, r = nwg % NXCD, xcd = wgid % NXCD, off = wgid / NXCD; wgid = (xcd < r ? xcd * (q + 1) : r * (q + 1) + (xcd - r) * q) + off; }
        const int nig = WGM * nN, gid = wgid / nig, fm = gid * WGM, gsz = (nM - fm) < WGM ? (nM - fm) : WGM;
        u.pm = fm + ((wgid % nig) % gsz); u.pn = (wgid % nig) / gsz; return true;
    }
};
struct Ctx { int wr, wc, fr, fq, wid, lane, tid; LAS unsigned char* lds; };
typedef f32x4 Acc[2][2][4][2];

struct GemmArgs { int K, lda, ldb, tsplit; long a_delta; };

template <class Epi, class Panel>
__device__ __forceinline__ void gemm_phase(LAS unsigned char* lds, const GemmArgs g, const StaticOrder& S, const Panel& PN, const Epi& E) {
    int tid_ = threadIdx.x; asm volatile("" : "+v"(tid_));
    const int tid = tid_, wid = __builtin_amdgcn_readfirstlane(tid >> 6), lane = tid & 63, wr = wid >> 2, wc = wid & 3, fr = lane & 15, fq = lane >> 4;
    const int nt = g.K / BK;
    Ctx cx{wr, wc, fr, fq, wid, lane, tid, lds};
    unsigned voffA[2], voffB[2];
#pragma unroll
    for (int i = 0; i < 2; ++i) { int R, C; stage_rc(tid * 16 + i * 8192, R, C); const int Rb = (R & ~31) + perm32(R & 31);
        voffA[i] = (unsigned)(R * g.lda + C) * 2u; voffB[i] = (unsigned)(Rb * g.ldb + C) * 2u; }
    const size_t kstep = (size_t)(BK * 2);
    const size_t hstepA = (size_t)HALF * g.lda * 2, hstepB = (size_t)HALF * g.ldb * 2;
    const unsigned ldsw = (unsigned)wid * 1024u;
    const int aoff = lds_byte(wr * 64 + fr, fq * 8), boff = lds_byte(wc * 32 + fr, fq * 8);
#define PG8_SA(b, h) (((b) * 2 + (h)) * HTB)
#define PG8_SB(b, h) ((4 + (b) * 2 + (h)) * HTB)
#define PG8_STAGE(bufoff, gbase, voff) do { _Pragma("unroll") for (int _i = 0; _i < 2; ++_i) \
        __builtin_amdgcn_global_load_lds((const unsigned*)((const char*)(gbase) + (voff)[_i]), (LAS unsigned*)(lds + (bufoff) + ldsw + _i * 8192), 16, 0, 0); } while (0)
#define PG8_LDA(dst, b, h) do { _Pragma("unroll") for (int m = 0; m < 4; ++m) _Pragma("unroll") for (int k = 0; k < 2; ++k) dst[m][k] = *(const LAS bf16x8*)(lds + PG8_SA(b, h) + aoff + m * 2048 + k * 1024); } while (0)
#define PG8_LDB(dst, b, h) do { _Pragma("unroll") for (int n = 0; n < 2; ++n) _Pragma("unroll") for (int k = 0; k < 2; ++k) dst[n][k] = *(const LAS bf16x8*)(lds + PG8_SB(b, h) + boff + n * 2048 + k * 1024); } while (0)
#define PG8_MMA(ai, bj, At, Bt) do { __builtin_amdgcn_s_setprio(1); _Pragma("unroll") for (int m = 0; m < 4; ++m) _Pragma("unroll") for (int n = 0; n < 2; ++n) _Pragma("unroll") for (int k = 0; k < 2; ++k) \
        acc[ai][bj][m][n] = __builtin_amdgcn_mfma_f32_16x16x32_bf16(Bt[n][k], At[m][k], acc[ai][bj][m][n], 0, 0, 0); __builtin_amdgcn_s_setprio(0); } while (0)
#define PG8_WAIT_V(n) asm volatile("s_waitcnt vmcnt(" #n ")" ::: "memory")
#define PG8_WAIT_L(n) asm volatile("s_waitcnt lgkmcnt(" #n ")" ::: "memory")
#define PG8_BAR __builtin_amdgcn_s_barrier()
#define PG8_SCHED __builtin_amdgcn_sched_barrier(0)
#define PG8_AP(base, tt) ((base) + (size_t)(tt) * kstep + (((tt) >= g.tsplit) ? g.a_delta : 0l))
    Unit cur, nxt; int ui = 0;
    if (!S.next(0, cur)) return;
    Acc acc;
#pragma unroll
    for (int a = 0; a < 2; ++a)
#pragma unroll
        for (int b = 0; b < 2; ++b)
#pragma unroll
            for (int m = 0; m < 4; ++m)
#pragma unroll
                for (int n = 0; n < 2; ++n) acc[a][b][m][n] = (f32x4){0.f, 0.f, 0.f, 0.f};
    bf16x8 At[4][2], B0[2][2], B1[2][2];
    const char* cA; const char* cB; PN(cur, cA, cB);
    if constexpr (Epi::HAS_BEGIN) E.begin(cur, cx, ui);
    PG8_STAGE(PG8_SB(0, 0), cB, voffB); PG8_STAGE(PG8_SB(0, 1), cB + hstepB, voffB); PG8_STAGE(PG8_SA(0, 0), cA, voffA); PG8_STAGE(PG8_SA(0, 1), cA + hstepA, voffA);
    if (wr == 1) PG8_BAR;
    PG8_WAIT_V(2); PG8_BAR;
    PG8_STAGE(PG8_SB(1, 0), cB + kstep, voffB); PG8_STAGE(PG8_SA(1, 0), cA + kstep, voffA); PG8_STAGE(PG8_SB(1, 1), cB + hstepB + kstep, voffB);
    PG8_WAIT_V(6); PG8_BAR;
    for (;;) {
        const bool has_next = S.next(ui + 1, nxt);
        const char* nA = cA; const char* nB = cB; if (has_next) PN(nxt, nA, nB);
#pragma unroll 1
        for (int t = 0; t < nt; t += 2) {
            const bool last = (t == nt - 2);
            if constexpr (Epi::HAS_MID) { if (t == g.tsplit) E.mid(acc, cur, cx, ui); }
            const char* a1 = PG8_AP(cA, t + 1);
            const char* a2 = last ? nA : PG8_AP(cA, t + 2); const char* b2 = last ? nB : cB + (size_t)(t + 2) * kstep;
            const char* a3 = last ? nA + kstep : PG8_AP(cA, t + 3); const char* b3 = b2 + kstep;
            PG8_LDB(B0, 0, 0); PG8_LDB(B1, 0, 1); PG8_SCHED; PG8_LDA(At, 0, 0); PG8_STAGE(PG8_SA(1, 1), a1 + hstepA, voffA);
            PG8_WAIT_V(8); PG8_WAIT_L(0); PG8_BAR; PG8_MMA(0, 0, At, B0); PG8_MMA(0, 1, At, B1); PG8_BAR; PG8_SCHED;
            PG8_LDA(At, 0, 1); PG8_STAGE(PG8_SB(0, 0), b2, voffB); PG8_STAGE(PG8_SB(0, 1), b2 + hstepB, voffB); PG8_STAGE(PG8_SA(0, 0), a2, voffA);
            PG8_WAIT_V(8); PG8_WAIT_L(0); PG8_BAR; PG8_MMA(1, 0, At, B0); PG8_MMA(1, 1, At, B1); PG8_BAR; PG8_SCHED;
            PG8_LDB(B0, 1, 0); PG8_LDB(B1, 1, 1); PG8_SCHED; PG8_LDA(At, 1, 0); PG8_STAGE(PG8_SA(0, 1), a2 + hstepA, voffA);
            PG8_WAIT_V(8); PG8_WAIT_L(0); PG8_BAR; PG8_MMA(0, 0, At, B0); PG8_MMA(0, 1, At, B1); PG8_BAR; PG8_SCHED;
            PG8_LDA(At, 1, 1); PG8_STAGE(PG8_SB(1, 0), b3, voffB); PG8_STAGE(PG8_SB(1, 1), b3 + hstepB, voffB); PG8_STAGE(PG8_SA(1, 0), a3, voffA);
            PG8_WAIT_V(8); PG8_WAIT_L(0); PG8_BAR; PG8_MMA(1, 0, At, B0); PG8_MMA(1, 1, At, B1); PG8_BAR; PG8_SCHED;
        }
        if (wr == 0) PG8_BAR;
        E(acc, cur, cx, ui);
        if (!has_next) break;
#pragma unroll
        for (int a = 0; a < 2; ++a)
#pragma unroll
            for (int b = 0; b < 2; ++b)
#pragma unroll
                for (int m = 0; m < 4; ++m)
#pragma unroll
                    for (int n = 0; n < 2; ++n) acc[a][b][m][n] = (f32x4){0.f, 0.f, 0.f, 0.f};
        cur = nxt; cA = nA; cB = nB; ++ui;
        if constexpr (Epi::HAS_BEGIN) E.begin(cur, cx, ui);
        if (wr == 1) PG8_BAR;
    }
    PG8_WAIT_V(0);
    PG8_BAR;
    asm volatile("" ::: "memory");
#undef PG8_SA
#undef PG8_SB
#undef PG8_STAGE
#undef PG8_LDA
#undef PG8_LDB
#undef PG8_MMA
#undef PG8_WAIT_V
#undef PG8_WAIT_L
#undef PG8_BAR
#undef PG8_SCHED
#undef PG8_AP
}
}
namespace ep {
using pg8::Acc; using pg8::Ctx; using pg8::Unit;
#define EP_FOR_ROWS _Pragma("unroll") for (int ai = 0; ai < 2; ++ai) _Pragma("unroll") for (int m = 0; m < 4; ++m)
#define EP_RU (ai * 128 + cx.wr * 64 + m * 16)
#define EP_FENCE asm volatile("" ::: "memory")
#define EP_PRELOAD_RS(name, sqp, invn) float name[2][4]; EP_FOR_ROWS name[ai][m] = (sqp)[u.pm * 256 + EP_RU + cx.fr]; EP_FOR_ROWS name[ai][m] = rstd_of(name[ai][m], invn);
__device__ __forceinline__ u32x4 pack8(const f32x4 a, const f32x4 b) { u32x4 w; w.x = cvt_pk_bf16(a[0], a[1]); w.y = cvt_pk_bf16(a[2], a[3]); w.z = cvt_pk_bf16(b[0], b[1]); w.w = cvt_pk_bf16(b[2], b[3]); return w; }
__device__ __forceinline__ float sq8(const f32x4 a, const f32x4 b) { return (a[0] * a[0] + a[1] * a[1]) + (a[2] * a[2] + a[3] * a[3]) + (b[0] * b[0] + b[1] * b[1]) + (b[2] * b[2] + b[3] * b[3]); }
__device__ __forceinline__ void row_atomic(float* sq_u, int fr, float ss, int fq) { ss += __shfl_xor(ss, 16); ss += __shfl_xor(ss, 32); if (fq == 0) unsafeAtomicAdd(sq_u + fr, ss); }
template <class TT> __device__ __forceinline__ TT* lane_ptr(TT* uni, unsigned lane_bytes) { return (TT*)((char*)uni + lane_bytes); }
template <class TT> __device__ __forceinline__ const TT* lane_ptr(const TT* uni, unsigned lane_bytes) { return (const TT*)((const char*)uni + lane_bytes); }
__device__ __forceinline__ void rope8(f32x4& a, f32x4& b, const f32x4 c4, const f32x4 s4) {
    const f32x4 a0 = a, b0 = b;
    a[0] = a0[0] * c4[0] - a0[1] * s4[0]; a[1] = a0[1] * c4[0] + a0[0] * s4[0]; a[2] = a0[2] * c4[1] - a0[3] * s4[1]; a[3] = a0[3] * c4[1] + a0[2] * s4[1];
    b[0] = b0[0] * c4[2] - b0[1] * s4[2]; b[1] = b0[1] * c4[2] + b0[0] * s4[2]; b[2] = b0[2] * c4[3] - b0[3] * s4[3]; b[3] = b0[3] * c4[3] + b0[2] * s4[3];
}
__device__ __forceinline__ size_t koff_u(int b, int h, int s16, int chunk) { return ((((size_t)(b * 8 + h) * 64 + (s16 >> 6)) * 12 + chunk) * 64 + (s16 & 63)) * 16; }
__device__ __forceinline__ size_t voff_u(int b, int h, int s16, int dh) { return ((((size_t)(b * 8 + h) * 64 + (s16 >> 6)) * 2 + dh) * 64 + (s16 & 63)) * 64; }

struct EpiProj {
    static constexpr bool HAS_MID = false, HAS_BEGIN = false;
    const float* sq_in; float* sq_cq; float* sq_ckv; bf16_t* projb; bf16_t* assm; unsigned char* kb; const float* cs;
    __device__ __forceinline__ void operator()(Acc& acc, const Unit& u, const Ctx& cx, int) const {
        const unsigned l_pj = (unsigned)(cx.fr * 512 + cx.fq * 8) * 2u, l_cs = (unsigned)(cx.fr * 32 + cx.fq * 4) * 4u, l_k = (unsigned)cx.fr * 16u, l_as = (unsigned)(cx.fr * 16) * 2u;
        EP_PRELOAD_RS(rsv, sq_in, 1.0f / 1024.0f)
        EP_FOR_ROWS { const int rowu = u.pm * 256 + EP_RU; const float rs = rsv[ai][m];
            if (u.pn == 0) { float ss = 0.f;
#pragma unroll
                for (int bj = 0; bj < 2; ++bj) { const f32x4 v0 = acc[ai][bj][m][0] * rs, v1 = acc[ai][bj][m][1] * rs; ss += sq8(v0, v1);
                    *(u32x4*)lane_ptr(projb + (size_t)rowu * 512 + bj * 128 + cx.wc * 32, l_pj) = pack8(v0, v1); }
                row_atomic(sq_cq + rowu, cx.fr, ss, cx.fq);
            } else if (u.pn == 1) {
                { const f32x4 v0 = acc[ai][0][m][0] * rs, v1 = acc[ai][0][m][1] * rs; *(u32x4*)lane_ptr(projb + (size_t)rowu * 512 + 256 + cx.wc * 32, l_pj) = pack8(v0, v1); row_atomic(sq_ckv + rowu, cx.fr, sq8(v0, v1), cx.fq); }
                f32x4 v0 = acc[ai][1][m][0] * rs, v1 = acc[ai][1][m][1] * rs;
                if (cx.wc != 0) { v0 = (f32x4){0.f, 0.f, 0.f, 0.f}; v1 = v0; }
                *(u32x4*)lane_ptr(projb + (size_t)rowu * 512 + 384 + cx.wc * 32, l_pj) = pack8(v0, v1);
                if (cx.wc == 0) { const float* cp = lane_ptr(cs + (size_t)rowu * 32, l_cs); const f32x4 c4 = *(const f32x4*)cp, s4 = *(const f32x4*)(cp + 16);
                    rope8(v0, v1, c4, s4); const u32x4 w = pack8(v0, v1); const int b = rowu >> 12, s16 = rowu & 4095;
#pragma unroll
                    for (int h = 0; h < 8; ++h) *(u32x4*)lane_ptr(kb + koff_u(b, h, s16, 8) , l_k + (unsigned)cx.fq * 1024u) = w; }
            } else {
#pragma unroll
                for (int bj = 0; bj < 2; ++bj) { const f32x4 v0 = acc[ai][bj][m][0] * rs, v1 = acc[ai][bj][m][1] * rs; const int chu = (u.pn - 2) * 256 + bj * 128 + cx.wc * 32;
                    *(u32x4*)lane_ptr(assm + ((size_t)(chu >> 4) * NCH + (rowu >> 5)) * KS3 + (rowu & 31) * 16, l_as + (unsigned)(cx.fq >> 1) * (unsigned)(NCH * KS3 * 2) + (unsigned)(cx.fq & 1) * 16u) = pack8(v0, v1); }
            }
            EP_FENCE;
        }
    }
};
struct EpiQ {
    static constexpr bool HAS_MID = false, HAS_BEGIN = false;
    const float* sq_cq; bf16_t* qb; const float* cs;
    __device__ __forceinline__ void operator()(Acc& acc, const Unit& u, const Ctx& cx, int) const {
        const unsigned l_q = (unsigned)(cx.fr * 768 + cx.fq * 8) * 2u, l_cs = (unsigned)(cx.fr * 32 + cx.fq * 4) * 4u;
        EP_PRELOAD_RS(rsv, sq_cq, 1.0f / 256.0f)
        EP_FOR_ROWS { const int rowu = u.pm * 256 + EP_RU; const float rs = rsv[ai][m];
            f32x4 c4 = (f32x4){1.f, 1.f, 1.f, 1.f}, s4 = (f32x4){0.f, 0.f, 0.f, 0.f}; if (u.pn == 2) { const float* cp = lane_ptr(cs + (size_t)rowu * 32, l_cs); c4 = *(const f32x4*)cp; s4 = *(const f32x4*)(cp + 16); }
#pragma unroll
            for (int bj = 0; bj < 2; ++bj) { f32x4 v0 = acc[ai][bj][m][0] * rs, v1 = acc[ai][bj][m][1] * rs;
                if (u.pn == 2) rope8(v0, v1, c4, s4);
                *(u32x4*)lane_ptr(qb + (size_t)rowu * 768 + u.pn * 256 + bj * 128 + cx.wc * 32, l_q) = pack8(v0, v1); }
            EP_FENCE; }
    }
};
struct EpiKV {
    static constexpr bool HAS_MID = false, HAS_BEGIN = false;
    const float* sq_ckv; unsigned char* kb; unsigned char* vb;
    __device__ __forceinline__ void operator()(Acc& acc, const Unit& u, const Ctx& cx, int) const {
        const unsigned l_kv = (cx.wc < 2) ? (unsigned)cx.fr * 16u + (unsigned)cx.fq * 1024u : (unsigned)cx.fr * 64u + (unsigned)cx.fq * 16u;
        EP_PRELOAD_RS(rsv, sq_ckv, 1.0f / 128.0f)
        EP_FOR_ROWS { const int rowu = u.pm * 256 + EP_RU; const float rs = rsv[ai][m]; const int b = rowu >> 12, s16 = rowu & 4095;
#pragma unroll
            for (int bj = 0; bj < 2; ++bj) { const f32x4 v0 = acc[ai][bj][m][0] * rs, v1 = acc[ai][bj][m][1] * rs; const int h = 2 * u.pn + bj;
                unsigned char* dst = (cx.wc < 2) ? kb + koff_u(b, h, s16, cx.wc * 4) : vb + voff_u(b, h, s16, cx.wc - 2);
                *(u32x4*)lane_ptr(dst, l_kv) = pack8(v0, v1); }
            EP_FENCE; }
    }
};
struct EpiUp {
    static constexpr bool HAS_MID = false, HAS_BEGIN = false;
    EpiQ q; EpiKV kv;
    __device__ __forceinline__ void operator()(Acc& acc, const Unit& u, const Ctx& cx, int ui) const { if (u.pn < 3) q(acc, u, cx, ui); else { const Unit u2{u.pm, u.pn - 3}; kv(acc, u2, cx, ui); } }
};
struct EpiXloc {
    static constexpr bool HAS_MID = false, HAS_BEGIN = false;
    float* xloc;
    __device__ __forceinline__ void operator()(Acc& acc, const Unit& u, const Ctx& cx, int) const {
        const unsigned l_x = (unsigned)(cx.fr * 128 + cx.fq * 8) * 4u;
        EP_FOR_ROWS { const int rowu = u.pm * 256 + EP_RU; float* o = lane_ptr(xloc + (size_t)rowu * 128 + cx.wc * 32, l_x); *(f32x4*)o = acc[ai][0][m][0]; *(f32x4*)(o + 4) = acc[ai][0][m][1]; EP_FENCE; }
    }
};
__device__ __forceinline__ float gelu_tanh_f(float x) { const float z = 0.7978845608028654f * (x + 0.044715f * x * x * x); return x * __builtin_amdgcn_rcpf(1.0f + __builtin_amdgcn_exp2f(-2.0f * LOG2E * z)); }
__device__ __forceinline__ f32x4 gelu4(const f32x4 v) { return (f32x4){gelu_tanh_f(v[0]), gelu_tanh_f(v[1]), gelu_tanh_f(v[2]), gelu_tanh_f(v[3])}; }
struct EpiY {
    static constexpr bool HAS_MID = false, HAS_BEGIN = false;
    bf16_t* yb; bf16_t* gb;
    __device__ __forceinline__ void operator()(Acc& acc, const Unit& u, const Ctx& cx, int) const {
        const unsigned l_y = (unsigned)((cx.fr * 32 + (cx.fq >> 1)) * 512 + (cx.fq & 1) * 8) * 2u;
        EP_FOR_ROWS { const int rowu = u.pm * 256 + EP_RU, g = rowu >> 10, chunku = rowu & 1023;
#pragma unroll
            for (int bj = 0; bj < 2; ++bj) { const int colu = u.pn * 256 + bj * 128 + cx.wc * 32; const size_t o = ((size_t)chunku * 32 + (colu >> 4)) * 512 + g * 16;
                const f32x4 v0 = acc[ai][bj][m][0], v1 = acc[ai][bj][m][1]; *(u32x4*)lane_ptr(yb + o, l_y) = pack8(v0, v1); *(u32x4*)lane_ptr(gb + o, l_y) = pack8(gelu4(v0), gelu4(v1)); }
            EP_FENCE;
        }
    }
};
__device__ __forceinline__ float sigm(float z) { return __builtin_amdgcn_rcpf(1.0f + __builtin_amdgcn_exp2f(-LOG2E * z)); }
struct EpiGlu {
    static constexpr bool HAS_MID = false, HAS_BEGIN = false;
    const bf16_t* yb; const float* bglu; bf16_t* sout; float* sq_s;
    __device__ __forceinline__ void operator()(Acc& acc, const Unit& u, const Ctx& cx, int) const {
        const unsigned l_y = (unsigned)(cx.fr * 512 + cx.fq * 8) * 2u, l_b = (unsigned)(cx.fq * 8) * 4u;
        f32x4 bv[2][2];
#pragma unroll
        for (int bj = 0; bj < 2; ++bj) { const float* bp = lane_ptr(bglu + u.pn * 256 + bj * 128 + cx.wc * 32, l_b); bv[bj][0] = *(const f32x4*)bp; bv[bj][1] = *(const f32x4*)(bp + 4); }
#pragma unroll
        for (int ai = 0; ai < 2; ++ai) { u32x4 yw[4][2];
#pragma unroll
            for (int m = 0; m < 4; ++m)
#pragma unroll
                for (int bj = 0; bj < 2; ++bj) yw[m][bj] = *(const u32x4*)lane_ptr(yb + (size_t)(u.pm * 256 + EP_RU) * 512 + u.pn * 256 + bj * 128 + cx.wc * 32, l_y);
#pragma unroll
            for (int m = 0; m < 4; ++m) { const int rowu = u.pm * 256 + EP_RU; float ss = 0.f;
#pragma unroll
                for (int bj = 0; bj < 2; ++bj) { const int colu = u.pn * 256 + bj * 128 + cx.wc * 32; const u32x4 w = yw[m][bj];
                    const f32x4 z0 = acc[ai][bj][m][0] + bv[bj][0], z1 = acc[ai][bj][m][1] + bv[bj][1];
                    const f32x4 v0 = (f32x4){bf_lo(w.x) * sigm(z0[0]), bf_hi(w.x) * sigm(z0[1]), bf_lo(w.y) * sigm(z0[2]), bf_hi(w.y) * sigm(z0[3])};
                    const f32x4 v1 = (f32x4){bf_lo(w.z) * sigm(z1[0]), bf_hi(w.z) * sigm(z1[1]), bf_lo(w.w) * sigm(z1[2]), bf_hi(w.w) * sigm(z1[3])};
                    ss += sq8(v0, v1); *(u32x4*)lane_ptr(sout + (size_t)rowu * 512 + colu, l_y) = pack8(v0, v1); }
                row_atomic(sq_s + rowu, cx.fr, ss, cx.fq); }
            EP_FENCE;
        }
    }
};
template <bool MIX> struct EpiRes {
    static constexpr bool HAS_MID = MIX, HAS_BEGIN = MIX;
    const float* hin32; float* hout32; bf16_t* hb; float* sq_next; const float* sq_a; const float* sq_s;
    __device__ __forceinline__ void begin(const Unit& u, const Ctx& cx, int ui) const {
        if (cx.tid < 256) { const int row = u.pm * 256 + cx.tid; const float ra = rstd_of(sq_a[row], 1.0f / 512.0f), rsd = rstd_of(sq_s[row], 1.0f / 512.0f);
            ((LAS f32x2*)(cx.lds + XCH_OFF + (ui & 1) * 2048))[cx.tid] = (f32x2){ra / rsd, rsd}; }
    }
    __device__ __forceinline__ void mid(Acc& acc, const Unit&, const Ctx& cx, int ui) const {
        const LAS f32x2* tab = (const LAS f32x2*)(cx.lds + XCH_OFF + (ui & 1) * 2048) + cx.fr;
        EP_FOR_ROWS { const float r = tab[EP_RU].x;
#pragma unroll
            for (int bj = 0; bj < 2; ++bj) { acc[ai][bj][m][0] *= r; acc[ai][bj][m][1] *= r; } }
    }
    __device__ __forceinline__ void operator()(Acc& acc, const Unit& u, const Ctx& cx, int ui) const {
        const LAS f32x2* tab = (const LAS f32x2*)(cx.lds + XCH_OFF + (ui & 1) * 2048) + cx.fr;
        const unsigned l_h = (unsigned)(cx.fr * 1024 + cx.fq * 8) * 4u, l_hb = l_h >> 1;
#pragma unroll
        for (int ai = 0; ai < 2; ++ai) {
            f32x4 pre[4][2][2];
#pragma unroll
            for (int m = 0; m < 4; ++m)
#pragma unroll
                for (int bj = 0; bj < 2; ++bj) { const size_t o = (size_t)(u.pm * 256 + EP_RU) * 1024 + u.pn * 256 + bj * 128 + cx.wc * 32;
                    if (hin32) { const float* hq = lane_ptr(hin32 + o, l_h); pre[m][bj][0] = *(const f32x4*)hq; pre[m][bj][1] = *(const f32x4*)(hq + 4); }
                    else { const u32x4 w = *(const u32x4*)lane_ptr(hb + o, l_hb); pre[m][bj][0] = __builtin_bit_cast(f32x4, w); } }
#pragma unroll
            for (int m = 0; m < 4; ++m) { const int ru = EP_RU, rowu = u.pm * 256 + ru; float sc = 1.0f; if (MIX) sc = tab[ru].y; float ss = 0.f;
#pragma unroll
                for (int bj = 0; bj < 2; ++bj) { const size_t o = (size_t)rowu * 1024 + u.pn * 256 + bj * 128 + cx.wc * 32; f32x4 h0, h1;
                    if (hin32) { h0 = pre[m][bj][0]; h1 = pre[m][bj][1]; }
                    else { const u32x4 w = __builtin_bit_cast(u32x4, pre[m][bj][0]); h0 = (f32x4){bf_lo(w.x), bf_hi(w.x), bf_lo(w.y), bf_hi(w.y)}; h1 = (f32x4){bf_lo(w.z), bf_hi(w.z), bf_lo(w.w), bf_hi(w.w)}; }
                    const f32x4 v0 = h0 + acc[ai][bj][m][0] * sc, v1 = h1 + acc[ai][bj][m][1] * sc;
                    if (hout32) { float* hp = lane_ptr(hout32 + o, l_h); *(f32x4*)hp = v0; *(f32x4*)(hp + 4) = v1; }
                    else *(u32x4*)lane_ptr(hb + o, l_hb) = pack8(v0, v1);
                    ss += sq8(v0, v1); }
                row_atomic(sq_next + rowu, cx.fr, ss, cx.fq); }
            EP_FENCE;
        }
    }
};
struct EpiSoftmax {
    static constexpr bool HAS_MID = false, HAS_BEGIN = false;
    const float* sq_x; bf16_t* pb;
    __device__ __forceinline__ void operator()(Acc& acc, const Unit& u, const Ctx& cx, int) const {
        LAS float* PM = (LAS float*)(cx.lds + XCH_OFF + 4096) + cx.fr * 4; LAS float* PS = (LAS float*)(cx.lds + XCH_OFF + 8192) + cx.fr * 4;
        EP_PRELOAD_RS(rsv, sq_x, 1.0f / 1024.0f)
        EP_FOR_ROWS { const int ru = EP_RU; const float rs = rsv[ai][m]; float mx = -3.0e38f;
#pragma unroll
            for (int bj = 0; bj < 2; ++bj)
#pragma unroll
                for (int n = 0; n < 2; ++n) { f32x4 v = acc[ai][bj][m][n] * rs; acc[ai][bj][m][n] = v; mx = fmaxf(fmaxf(mx, fmaxf(v[0], v[1])), fmaxf(v[2], v[3])); }
            mx = fmaxf(mx, __shfl_xor(mx, 16)); mx = fmaxf(mx, __shfl_xor(mx, 32));
            if (cx.fq == 0) PM[ru * 4 + cx.wc] = mx; EP_FENCE; }
        asm volatile("s_waitcnt lgkmcnt(0)" ::: "memory"); __builtin_amdgcn_s_barrier(); asm volatile("" ::: "memory");
        EP_FOR_ROWS { const int ru = EP_RU; const f32x4 q = *(const LAS f32x4*)(PM + ru * 4); const float mx = fmaxf(fmaxf(q[0], q[1]), fmaxf(q[2], q[3])); float sm = 0.f;
#pragma unroll
            for (int bj = 0; bj < 2; ++bj)
#pragma unroll
                for (int n = 0; n < 2; ++n) { f32x4 v = acc[ai][bj][m][n]; v = (f32x4){__builtin_amdgcn_exp2f(v[0] - mx), __builtin_amdgcn_exp2f(v[1] - mx), __builtin_amdgcn_exp2f(v[2] - mx), __builtin_amdgcn_exp2f(v[3] - mx)};
                    acc[ai][bj][m][n] = v; sm += (v[0] + v[1]) + (v[2] + v[3]); }
            sm += __shfl_xor(sm, 16); sm += __shfl_xor(sm, 32);
            if (cx.fq == 0) PS[ru * 4 + cx.wc] = sm; EP_FENCE; }
        asm volatile("s_waitcnt lgkmcnt(0)" ::: "memory"); __builtin_amdgcn_s_barrier(); asm volatile("" ::: "memory");
        const unsigned l_p = (unsigned)(cx.fr * 1024 + cx.fq * 8) * 2u;
        EP_FOR_ROWS { const int ru = EP_RU, rowu = u.pm * 256 + ru; const f32x4 q = *(const LAS f32x4*)(PS + ru * 4); const float inv = __builtin_amdgcn_rcpf((q[0] + q[1]) + (q[2] + q[3]));
#pragma unroll
            for (int bj = 0; bj < 2; ++bj) *(u32x4*)lane_ptr(pb + (size_t)rowu * 1024 + u.pn * 256 + bj * 128 + cx.wc * 32, l_p) = pack8(acc[ai][bj][m][0] * inv, acc[ai][bj][m][1] * inv);
            EP_FENCE; }
    }
};
struct EpiSwiglu {
    static constexpr bool HAS_MID = false, HAS_BEGIN = false;
    const float* sq_f; bf16_t* hid;
    __device__ __forceinline__ void operator()(Acc& acc, const Unit& u, const Ctx& cx, int) const {
        const unsigned l_h = (unsigned)(cx.fr * FF + cx.fq * 8) * 2u;
        EP_PRELOAD_RS(rsv, sq_f, 1.0f / 1024.0f)
        EP_FOR_ROWS { const int rowu = u.pm * 256 + EP_RU; const float rs = rsv[ai][m]; f32x4 o[2];
#pragma unroll
            for (int n = 0; n < 2; ++n) { const f32x4 g = acc[ai][0][m][n] * rs, up = acc[ai][1][m][n] * rs; o[n] = (f32x4){g[0] * sigm(g[0]) * up[0], g[1] * sigm(g[1]) * up[1], g[2] * sigm(g[2]) * up[2], g[3] * sigm(g[3]) * up[3]}; }
            *(u32x4*)lane_ptr(hid + (size_t)rowu * FF + u.pn * 128 + cx.wc * 32, l_h) = pack8(o[0], o[1]); EP_FENCE; }
    }
};
template <class OutFn> struct EpiStore {
    static constexpr bool HAS_MID = false, HAS_BEGIN = false;
    OutFn of;
    __device__ __forceinline__ void operator()(Acc& acc, const Unit& u, const Ctx& cx, int) const {
        int ld; bf16_t* base = of(u, ld); const unsigned l_o = (unsigned)(cx.fr * ld + cx.fq * 8) * 2u;
        EP_FOR_ROWS { const int ru = EP_RU;
#pragma unroll
            for (int bj = 0; bj < 2; ++bj) *(u32x4*)lane_ptr(base + (size_t)ru * ld + bj * 128 + cx.wc * 32, l_o) = pack8(acc[ai][bj][m][0], acc[ai][bj][m][1]);
            EP_FENCE; }
    }
};
}
namespace att {
constexpr int KSLOT = 12288, VSLOT = 8192, NSLOT = 3;
constexpr int L_K = 0, L_V = NSLOT * KSLOT, L_WS = L_V + NSLOT * VSLOT, L_OST = L_WS + 8 * 256, L_END = L_OST + 8 * 4096;
static_assert(L_END <= RING_BYTES, "attention LDS");
__device__ __forceinline__ int crow(int r, int hi) { return (r & 3) + 8 * (r >> 2) + 4 * hi; }
#define SBAR() __builtin_amdgcn_sched_barrier(0)
__device__ __forceinline__ void cmask(f32x16& p0, f32x16& p1, int jb, int qrel, int hi) {
    const float NEG = -INFINITY; const int kb = 64 * jb + 4 * hi;
#pragma unroll
    for (int r = 0; r < 16; ++r) { const int kv = kb + (r & 3) + 8 * (r >> 2); if (kv > qrel) p0[r] = NEG; if (kv + 32 > qrel) p1[r] = NEG; }
}
__device__ __forceinline__ void glds16(const void* gsrc, unsigned lds_dst) { unsigned keep;
    asm volatile("s_mov_b32 %0, m0\n\ts_mov_b32 m0, %2\n\ts_nop 0\n\tglobal_load_lds_dwordx4 %1, off\n\ts_mov_b32 m0, %0" : "=&s"(keep) : "v"(gsrc), "s"(lds_dst) : "memory"); }
__device__ __forceinline__ float max3f(float a, float b, float c) { float r; asm("v_max3_f32 %0, %1, %2, %3" : "=v"(r) : "v"(a), "v"(b), "v"(c)); return r; }
__device__ __forceinline__ float max2f(float a, float b) { float r; asm("v_max_f32_e32 %0, %1, %2" : "=v"(r) : "v"(a), "v"(b)); return r; }
__device__ __forceinline__ float fadd_s(float a, float b) { float r; asm("v_add_f32_e32 %0, %1, %2" : "=v"(r) : "v"(a), "v"(b)); return r; }
__device__ __forceinline__ float fsub_s(float a, float b) { float r; asm("v_sub_f32_e32 %0, %1, %2" : "=v"(r) : "v"(a), "v"(b)); return r; }
#define WAIT_BAR(N) asm volatile("s_waitcnt vmcnt(" #N ") lgkmcnt(0)\n\ts_barrier" ::: "memory")
typedef LAS const char* lds_cptr;
typedef short v4i16_t __attribute__((ext_vector_type(4)));
__device__ __forceinline__ void qkt(f32x16& p0, f32x16& p1, lds_cptr kb, const bf16x8* qr) { const f32x16 negm = f32x16{};
#pragma unroll
    for (int d0 = 0; d0 < 6; ++d0) { const bf16x8 b0 = *(const LAS bf16x8*)(kb + d0 * 2048), b1 = *(const LAS bf16x8*)(kb + d0 * 2048 + 512);
        if (d0 == 0) { p0 = __builtin_amdgcn_mfma_f32_32x32x16_bf16(b0, qr[0], negm, 0, 0, 0); p1 = __builtin_amdgcn_mfma_f32_32x32x16_bf16(b1, qr[0], negm, 0, 0, 0); }
        else { p0 = __builtin_amdgcn_mfma_f32_32x32x16_bf16(b0, qr[d0], p0, 0, 0, 0); p1 = __builtin_amdgcn_mfma_f32_32x32x16_bf16(b1, qr[d0], p1, 0, 0, 0); } }
}
__device__ __forceinline__ void kload2(bf16x8* kf, lds_cptr kp, int j) { kf[2 * j] = *(const LAS bf16x8*)(kp + j * 2048); kf[2 * j + 1] = *(const LAS bf16x8*)(kp + j * 2048 + 512); }
__device__ __forceinline__ s16x4 vtr(lds_cptr p) { return __builtin_bit_cast(s16x4, __builtin_amdgcn_ds_read_tr16_b64_v4i16((LAS v4i16_t*)p)); }
__device__ __forceinline__ float rowmax(const f32x16& p0, const f32x16& p1) {
    float a = max3f(p0[0], p0[1], p1[0]), b = max3f(p0[2], p0[3], p1[1]); a = max3f(a, p1[2], p1[3]);
#pragma unroll
    for (int r = 4; r < 16; r += 4) { a = max3f(a, p0[r], p0[r + 1]); b = max3f(b, p0[r + 2], p0[r + 3]); a = max3f(a, p1[r], p1[r + 1]); b = max3f(b, p1[r + 2], p1[r + 3]); }
    const float m = max2f(a, b);
    auto rr = __builtin_amdgcn_permlane32_swap(__float_as_uint(m), __float_as_uint(m), false, false);
    return max2f(__uint_as_float(rr[0]), __uint_as_float(rr[1]));
}
__device__ __forceinline__ void pv(f32x16* o, int vb, bf16x8 pa0, bf16x8 pa1, bf16x8 pa2, bf16x8 pa3) {
#pragma unroll
    for (int d0 = 0; d0 < 2; ++d0) { s16x4 lo[4], hi[4];
#pragma unroll
        for (int ks = 0; ks < 4; ++ks) {
            asm volatile("ds_read_b64_tr_b16 %0,%1 offset:%c2" : "=&v"(lo[ks]) : "v"(vb), "i"(d0 * 4096 + ks * 1024) : "memory");
            asm volatile("ds_read_b64_tr_b16 %0,%1 offset:%c2" : "=&v"(hi[ks]) : "v"(vb), "i"(d0 * 4096 + ks * 1024 + 512) : "memory"); }
        asm volatile("s_waitcnt lgkmcnt(0)" ::: "memory"); SBAR();
#define PK(k) (bf16x8){lo[k][0], lo[k][1], lo[k][2], lo[k][3], hi[k][0], hi[k][1], hi[k][2], hi[k][3]}
        o[d0] = __builtin_amdgcn_mfma_f32_32x32x16_bf16(pa0, PK(0), o[d0], 0, 0, 0);
        o[d0] = __builtin_amdgcn_mfma_f32_32x32x16_bf16(pa1, PK(1), o[d0], 0, 0, 0);
        o[d0] = __builtin_amdgcn_mfma_f32_32x32x16_bf16(pa2, PK(2), o[d0], 0, 0, 0);
        o[d0] = __builtin_amdgcn_mfma_f32_32x32x16_bf16(pa3, PK(3), o[d0], 0, 0, 0);
#undef PK
    }
}
template <int THRL>
__device__ __forceinline__ void attn_unit(int b, int h, int qb, const bf16_t* Q, const unsigned char* Kg, const unsigned char* Vg, bf16_t* AO, float* sq_a, LAS unsigned char* lds) {
    int tid_ = threadIdx.x; asm volatile("" : "+v"(tid_));
    const int tid = tid_, lane = tid & 63, r32 = lane & 31, hi = lane >> 5; const int wid = __builtin_amdgcn_readfirstlane(tid >> 6);
    const int q0 = qb * 256; const size_t rowbase = (size_t)b * S;
    const bf16_t* Qw = Q + (rowbase + q0 + wid * 32) * 768;
    const unsigned lds0 = (unsigned)(uintptr_t)lds;
    LAS float* wsf = (LAS float*)(lds + L_WS) + wid * 64;
    const unsigned char* ksrc = Kg + (size_t)(b * 8 + h) * 64 * KSLOT + wid * 1536 + lane * 16; const unsigned char* vsrc = Vg + (size_t)(b * 8 + h) * 64 * VSLOT + wid * 1024 + lane * 16;
    const unsigned kdst = lds0 + L_K + wid * 1536, vdst = lds0 + L_V + wid * 1024;
#define DMA_K(t, sl) do { glds16(ksrc + (size_t)(t) * KSLOT, (unsigned)__builtin_amdgcn_readfirstlane(kdst + (sl) * KSLOT)); \
        if (lane < 32) glds16(ksrc + (size_t)(t) * KSLOT + 1024, (unsigned)__builtin_amdgcn_readfirstlane(kdst + (sl) * KSLOT + 1024)); } while (0)
#define DMA_V(t, sl) glds16(vsrc + (size_t)(t) * VSLOT, (unsigned)__builtin_amdgcn_readfirstlane(vdst + (sl) * VSLOT))
    const int vb0 = (int)(lds0 + L_V) + ((lane >> 4) & 1) * 32 + (lane & 3) * 8 + (4 * hi + ((lane & 15) >> 2)) * 64;
    bf16x8 kf[12];
    const lds_cptr kp0 = (lds_cptr)lds + L_K + hi * 1024 + r32 * 16; const lds_cptr vp0 = (lds_cptr)lds + L_V + ((lane >> 4) & 1) * 32 + (lane & 3) * 8 + (4 * hi + ((lane & 15) >> 2)) * 64;
    const int NT = 4 * (qb + 1);
    DMA_K(0, 0); DMA_V(0, 0); DMA_K(1, 1);
    bf16x8 qr[6];
#pragma unroll
    for (int d0 = 0; d0 < 6; ++d0) qr[d0] = *reinterpret_cast<const bf16x8*>(&Qw[(size_t)r32 * 768 + (d0 < 4 ? h * 64 + d0 * 16 : 512 + h * 32 + (d0 - 4) * 16) + hi * 8]);
    float mhat = 0.f, l_reg = 0.f; f32x16 o[2]; o[0] = f32x16{}; o[1] = f32x16{};
    const int qrel = wid * 32 + r32;
#define CMASK(P0, P1, t) do { int jb_ = (t) - (NT - 4); if (jb_ >= 0) cmask(P0, P1, jb_, qrel, hi); } while (0)
    bool resc = false;
#define START(P0, P1) do { const float rm = rowmax(P0, P1); resc = false; \
    mhat = rm; \
    _Pragma("unroll") for (int r = 0; r < 16; ++r) P0[r] = __builtin_amdgcn_exp2f(P0[r] - mhat); } while (0)
#define RESC() do { if (resc) { asm volatile("s_waitcnt lgkmcnt(0)" ::: "memory"); \
      _Pragma("unroll") for (int d_ = 0; d_ < 2; ++d_) _Pragma("unroll") for (int r = 0; r < 16; ++r) o[d_][r] *= wsf[crow(r, hi)]; } } while (0)
    f32x16 pA0, pA1, pB0, pB1;
    int sp = 0, sc = 0, sn = 1;
#define ROT() do { sp = sc; sc = sn; sn = (sn == NSLOT - 1) ? 0 : sn + 1; } while (0)
    DMA_K(2, 2);
    WAIT_BAR(5);
    qkt(pA0, pA1, kp0, qr); asm volatile("s_nop 15\n\ts_nop 7" : "+v"(pA0), "+v"(pA1)); CMASK(pA0, pA1, 0);
    START(pA0, pA1);
#pragma unroll
    for (int r = 0; r < 16; ++r) pA1[r] = __builtin_amdgcn_exp2f(pA1[r] - mhat);
    WAIT_BAR(0);
    DMA_K(3, 0); DMA_V(1, 1);
    ROT();
#pragma unroll
    for (int j = 0; j < 6; ++j) kload2(kf, kp0 + sc * KSLOT, j);
    WAIT_BAR(3);
    s16x4 vlo[8], vhi[8]; u32x4 pw0, pw1, pw2, pw3;
#define PKW(P, B) cvt_pk_bf16(P[B], P[B + 1])
#define PAF(k) __builtin_bit_cast(bf16x8, pw##k)
#define VFR(i) (bf16x8){vlo[i][0], vlo[i][1], vlo[i][2], vlo[i][3], vhi[i][0], vhi[i][1], vhi[i][2], vhi[i][3]}
#define PIN(x) asm volatile("" : "+v"(x))
#define MX3(a, b, c) __builtin_fmaxf(__builtin_fmaxf((a), (b)), (c))
#define GAPA(MF, A0, A1, A2, A3, W0, W1, PW) do { MF; sacc += A0; sacc += A1; sacc += A2; sacc += A3; PIN(sacc); W0; W1; PIN(PW); SBAR(); } while (0)
#define GAPM(MF) do { MF; SBAR(); } while (0)
#define EX(v) __builtin_amdgcn_exp2f(v)
#define GAPB(MF, X, B) do { MF; X[B] = EX(X[B] - mhat); X[B + 1] = EX(X[B + 1] - mhat); X[B + 2] = EX(X[B + 2] - mhat); X[B + 3] = EX(X[B + 3] - mhat); PIN(X); SBAR(); } while (0)
#define VRD(i) do { vlo[i] = vtr(vp_ + (((i) >> 2) * 4096 + ((i) & 3) * 1024)); vhi[i] = vtr(vp_ + (((i) >> 2) * 4096 + ((i) & 3) * 1024 + 512)); } while (0)
#define KRD(G, j) do { if (G) { kload2(kf, kp0 + sn * KSLOT, j); SBAR(); } } while (0)
#define MF32(A, B, C) __builtin_amdgcn_mfma_f32_32x32x16_bf16(A, B, C, 0, 0, 0)
#define STEP(C0, C1, P0, P1, t, GK, GV, GL) do { SBAR(); const f32x16 zero16 = f32x16{}; \
    const lds_cptr vp_ = vp0 + sp * VSLOT; \
    VRD(0); SBAR(); float sacc = (P0[0] + P0[1]); \
    GAPA(C0 = MF32(kf[0], qr[0], zero16), P0[2], P0[3], P0[4], P0[5],     pw0[0] = PKW(P0, 0), pw0[1] = PKW(P0, 2), pw0); \
    VRD(4); SBAR(); GAPA(C1 = MF32(kf[1], qr[0], zero16), P0[6], P0[7], P0[8], P0[9],     pw0[2] = PKW(P0, 4), pw0[3] = PKW(P0, 6), pw0); \
    VRD(1); SBAR(); GAPA(C0 = MF32(kf[2], qr[1], C0),   P0[10], P0[11], P0[12], P0[13], pw1[0] = PKW(P0, 8), pw1[1] = PKW(P0, 10), pw1); \
    VRD(5); SBAR(); GAPA(C1 = MF32(kf[3], qr[1], C1),   P0[14], P0[15], P1[0], P1[1],   pw1[2] = PKW(P0, 12), pw1[3] = PKW(P0, 14), pw1); \
    VRD(2); SBAR(); GAPA(C0 = MF32(kf[4], qr[2], C0),   P1[2], P1[3], P1[4], P1[5],     pw2[0] = PKW(P1, 0), pw2[1] = PKW(P1, 2), pw2); \
    VRD(6); SBAR(); GAPA(C1 = MF32(kf[5], qr[2], C1),   P1[6], P1[7], P1[8], P1[9],     pw2[2] = PKW(P1, 4), pw2[3] = PKW(P1, 6), pw2); \
    VRD(3); SBAR(); GAPA(C0 = MF32(kf[6], qr[3], C0),   P1[10], P1[11], P1[12], P1[13], pw3[0] = PKW(P1, 8), pw3[1] = PKW(P1, 10), pw3); \
    VRD(7); SBAR(); GAPA(C1 = MF32(kf[7], qr[3], C1),   P1[14], P1[15], 0.f, 0.f,       pw3[2] = PKW(P1, 12), pw3[3] = PKW(P1, 14), pw3); \
    GAPM(C0 = MF32(kf[8], qr[4], C0)); GAPM(C1 = MF32(kf[9], qr[4], C1)); GAPM(C0 = MF32(kf[10], qr[5], C0)); GAPM(C1 = MF32(kf[11], qr[5], C1)); \
    l_reg += sacc; \
    if (GK) { DMA_K((t) + 3, sc); } if (GV) { DMA_V((t) + 1, sn); } \
    CMASK(C0, C1, t); \
    { float a = MX3(C0[0], C0[1], C1[0]), b = MX3(C0[2], C0[3], C1[1]); a = MX3(a, C1[2], C1[3]); \
      _Pragma("unroll") for (int r = 4; r < 16; r += 4) { a = MX3(a, C0[r], C0[r + 1]); b = MX3(b, C0[r + 2], C0[r + 3]); a = MX3(a, C1[r], C1[r + 1]); b = MX3(b, C1[r + 2], C1[r + 3]); } \
      float rm = __builtin_fmaxf(a, b); { auto rr = __builtin_amdgcn_permlane32_swap(__float_as_uint(rm), __float_as_uint(rm), false, false); rm = __builtin_fmaxf(__uint_as_float(rr[0]), __uint_as_float(rr[1])); } \
      resc = false; \
      rm -= mhat; \
      if (__builtin_expect(__any(rm > (float)THRL), 0)) { const float dl = __builtin_fmaxf(rm, 0.f); mhat += dl; \
        const float f = __builtin_amdgcn_exp2f(-dl); l_reg *= f; if (hi == 0) wsf[r32] = f; resc = true; } } \
    SBAR(); \
    GAPB(o[0] = MF32(PAF(0), VFR(0), o[0]), C0, 0); \
    KRD(GL, 0); GAPB(o[1] = MF32(PAF(0), VFR(4), o[1]), C0, 4); \
    KRD(GL, 1); GAPB(o[0] = MF32(PAF(1), VFR(1), o[0]), C0, 8); \
    KRD(GL, 2); GAPB(o[1] = MF32(PAF(1), VFR(5), o[1]), C0, 12); \
    KRD(GL, 3); GAPB(o[0] = MF32(PAF(2), VFR(2), o[0]), C1, 0); \
    KRD(GL, 4); GAPB(o[1] = MF32(PAF(2), VFR(6), o[1]), C1, 4); \
    KRD(GL, 5); GAPB(o[0] = MF32(PAF(3), VFR(3), o[0]), C1, 8); \
    GAPB(o[1] = MF32(PAF(3), VFR(7), o[1]), C1, 12); \
    } while (0)
    int t = 1;
#undef CMASK
#define CMASK(P0, P1, t) do {} while (0)
    for (; t + 5 < NT; t += 2) {
        STEP(pB0, pB1, pA0, pA1, t, true, true, true);     WAIT_BAR(3); RESC(); ROT();
        STEP(pA0, pA1, pB0, pB1, t + 1, true, true, true); WAIT_BAR(3); RESC(); ROT();
    }
#undef CMASK
#define CMASK(P0, P1, t) do { int jb_ = (t) - (NT - 4); if (jb_ >= 0) cmask(P0, P1, jb_, qrel, hi); } while (0)
#define ENDW(tt) do { if ((tt) + 3 < NT) { WAIT_BAR(3); } else if ((tt) + 2 < NT) { WAIT_BAR(1); } else { WAIT_BAR(0); } } while (0)
    for (; t + 1 < NT; t += 2) {
        STEP(pB0, pB1, pA0, pA1, t, (t + 3 < NT), (t + 1 < NT), (t + 1 < NT));     ENDW(t);     RESC(); ROT();
        STEP(pA0, pA1, pB0, pB1, t + 1, (t + 4 < NT), (t + 2 < NT), (t + 2 < NT)); ENDW(t + 1); RESC(); ROT();
    }
    STEP(pB0, pB1, pA0, pA1, NT - 1, false, false, false); RESC();
    { float sacc = pB0[0] + pB0[1];
#pragma unroll
      for (int r = 2; r < 16; ++r) sacc += pB0[r];
#pragma unroll
      for (int r = 0; r < 16; ++r) sacc += pB1[r];
      l_reg += sacc;
      pw0 = (u32x4){PKW(pB0, 0), PKW(pB0, 2), PKW(pB0, 4), PKW(pB0, 6)}; pw1 = (u32x4){PKW(pB0, 8), PKW(pB0, 10), PKW(pB0, 12), PKW(pB0, 14)};
      pw2 = (u32x4){PKW(pB1, 0), PKW(pB1, 2), PKW(pB1, 4), PKW(pB1, 6)}; pw3 = (u32x4){PKW(pB1, 8), PKW(pB1, 10), PKW(pB1, 12), PKW(pB1, 14)};
      SBAR(); pv(o, vb0 + sc * VSLOT, PAF(0), PAF(1), PAF(2), PAF(3)); }
#undef PKW
#undef PAF
#undef VFR
#undef PIN
#undef MX3
#undef GAPA
#undef GAPM
#undef GAPB
#undef EX
#undef VRD
#undef KRD
#undef MF32
#undef STEP
#undef ENDW
#undef DMA_K
#undef DMA_V
#undef CMASK
#undef START
#undef RESC
#undef ROT
    { auto rr = __builtin_amdgcn_permlane32_swap(__float_as_uint(l_reg), __float_as_uint(l_reg), false, false); l_reg = __uint_as_float(rr[0]) + __uint_as_float(rr[1]); }
    if (hi == 0) wsf[32 + r32] = l_reg;
    asm volatile("s_waitcnt lgkmcnt(0)" ::: "memory");
    LAS bf16_t* stg = (LAS bf16_t*)(lds + L_OST) + wid * 2048;
#pragma unroll
    for (int r = 0; r < 16; ++r) { const int orow = crow(r, hi); const float rl = __builtin_amdgcn_rcpf(wsf[32 + orow]);
#pragma unroll
        for (int d0 = 0; d0 < 2; ++d0) stg[orow * 64 + d0 * 32 + r32] = (bf16_t)(cvt_pk_bf16(o[d0][r] * rl, 0.f) & 0xffffu); }
    asm volatile("s_waitcnt lgkmcnt(0)" ::: "memory");
    bf16_t* Ow = AO + (rowbase + q0 + wid * 32) * 512 + h * 64;
#pragma unroll
    for (int i = 0; i < 4; ++i) { const int row = i * 8 + (lane >> 3), ch = lane & 7; const u32x4 v = *(const LAS u32x4*)(stg + row * 64 + ch * 8); *(u32x4*)(Ow + (size_t)row * 512 + ch * 8) = v;
        float ss = (bf_lo(v.x) * bf_lo(v.x) + bf_hi(v.x) * bf_hi(v.x)) + (bf_lo(v.y) * bf_lo(v.y) + bf_hi(v.y) * bf_hi(v.y)) + (bf_lo(v.z) * bf_lo(v.z) + bf_hi(v.z) * bf_hi(v.z)) + (bf_lo(v.w) * bf_lo(v.w) + bf_hi(v.w) * bf_hi(v.w));
        ss += __shfl_xor(ss, 1); ss += __shfl_xor(ss, 2); ss += __shfl_xor(ss, 4);
        if (ch == 0) unsafeAtomicAdd(sq_a + rowbase + q0 + wid * 32 + row, ss); }
    asm volatile("s_waitcnt lgkmcnt(0)\n\ts_barrier" ::: "memory");
}
#undef SBAR
#undef WAIT_BAR
__device__ __forceinline__ void attn_phase(int vcu, int G, const bf16_t* Q, const unsigned char* Kg, const unsigned char* Vg, bf16_t* AO, float* sq_a, LAS unsigned char* lds) {
    for (int v = vcu; v < 256; v += G) { const int bh = v >> 2, s = v & 3;
#pragma unroll 1
        for (int i = 0; i < 4; ++i) { const int qb = (i == 0) ? s : (i == 1) ? 7 - s : (i == 2) ? 8 + s : 15 - s; attn_unit<8>(bh >> 3, bh & 7, qb, Q, Kg, Vg, AO, sq_a, lds); } }
}
}

__device__ __forceinline__ void ssm_scan_phase(int vcu, int G, const float* xloc, const float* aL  , bf16_t* assm, LAS unsigned char* lds) {
    int tid_ = threadIdx.x; asm volatile("" : "+v"(tid_));
    const int p = tid_ & 63, wave = __builtin_amdgcn_readfirstlane(tid_ >> 6);
    LAS float* ends = (LAS float*)lds;
    for (int v = vcu; v < 256; v += G) { const int b = v >> 5, g = v & 31; const float ar = aL[(g * 64 + p) * 2], ai = aL[(g * 64 + p) * 2 + 1];
        const int c0 = wave * 16;
        const float* xl = xloc + ((size_t)g * NCH + b * NCHB + c0) * 128; bf16_t* as = assm + ((size_t)g * NCH + b * NCHB + c0) * KS3 + KS1;
        float lr[16], li[16];
#pragma unroll
        for (int k = 0; k < 16; ++k) { lr[k] = xl[(size_t)k * 128 + p]; li[k] = xl[(size_t)k * 128 + 64 + p]; }
        float xr = 0.f, xi = 0.f, pr_[16], pi_[16];
#pragma unroll
        for (int k = 0; k < 16; ++k) { pr_[k] = xr; pi_[k] = xi; const float nr = ar * xr - ai * xi + lr[k], ni = ar * xi + ai * xr + li[k]; xr = nr; xi = ni; }
        ends[(wave * 64 + p) * 2] = xr; ends[(wave * 64 + p) * 2 + 1] = xi;
        float a16r = ar, a16i = ai;
#pragma unroll
        for (int q = 0; q < 4; ++q) { const float nr = a16r * a16r - a16i * a16i, ni = 2.f * a16r * a16i; a16r = nr; a16i = ni; }
        __syncthreads();
        float sr = 0.f, si = 0.f;
        for (int w = 0; w < wave; ++w) { const float er = ends[(w * 64 + p) * 2], ei = ends[(w * 64 + p) * 2 + 1]; const float nr = a16r * sr - a16i * si + er, ni = a16r * si + a16i * sr + ei; sr = nr; si = ni; }
        float wr_ = sr, wi_ = si;
#pragma unroll
        for (int k = 0; k < 16; ++k) { const float orr = pr_[k] + wr_, oii = pi_[k] + wi_;
            as[(size_t)k * KS3 + p] = (bf16_t)(cvt_pk_bf16(orr, 0.f) & 0xffffu); as[(size_t)k * KS3 + 64 + p] = (bf16_t)(cvt_pk_bf16(oii, 0.f) & 0xffffu);
            const float nr = ar * wr_ - ai * wi_, ni = ar * wi_ + ai * wr_; wr_ = nr; wi_ = ni; }
        __syncthreads();
    }
}
__device__ __forceinline__ void sincos_d(double a, double& s, double& c) {
    const double k = rint(a * 0.63661977236758134308);
    double y = fma(-k, 1.57079632679489655800e+00, a); y = fma(-k, 6.12323399573676603587e-17, y);
    const double y2 = y * y;
    double sp = -1.0 / 1307674368000.0; sp = fma(sp, y2, 1.0 / 6227020800.0); sp = fma(sp, y2, -1.0 / 39916800.0); sp = fma(sp, y2, 1.0 / 362880.0);
    sp = fma(sp, y2, -1.0 / 5040.0); sp = fma(sp, y2, 1.0 / 120.0); sp = fma(sp, y2, -1.0 / 6.0); sp = fma(sp * y2, y, y);
    double cp = 1.0 / 20922789888000.0; cp = fma(cp, y2, -1.0 / 87178291200.0); cp = fma(cp, y2, 1.0 / 479001600.0); cp = fma(cp, y2, -1.0 / 3628800.0);
    cp = fma(cp, y2, 1.0 / 40320.0); cp = fma(cp, y2, -1.0 / 720.0); cp = fma(cp, y2, 1.0 / 24.0); cp = fma(cp, y2, -0.5); cp = fma(cp, y2, 1.0);
    const int q = (int)((long long)k & 3);
    if (q == 0) { s = sp; c = cp; } else if (q == 1) { s = cp; c = -sp; } else if (q == 2) { s = -sp; c = -cp; } else { s = -cp; c = sp; }
}
__device__ __forceinline__ float wave_sum(float v) {
#pragma unroll
    for (int o = 1; o < 64; o <<= 1) v += __shfl_xor(v, o);
    return v;
}
template <class ColFn, class GainFn>
__device__ __forceinline__ void conv_T(int gw, int NGW, int& base, int lane, LAS float* scr, int Ksrc, int ldw, int Ndst, bf16_t* dst, int ldd, ColFn colp, GainFn gain, float scale) {
    const int nblk = Ndst / 32, nitems = nblk * (Ksrc / 64);
    int first = gw - (base % NGW); if (first < 0) first += NGW;
    base += nitems;
    for (int it = first; it < nitems; it += NGW) { const int kb = it / nblk, nb = it % nblk, k0 = 64 * kb, n0 = 32 * nb;
        const float* cp = colp(n0 + (lane & 31)); float v[32];
        if (cp) { const float* q = cp + (size_t)(k0 + (lane >> 5)) * ldw;
#pragma unroll
            for (int i = 0; i < 32; ++i) v[i] = q[(size_t)(2 * i) * ldw]; }
        else {
#pragma unroll
            for (int i = 0; i < 32; ++i) v[i] = 0.f; }
#pragma unroll
        for (int i = 0; i < 32; ++i) scr[(2 * i + (lane >> 5)) * 33 + (lane & 31)] = v[i];
        asm volatile("s_waitcnt lgkmcnt(0)" ::: "memory");
        const int c = lane & 7; float gk[8];
#pragma unroll
        for (int e = 0; e < 8; ++e) gk[e] = gain(k0 + 8 * c + e) * scale;
#pragma unroll
        for (int j = 0; j < 4; ++j) { const int n = (lane >> 3) + 8 * j; const LAS float* sp = scr + (8 * c) * 33 + n;
            u32x4 o; o.x = cvt_pk_bf16(sp[0 * 33] * gk[0], sp[1 * 33] * gk[1]); o.y = cvt_pk_bf16(sp[2 * 33] * gk[2], sp[3 * 33] * gk[3]); o.z = cvt_pk_bf16(sp[4 * 33] * gk[4], sp[5 * 33] * gk[5]); o.w = cvt_pk_bf16(sp[6 * 33] * gk[6], sp[7 * 33] * gk[7]);
            *(u32x4*)(dst + (size_t)(n0 + n) * ldd + k0 + 8 * c) = o; }
        asm volatile("s_waitcnt lgkmcnt(0)" ::: "memory");
    }
}
struct In {
    const float *x, *mem; const int* pos; const float *norm_mix_g, *w_in, *q_norm_g, *w_uq, *kv_norm_g, *w_ukv, *lam_re, *lam_im, *log_dt, *b_re, *b_im, *c_re, *c_im, *ssm_d, *w_glu, *b_glu,
        *attn_out_g, *ssm_out_g, *w_out, *norm_x_g, *mem_norm_g, *w_xq, *w_xkv, *w_xo, *norm_ffn_g, *w_gate, *w_up, *w_down, *final_g;
};
struct Freqs { double f[16]; };

__device__ __forceinline__ void ssm_mats(const In& in, int l, int g, int q, unsigned char* ws, LAS unsigned char* lds) {
    const int tid = threadIdx.x;
    LAS float* bbr = (LAS float*)lds; LAS float* bbi = bbr + 1024; LAS float* apr = bbi + 1024; LAS float* api = apr + 34 * 64; LAS float* cr = api + 34 * 64; LAS float* ci = cr + 1024;
    LAS float* ktabT = ci + 1024  ; LAS float* aprT = ktabT + 2048  ; LAS float* apiT = aprT + 64 * 35; LAS float* dvs = apiT + 64 * 35;
    const int lg = l * 32 + g;
    if (tid < 128) { const int p = tid & 63; const double lr = in.lam_re[lg * 64 + p], li = in.lam_im[lg * 64 + p], dt = exp((double)in.log_dt[lg]);
        double sn, cn; sincos_d(fabs(li * dt), sn, cn); if (li * dt < 0) sn = -sn;
        const double er = exp(lr * dt), ar = er * cn, ai = er * sn;
        if (tid < 64) {
            double pr = 1.0, pi = 0.0;
            for (int j = 0; j < 34; ++j) { apr[j * 64 + p] = (float)pr; api[j * 64 + p] = (float)pi; aprT[p * 35 + j] = (float)pr; apiT[p * 35 + j] = (float)pi;
                if (j == LC && q == 0) { float* al = (float*)(ws + WS_AL) + (size_t)(lg * 64 + p) * 2; al[0] = (float)pr; al[1] = (float)pi; }
                const double nr = pr * ar - pi * ai, ni = pr * ai + pi * ar; pr = nr; pi = ni; }
        } else {
            const double den = lr * lr + li * li, cfr = ((ar - 1.0) * lr + ai * li) / den, cfi = (ai * lr - (ar - 1.0) * li) / den; const float fr_ = (float)cfr, fi_ = (float)cfi;
            float bre[16], bim[16];
#pragma unroll
            for (int c = 0; c < 16; ++c) { bre[c] = in.b_re[(size_t)(lg * 64 + p) * 16 + c]; bim[c] = in.b_im[(size_t)(lg * 64 + p) * 16 + c]; }
#pragma unroll
            for (int c = 0; c < 16; ++c) { bbr[p * 16 + c] = fr_ * bre[c] - fi_ * bim[c]; bbi[p * 16 + c] = fr_ * bim[c] + fi_ * bre[c]; }
        }
    } else if (tid < 192) { const int p = tid - 128;
#pragma unroll
        for (int c = 0; c < 16; ++c) { cr[c * 64 + p] = in.c_re[(size_t)(lg * 16 + c) * 64 + p]; ci[c * 64 + p] = in.c_im[(size_t)(lg * 16 + c) * 64 + p]; }
    } else if (tid < 208) dvs[tid - 192] = in.ssm_d[l * 512 + g * 16 + (tid - 192)];
    __syncthreads();
    {
      const int j = tid >> 4, c4 = (tid >> 2) & 3, c = 4 * q + c4, c2b = (tid & 3) * 4; f32x4 sum = (f32x4){0.f, 0.f, 0.f, 0.f};
#pragma unroll 4
      for (int p = 0; p < 64; ++p) { const float yr = apr[j * 64 + p], yi = api[j * 64 + p], xr = cr[c * 64 + p], xi = ci[c * 64 + p]; const float car = xr * yr - xi * yi, cai = xr * yi + xi * yr;
          sum += car * *(const LAS f32x4*)(bbr + p * 16 + c2b) - cai * *(const LAS f32x4*)(bbi + p * 16 + c2b); }
#pragma unroll
      for (int y = 0; y < 4; ++y) ktabT[(c4 * 16 + c2b + y) * 32 + j] = sum[y]; }
    __syncthreads();
    bf16_t* bt1 = (bf16_t*)(ws + WS_SSM + (size_t)lg * SSM_G_STRIDE); bf16_t* bt3 = (bf16_t*)(ws + WS_SSM + (size_t)lg * SSM_G_STRIDE + SSM_BT3_OFF);
    for (int idx = tid; idx < 128 * 80; idx += 512) { const int rq = idx / 80, k0 = (idx % 80) * 8, s = rq >> 2, c4 = rq & 3, c = 4 * q + c4, n = s * 16 + c; float v[8];
        if (k0 < KS1) { const int s2 = k0 >> 4, c0 = k0 & 15; const float dvc = (s2 == s) ? dvs[c] : 0.f; const LAS float* kt = ktabT + (c4 * 16 + c0) * 32 + (s2 <= s ? s - s2 : 0);
#pragma unroll
            for (int e = 0; e < 8; ++e) { float t = kt[e * 32]; if (s2 > s) t = 0.f; if (c0 + e == c) t += dvc; v[e] = t; }
        } else { const int pq = k0 - KS1, p0 = pq & 63; const bool im = (pq >> 6) != 0;
            const LAS float* xrp = cr + c * 64 + p0; const LAS float* xip = ci + c * 64 + p0; const LAS float* yrp = apr + (s + 1) * 64 + p0; const LAS float* yip = api + (s + 1) * 64 + p0;
#pragma unroll
            for (int hh = 0; hh < 2; ++hh) { const f32x4 xr = *(const LAS f32x4*)(xrp + 4 * hh), xi = *(const LAS f32x4*)(xip + 4 * hh), yr = *(const LAS f32x4*)(yrp + 4 * hh), yi = *(const LAS f32x4*)(yip + 4 * hh);
                const f32x4 re = xr * yr - xi * yi, mi = -(xr * yi + xi * yr);
#pragma unroll
                for (int e = 0; e < 4; ++e) v[4 * hh + e] = im ? mi[e] : re[e]; }
        }
        u32x4 o; o.x = cvt_pk_bf16(v[0], v[1]); o.y = cvt_pk_bf16(v[2], v[3]); o.z = cvt_pk_bf16(v[4], v[5]); o.w = cvt_pk_bf16(v[6], v[7]);
        *(u32x4*)(bt3 + (size_t)n * KS3 + k0) = o; }
    for (int idx = tid; idx < 64 * 64; idx += 512) { const int rq = idx >> 6, k0 = (idx & 63) * 8, s2 = k0 >> 4, c0 = k0 & 15; float v[8];
        const bool real_row = rq < 32; const int p = 16 * q + (rq & 15); const bool im = (rq >> 4) & 1; const int n = real_row ? (im ? 64 + p : p) : 128 + 32 * q + (rq - 32);
        if (real_row) { const float yr = aprT[p * 35 + (LC - 1 - s2)], yi = apiT[p * 35 + (LC - 1 - s2)];
#pragma unroll
            for (int hh = 0; hh < 2; ++hh) { const f32x4 br = *(const LAS f32x4*)(bbr + p * 16 + c0 + 4 * hh), bi = *(const LAS f32x4*)(bbi + p * 16 + c0 + 4 * hh);
                const f32x4 re = br * yr - bi * yi, mi = bi * yr + br * yi;
#pragma unroll
                for (int e = 0; e < 4; ++e) v[4 * hh + e] = im ? mi[e] : re[e]; }
        } else {
#pragma unroll
            for (int e = 0; e < 8; ++e) v[e] = 0.f; }
        u32x4 o; o.x = cvt_pk_bf16(v[0], v[1]); o.y = cvt_pk_bf16(v[2], v[3]); o.z = cvt_pk_bf16(v[4], v[5]); o.w = cvt_pk_bf16(v[6], v[7]);
        *(u32x4*)(bt1 + (size_t)n * KS1 + k0) = o; }
    __syncthreads();
}

__device__ __forceinline__ void prologue(const In& in, const Freqs& fr, unsigned char* ws, LAS unsigned char* lds, int vcu, int G, int parts) {
    const int tid = threadIdx.x, lane = tid & 63, wave = __builtin_amdgcn_readfirstlane(tid >> 6);
    __syncthreads();
    if (parts & 1) for (int j = vcu; j < 256; j += G) ssm_mats(in, j >> 7, (j >> 2) & 31, j & 3, ws, lds);
    LAS float* scr = (LAS float*)(lds + wave * 16384);
    const int gw = vcu * 8 + wave, NGW = G * 8;
    if (parts & 2) {
    { bf16_t* hb = (bf16_t*)(ws + WS_HB); float* sq0 = (float*)(ws + WS_CTL) + CW_SQ + (size_t)SQ_MIX * T;
      for (int r = gw * 2; r < T; r += NGW * 2) { const f32x4* xr = (const f32x4*)(in.x + (size_t)r * D) + lane; u32x2* hrow = (u32x2*)(hb + (size_t)r * D) + lane; f32x4 v[8];
#pragma unroll
          for (int j = 0; j < 8; ++j) v[j] = xr[64 * j];
          float s0 = 0.f, s1 = 0.f;
#pragma unroll
          for (int j = 0; j < 4; ++j) { s0 += (v[j][0] * v[j][0] + v[j][1] * v[j][1]) + (v[j][2] * v[j][2] + v[j][3] * v[j][3]); s1 += (v[j + 4][0] * v[j + 4][0] + v[j + 4][1] * v[j + 4][1]) + (v[j + 4][2] * v[j + 4][2] + v[j + 4][3] * v[j + 4][3]); }
#pragma unroll
          for (int j = 0; j < 8; ++j) hrow[64 * j] = (u32x2){cvt_pk_bf16(v[j][0], v[j][1]), cvt_pk_bf16(v[j][2], v[j][3])};
          s0 = wave_sum(s0); s1 = wave_sum(s1); if (lane == 0) { sq0[r] = s0; sq0[r + 1] = s1; } } }
    { bf16_t* mn = (bf16_t*)(ws + WS_RA + RA_MEMN);
      for (int r = gw; r < NB * MEMT; r += NGW) { const f32x4* xr = (const f32x4*)(in.mem + (size_t)r * D) + lane; u32x2* mrow = (u32x2*)(mn + (size_t)r * D) + lane; f32x4 v[4]; float s = 0.f;
#pragma unroll
          for (int j = 0; j < 4; ++j) { v[j] = xr[64 * j]; s += (v[j][0] * v[j][0] + v[j][1] * v[j][1]) + (v[j][2] * v[j][2] + v[j][3] * v[j][3]); }
          const float rs = rstd_of(wave_sum(s), 1.0f / 1024.0f);
#pragma unroll
          for (int j = 0; j < 4; ++j) mrow[64 * j] = (u32x2){cvt_pk_bf16(v[j][0] * rs, v[j][1] * rs), cvt_pk_bf16(v[j][2] * rs, v[j][3] * rs)}; } }
    { float* cs = (float*)(ws + WS_CS);
      for (int i = vcu * 512 + tid; i < T * 16; i += G * 512) { const int t = i >> 4, j = i & 15; double s, c; sincos_d((double)in.pos[t] * fr.f[j], s, c); cs[(size_t)t * 32 + j] = (float)c; cs[(size_t)t * 32 + 16 + j] = (float)s; } }
    }
    if (!(parts & 4)) return;
    int cbase = 0;
    for (int l = 0; l < NL; ++l) {
        unsigned char* wl = ws + WS_W + (size_t)l * WL_STRIDE;
        { const float* W = in.w_in + (size_t)l * D * 928; const float* gn = in.norm_mix_g + l * D;
          conv_T(gw, NGW, cbase, lane, scr, D, 928, 1024, (bf16_t*)(wl + WL_IN), 1024,
                 [=](int n) -> const float* { if (n < 384) return W + n; if (n < 416) { const int i = n - 384; return W + ((i & 1) ? 400 + (i >> 1) : 384 + (i >> 1)); } if (n < 512) return nullptr; return W + 416 + (n - 512); },
                 [=](int k) { return gn[k]; }, 1.0f); }
        { const float* W = in.w_uq + (size_t)l * 256 * 768; const float* gn = in.q_norm_g + l * 256;
          conv_T(gw, NGW, cbase, lane, scr, 256, 768, 768, (bf16_t*)(wl + WL_UP), 256,
                 [=](int n) -> const float* { if (n < 512) return W + (n >> 6) * 96 + (n & 63); const int h = (n - 512) >> 5, i = (n - 512) & 31; return W + h * 96 + ((i & 1) ? 80 + (i >> 1) : 64 + (i >> 1)); },
                 [=](int k) { return gn[k]; }, 0.10206207261596575f * LOG2E); }
        { const float* W = in.w_ukv + (size_t)l * 128 * 1024; const float* gn = in.kv_norm_g + l * 128; bf16_t* dst = (bf16_t*)(wl + WL_UP) + (size_t)768 * 256;
          conv_T(gw, NGW, cbase, lane, scr, 128, 1024, 1024, dst, 256, [=](int n) -> const float* { return W + n; }, [=](int k) { return gn[k]; }, 1.0f);
          for (int i = vcu * 512 + tid; i < 1024 * 16; i += G * 512) *(u32x4*)(dst + (size_t)(i >> 4) * 256 + 128 + (i & 15) * 8) = (u32x4){0u, 0u, 0u, 0u}; }
        { const float* W = in.w_glu + (size_t)l * 512 * 512;
          conv_T(gw, NGW, cbase, lane, scr, 512, 512, 512, (bf16_t*)(wl + WL_GLU), 512, [=](int n) -> const float* { return W + n; }, [=](int) { return 1.0f; }, 1.0f); }
        { const float* W = in.w_out + (size_t)l * D * D; const float* ga = in.attn_out_g + l * 512; const float* gs = in.ssm_out_g + l * 512;
          conv_T(gw, NGW, cbase, lane, scr, D, D, D, (bf16_t*)(wl + WL_OUT), D, [=](int n) -> const float* { return W + n; }, [=](int k) { return k < 512 ? ga[k] : gs[k - 512]; }, 1.0f); }
        { const float* W = in.w_xkv + (size_t)l * D * 2048; const float* gn = in.mem_norm_g + l * D;
          conv_T(gw, NGW, cbase, lane, scr, D, 2048, 2048, (bf16_t*)(ws + WS_WXKV) + (size_t)l * 2048 * D, D, [=](int n) -> const float* { return W + n; }, [=](int k) { return gn[k]; }, 1.0f); }
        { const float* W = in.w_xo + (size_t)l * D * D;
          conv_T(gw, NGW, cbase, lane, scr, D, D, D, (bf16_t*)(ws + WS_WXO) + (size_t)l * D * D, D, [=](int n) -> const float* { return W + n; }, [=](int) { return 1.0f; }, 1.0f); }
        { const float* Wg = in.w_gate + (size_t)l * D * FF; const float* Wu = in.w_up + (size_t)l * D * FF; const float* gn = in.norm_ffn_g + l * D;
          conv_T(gw, NGW, cbase, lane, scr, D, FF, 2 * FF, (bf16_t*)(wl + WL_GU), D,
                 [=](int n) -> const float* { const int tl = n >> 8, r = n & 255; return r < 128 ? Wg + tl * 128 + r : Wu + tl * 128 + (r - 128); }, [=](int k) { return gn[k]; }, 1.0f); }
        { const float* W = in.w_down + (size_t)l * FF * D;
          conv_T(gw, NGW, cbase, lane, scr, FF, D, D, (bf16_t*)(wl + WL_DN), FF, [=](int n) -> const float* { return W + n; }, [=](int) { return 1.0f; }, 1.0f); }
        { const float* W = in.w_xq + (size_t)l * D * D; const float* gn = in.norm_x_g + l * D; bf16_t* dst = (bf16_t*)(wl + WL_XQ);
          for (int i = vcu * 512 + tid; i < D * D / 8; i += G * 512) { const int k = i >> 7; const float sc = gn[k] * (0.0625f * LOG2E); const f32x4 a = *(const f32x4*)(W + (size_t)i * 8) * sc, b = *(const f32x4*)(W + (size_t)i * 8 + 4) * sc;
              *(u32x4*)(dst + (size_t)i * 8) = ep::pack8(a, b); } }
    }
}
struct Args { In in; float* out; unsigned char* ws; Freqs fr; int ph_hi; int pad; };

template <class F> struct PanelFn { F f; __device__ __forceinline__ void operator()(const pg8::Unit& u, const char*& a, const char*& b) const { f(u, a, b); } };
template <class F> __device__ __forceinline__ PanelFn<F> make_panel(F f) { return PanelFn<F>{f}; }
template <class F> struct OutFnT { F f; __device__ __forceinline__ bf16_t* operator()(const pg8::Unit& u, int& ld) const { return f(u, ld); } };
template <class F> __device__ __forceinline__ ep::EpiStore<OutFnT<F>> make_store(F f) { return ep::EpiStore<OutFnT<F>>{OutFnT<F>{f}}; }

__global__ void __launch_bounds__(512, 2) mk_fwd(Args a) {
    extern __shared__ __attribute__((aligned(16))) unsigned char lds_raw[];
    LAS unsigned char* lds = (LAS unsigned char*)lds_raw;
    const int tid = threadIdx.x, lane = tid & 63, wave = __builtin_amdgcn_readfirstlane(tid >> 6);
    const int G = gridDim.x, bx = blockIdx.x, vcu = (G % 8 == 0) ? (bx % 8) * (G / 8) + bx / 8 : bx;
    unsigned char* ws = a.ws; float* out = a.out;
    unsigned* ctl = (unsigned*)(ws + WS_CTL);
    for (int u = tid; u < (LDS_BYTES - LDSCTL_OFF) / 4; u += 512) ((LAS unsigned*)(lds + LDSCTL_OFF))[u] = 0u;
    __syncthreads();
    XcdBarrier bar = xcd_barrier_post(ctl + CW_BAR, (volatile LAS unsigned*)(lds + LDSCTL_OFF));
    int ph = 0;
#ifndef MK_MASK
#define MK_MASK 0xffff
#endif
#ifdef MK_TSET
    unsigned long long t_prev = __builtin_amdgcn_s_memrealtime(), t_acc = 0ull; int id_prev = -1;
#define T_STAMP(id) { const unsigned long long t_now = __builtin_amdgcn_s_memrealtime(); if (id_prev >= 0 && ((MK_TSET >> id_prev) & 1)) t_acc += t_now - t_prev; t_prev = t_now; id_prev = (id); }
#ifdef MK_TBAR
#define GRID_BAR { const unsigned long long tb0 = __builtin_amdgcn_s_memrealtime(); xcd_barrier(bar); t_acc += __builtin_amdgcn_s_memrealtime() - tb0; }
#else
#define GRID_BAR xcd_barrier(bar)
#endif
#else
#define T_STAMP(id)
#ifdef MK_DBLBAR
#define GRID_BAR { xcd_barrier(bar); xcd_barrier(bar); }
#else
#define GRID_BAR xcd_barrier(bar)
#endif
#endif
#define PHASE_BEGIN(id) if (ph++ >= a.ph_hi) return; T_STAMP(id) if ((MK_MASK >> (id)) & 1)
    float* sqb = (float*)ctl + CW_SQ;
#define SQ(l, id) (sqb + (size_t)((l) * SQ_PER_LAYER + (id)) * T)
    bf16_t* hb = (bf16_t*)(ws + WS_HB); bf16_t* assm = (bf16_t*)(ws + WS_ASSM); const float* cs = (const float*)(ws + WS_CS);
    unsigned char* ra = ws + WS_RA;
    pg8::StaticOrder SO;
#ifdef MK_CLKPROBE
    unsigned clk_mhz = 0;
#endif
    const long NEVER = 1 << 30;

#ifndef MK_REP_PRO
#define MK_REP_PRO 1
#define MK_REP_PARTS 7
#define MK_REP_ATTN 1
#define MK_REP_P9 1
#endif
    PHASE_BEGIN(0) { for (int rep = 0; rep < MK_REP_PRO; ++rep) prologue(a.in, a.fr, ws, lds, vcu, G, rep ? MK_REP_PARTS : 7); } GRID_BAR;
    PHASE_BEGIN(1) {
        const char* A0 = (const char*)(ra + RA_MEMN); const char* B0 = (const char*)(ws + WS_WXKV); bf16_t* kvm = (bf16_t*)(ra + RA_KVM);
        SO.init(8, 16, G, bx);
        auto PN = make_panel([=](const pg8::Unit& u, const char*& pa, const char*& pb) { pa = A0 + (size_t)u.pm * 256 * 1024 * 2; pb = B0 + (size_t)u.pn * 256 * 1024 * 2; });
        auto E = make_store([=](const pg8::Unit& u, int& ld) -> bf16_t* { ld = 2048; return kvm + ((size_t)(u.pn >> 3) * 2048 + u.pm * 256) * 2048 + (u.pn & 7) * 256; });
        pg8::gemm_phase(lds, pg8::GemmArgs{1024, 1024, 1024, (int)NEVER, 0}, SO, PN, E);
    } GRID_BAR;
    PHASE_BEGIN(2) {
        const char* kvm = (const char*)(ra + RA_KVM); bf16_t* wkvw = (bf16_t*)(ws + WS_WKVW);
        { SO.init(64, 4, G, bx);
          const char* wx = (const char*)(ws + WS_W + WL_XQ);
          auto PN = make_panel([=](const pg8::Unit& u, const char*& pa, const char*& pb) { const int l = u.pm >> 5, b = (u.pm >> 2) & 7, h = u.pm & 3;
              pa = kvm + (((size_t)l * 2048 + b * 256) * 2048 + h * 256) * 2; pb = wx + (size_t)l * WL_STRIDE + ((size_t)u.pn * 256 * 1024 + h * 256) * 2; });
          auto E = make_store([=](const pg8::Unit& u, int& ld) -> bf16_t* { const int l = u.pm >> 5, b = (u.pm >> 2) & 7, h = u.pm & 3; ld = 1024;
              return wkvw + ((size_t)(l * 16 + b) << 20) + (size_t)(h * 256) * 1024 + u.pn * 256; });
          pg8::gemm_phase(lds, pg8::GemmArgs{256, 2048, 1024, (int)NEVER, 0}, SO, PN, E); }
        { SO.init(256, 1, G, bx);
          const char* wo = (const char*)(ws + WS_WXO);
          auto PN = make_panel([=](const pg8::Unit& u, const char*& pa, const char*& pb) { const int rt = u.pm & 3, h = (u.pm >> 2) & 3, b = (u.pm >> 4) & 7, l = u.pm >> 7;
              pa = wo + (((size_t)l * 1024 + rt * 256) * 1024 + h * 256) * 2; pb = kvm + (((size_t)l * 2048 + b * 256) * 2048 + 1024 + h * 256) * 2; });
          auto E = make_store([=](const pg8::Unit& u, int& ld) -> bf16_t* { const int rt = u.pm & 3, h = (u.pm >> 2) & 3, b = (u.pm >> 4) & 7, l = u.pm >> 7; ld = 1024;
              return wkvw + ((size_t)(l * 16 + 8 + b) << 20) + (size_t)(rt * 256) * 1024 + h * 256; });
          pg8::gemm_phase(lds, pg8::GemmArgs{256, 1024, 2048, (int)NEVER, 0}, SO, PN, E); }
    } GRID_BAR;

    for (int l = 0; l < NL; ++l) {
        const char* wl = (const char*)(ws + WS_W + (size_t)l * WL_STRIDE);
        PHASE_BEGIN(3) {
            SO.init(128, 4, G, bx);
            auto PN = make_panel([=](const pg8::Unit& u, const char*& pa, const char*& pb) { pa = (const char*)hb + (size_t)u.pm * 256 * 1024 * 2; pb = wl + WL_IN + (size_t)u.pn * 256 * 1024 * 2; });
            ep::EpiProj E{SQ(l, SQ_MIX), SQ(l, SQ_CQ), SQ(l, SQ_CKV), (bf16_t*)(ra + RA_PROJB), assm, ra + RA_K, cs};
            pg8::gemm_phase(lds, pg8::GemmArgs{1024, 1024, 1024, (int)NEVER, 0}, SO, PN, E);
        } GRID_BAR;
        PHASE_BEGIN(4) {
            const char* pj = (const char*)(ra + RA_PROJB);
            { SO.init(128, 7, G, bx);
              auto PN = make_panel([=](const pg8::Unit& u, const char*& pa, const char*& pb) { pa = pj + (size_t)u.pm * 256 * 512 * 2 + (u.pn >= 3 ? 512 : 0); pb = wl + WL_UP + (size_t)u.pn * 256 * 256 * 2; });
              ep::EpiUp E{ep::EpiQ{SQ(l, SQ_CQ), (bf16_t*)(ra + RA_Q), cs}, ep::EpiKV{SQ(l, SQ_CKV), ra + RA_K, ra + RA_V}};
              pg8::gemm_phase(lds, pg8::GemmArgs{256, 512, 256, (int)NEVER, 0}, SO, PN, E); }
            { SO.init(128, 1, G, (bx + G / 2) % G);
              const char* bt = (const char*)(ws + WS_SSM) + (size_t)l * 32 * SSM_G_STRIDE;
              auto PN = make_panel([=](const pg8::Unit& u, const char*& pa, const char*& pb) { pa = (const char*)assm + (size_t)u.pm * 256 * KS3 * 2; pb = bt + (size_t)(u.pm >> 2) * SSM_G_STRIDE; });
              ep::EpiXloc E{(float*)(ra + RA_XLOC)};
              pg8::gemm_phase(lds, pg8::GemmArgs{KS1, KS3, KS1, (int)NEVER, 0}, SO, PN, E); }
        } GRID_BAR;
        PHASE_BEGIN(5) {
            ssm_scan_phase(vcu, G, (const float*)(ra + RA_XLOC), (const float*)(ws + WS_AL) + (size_t)l * 32 * 64 * 2, assm, lds);
            for (int rep = 0; rep < MK_REP_ATTN; ++rep) att::attn_phase(vcu, G, (const bf16_t*)(ra + RA_Q), ra + RA_K, ra + RA_V, (bf16_t*)(ra + RA_AO), rep ? SQ(2, 1) : SQ(l, SQ_A), lds);
        } GRID_BAR;
        PHASE_BEGIN(6) {
            SO.init(128, 2, G, bx);
            const char* bt = (const char*)(ws + WS_SSM) + (size_t)l * 32 * SSM_G_STRIDE + SSM_BT3_OFF;
            auto PN = make_panel([=](const pg8::Unit& u, const char*& pa, const char*& pb) { pa = (const char*)assm + (size_t)u.pm * 256 * KS3 * 2; pb = bt + (size_t)(u.pm >> 2) * SSM_G_STRIDE + (size_t)u.pn * 256 * KS3 * 2; });
            ep::EpiY E{(bf16_t*)(ra + RA_Y), (bf16_t*)(ra + RA_G)};
            pg8::gemm_phase(lds, pg8::GemmArgs{KS3, KS3, KS3, (int)NEVER, 0}, SO, PN, E);
        } GRID_BAR;
        PHASE_BEGIN(7) {
            SO.init(128, 2, G, bx);
            const char* gb = (const char*)(ra + RA_G);
            auto PN = make_panel([=](const pg8::Unit& u, const char*& pa, const char*& pb) { pa = gb + (size_t)u.pm * 256 * 512 * 2; pb = wl + WL_GLU + (size_t)u.pn * 256 * 512 * 2; });
            ep::EpiGlu E{(const bf16_t*)(ra + RA_Y), a.in.b_glu + l * 512, (bf16_t*)(ra + RA_SOUT), SQ(l, SQ_S)};
            pg8::gemm_phase(lds, pg8::GemmArgs{512, 512, 512, (int)NEVER, 0}, SO, PN, E);
        } GRID_BAR;
        PHASE_BEGIN(8) {
            SO.init(128, 4, G, bx);
            const char* ao = (const char*)(ra + RA_AO);
            auto PN = make_panel([=](const pg8::Unit& u, const char*& pa, const char*& pb) { pa = ao + (size_t)u.pm * 256 * 512 * 2; pb = wl + WL_OUT + (size_t)u.pn * 256 * 1024 * 2; });
            ep::EpiRes<true> E{l == 0 ? a.in.x : nullptr, nullptr, hb, SQ(l, SQ_X), SQ(l, SQ_A), SQ(l, SQ_S)};
            pg8::gemm_phase(lds, pg8::GemmArgs{1024, 512, 1024, 8, (long)(RA_SOUT - RA_AO) - 8 * 128}, SO, PN, E);
        } GRID_BAR;
        PHASE_BEGIN(9) {
            SO.init(128, 4, G, bx);
            const char* wk = (const char*)(ws + WS_WKVW) + ((size_t)(l * 16) << 21);
            auto PN = make_panel([=](const pg8::Unit& u, const char*& pa, const char*& pb) { pa = (const char*)hb + (size_t)u.pm * 256 * 1024 * 2; pb = wk + ((size_t)(u.pm >> 4) << 21) + (size_t)u.pn * 256 * 1024 * 2; });
            ep::EpiSoftmax E{SQ(l, SQ_X), (bf16_t*)(ra + RA_P)};
            pg8::gemm_phase(lds, pg8::GemmArgs{1024, 1024, 1024, (int)NEVER, 0}, SO, PN, E);
        } GRID_BAR;
        PHASE_BEGIN(10) {
            SO.init(128, 4, G, bx);
            const char* vw = (const char*)(ws + WS_WKVW) + ((size_t)(l * 16 + 8) << 21); const char* pp = (const char*)(ra + RA_P);
            auto PN = make_panel([=](const pg8::Unit& u, const char*& pa, const char*& pb) { pa = pp + (size_t)u.pm * 256 * 1024 * 2; pb = vw + ((size_t)(u.pm >> 4) << 21) + (size_t)u.pn * 256 * 1024 * 2; });
            ep::EpiRes<false> E{nullptr, nullptr, hb, SQ(l, SQ_FFN), nullptr, nullptr};
            pg8::gemm_phase(lds, pg8::GemmArgs{1024, 1024, 1024, (int)NEVER, 0}, SO, PN, E);
        } GRID_BAR;
#ifdef MK_CLKPROBE
        unsigned long long ck0 = __builtin_amdgcn_s_memtime(), rk0 = __builtin_amdgcn_s_memrealtime();
#endif
        PHASE_BEGIN(11) {
            SO.init(128, 22, G, bx);
            auto PN = make_panel([=](const pg8::Unit& u, const char*& pa, const char*& pb) { pa = (const char*)hb + (size_t)u.pm * 256 * 1024 * 2; pb = wl + WL_GU + (size_t)u.pn * 256 * 1024 * 2; });
            ep::EpiSwiglu E{SQ(l, SQ_FFN), (bf16_t*)(ra + RA_HID)};
            for (int rep = 0; rep < MK_REP_P9; ++rep) pg8::gemm_phase(lds, pg8::GemmArgs{1024, 1024, 1024, (int)NEVER, 0}, SO, PN, E);
        } GRID_BAR;
#ifdef MK_CLKPROBE
        if (l == 0) { const unsigned long long ck1 = __builtin_amdgcn_s_memtime(), rk1 = __builtin_amdgcn_s_memrealtime(); clk_mhz = (unsigned)(((ck1 - ck0) * 100ull) / (rk1 - rk0)); }
#endif
        PHASE_BEGIN(12) {
            SO.init(128, 4, G, bx);
            const char* hd = (const char*)(ra + RA_HID);
            auto PN = make_panel([=](const pg8::Unit& u, const char*& pa, const char*& pb) { pa = hd + (size_t)u.pm * 256 * FF * 2; pb = wl + WL_DN + (size_t)u.pn * 256 * FF * 2; });
            ep::EpiRes<false> E{nullptr, l == NL - 1 ? out : nullptr, hb, SQ(l + 1, SQ_MIX), nullptr, nullptr};
            pg8::gemm_phase(lds, pg8::GemmArgs{FF, FF, FF, (int)NEVER, 0}, SO, PN, E);
        } GRID_BAR;
    }
    PHASE_BEGIN(13) {
        const float* sqf = SQ(NL, SQ_MIX); const float* gf = a.in.final_g;
        const f32x4* gr = (const f32x4*)gf + lane; f32x4 gv[4];
#pragma unroll
        for (int j = 0; j < 4; ++j) gv[j] = gr[64 * j];
        for (int r = (vcu * 8 + wave) * 4; r < T; r += G * 8 * 4) { f32x4* orow = (f32x4*)(out + (size_t)r * D) + lane; f32x4 v[16]; float rs[4];
#pragma unroll
            for (int q = 0; q < 4; ++q) rs[q] = sqf[r + q];
#pragma unroll
            for (int j = 0; j < 16; ++j) v[j] = orow[64 * j];
#pragma unroll
            for (int j = 0; j < 16; ++j) orow[64 * j] = v[j] * rstd_of(rs[j >> 2], 1.0f / 1024.0f) * gv[j & 3]; }
    }
#ifdef MK_CLKPROBE
    if (blockIdx.x == 0) { const unsigned long long t_end = __builtin_amdgcn_s_memrealtime(); while (__builtin_amdgcn_s_memrealtime() - t_end < (unsigned long long)clk_mhz * 50ull) __builtin_amdgcn_s_sleep(8); }
#endif
#ifdef MK_TSET
    T_STAMP(14)
    if (blockIdx.x == 0) { const unsigned long long t_end = __builtin_amdgcn_s_memrealtime(); while (__builtin_amdgcn_s_memrealtime() - t_end < t_acc) __builtin_amdgcn_s_sleep(8); }
#endif
#undef PHASE_BEGIN
#undef GRID_BAR
#undef SQ
}

extern "C" void kernel_launch(void* const* d_in, const int* in_sizes, int n_in, void* d_out, int out_size, void* d_ws, size_t ws_size, hipStream_t stream) {
    static int grid = 0;
    if (grid == 0) {
        if (n_in != 32 || out_size != T * D || ws_size < WS_END) { fprintf(stderr, "kernel_launch: unexpected shapes (n_in %d out %d ws %zu)\n", n_in, out_size, ws_size); grid = -1; return; }
        int dev = 0, cus = 0, per_cu = 0;
        if (hipGetDevice(&dev) != hipSuccess || hipDeviceGetAttribute(&cus, hipDeviceAttributeMultiprocessorCount, dev) != hipSuccess) { grid = -1; return; }
        if (hipFuncSetAttribute((const void*)mk_fwd, hipFuncAttributeMaxDynamicSharedMemorySize, LDS_BYTES) != hipSuccess) { fprintf(stderr, "kernel_launch: hipFuncSetAttribute failed\n"); grid = -1; return; }
        if (hipOccupancyMaxActiveBlocksPerMultiprocessor(&per_cu, (const void*)mk_fwd, 512, LDS_BYTES) != hipSuccess || per_cu < 1) { fprintf(stderr, "kernel_launch: occupancy query says %d\n", per_cu); per_cu = 1; }
        (void)hipGetLastError();
        grid = cus;
    }
    if (grid < 0) return;
    if (hipMemsetAsync((char*)d_ws + WS_CTL, 0, CTL_ZERO_BYTES, stream) != hipSuccess) return;
    Args a{};
    const void** ip = (const void**)&a.in;
    for (int i = 0; i < 32; ++i) ip[i] = d_in[i];
    a.out = (float*)d_out; a.ws = (unsigned char*)d_ws;
    for (int i = 0; i < 16; ++i) a.fr.f[i] = std::pow(10000.0, -(double)i / 16.0);
#ifndef MK_PH_HI
#define MK_PH_HI 1000
#endif
    a.ph_hi = MK_PH_HI; a.pad = 0;
    void* args[] = {&a};
    hipError_t e = hipLaunchCooperativeKernel((const void*)mk_fwd, dim3(grid), dim3(512), args, LDS_BYTES, stream);
    if (e != hipSuccess) fprintf(stderr, "kernel_launch: cooperative launch failed: %s (grid %d)\n", hipGetErrorString(e), grid);
}
```

```cpp
#include <hip/hip_runtime.h>
#include <hip/hip_bf16.h>
#include <cstdint>
#include <cstdio>
#include <cmath>

#define LAS __attribute__((address_space(3)))
typedef unsigned short bf16_t;
typedef short bf16x8 __attribute__((ext_vector_type(8)));
typedef short s16x4 __attribute__((ext_vector_type(4)));
typedef float f32x4 __attribute__((ext_vector_type(4)));
typedef float f32x2 __attribute__((ext_vector_type(2)));
typedef float f32x16 __attribute__((ext_vector_type(16)));
typedef unsigned u32x4 __attribute__((ext_vector_type(4)));
typedef unsigned u32x2 __attribute__((ext_vector_type(2)));

constexpr int D = 1024, NB = 8, S = 4096, T = NB * S, NL = 2, FF = 2816;
constexpr int NH = 8, QKD = 96, HD = 64;
constexpr int LC = 32, KS1 = 16 * LC  , KS3 = KS1 + 128  , NCHB = S / LC  , NCH = T / LC  ;
constexpr int MEMT = 256;
constexpr float EPS = 1e-6f;
constexpr float LOG2E = 1.4426950408889634f;

constexpr size_t MiB = 1u << 20;
constexpr size_t WS_CTL = 0, CTL_ZERO_BYTES = 4 * MiB;
constexpr size_t WS_CS = 4 * MiB;
constexpr size_t WS_W = 8 * MiB;
constexpr size_t WL_IN = 0, WL_UP = 2 * MiB, WL_GLU = 3 * MiB, WL_OUT = 3 * MiB + 512 * 1024, WL_XQ = 5 * MiB + 512 * 1024, WL_GU = 7 * MiB + 512 * 1024, WL_DN = 18 * MiB + 512 * 1024, WL_STRIDE = 24 * MiB + 512 * 1024;
constexpr size_t WS_WXKV = WS_W + 2 * WL_STRIDE;
constexpr size_t WS_WXO = WS_WXKV + 8 * MiB;
constexpr size_t WS_SSM = 70 * MiB;
constexpr size_t SSM_G_STRIDE = 896 * 1024, SSM_BT3_OFF = 256 * 1024;
constexpr size_t WS_AL = 126 * MiB;
constexpr size_t WS_WKVW = 128 * MiB;
constexpr size_t WS_HB = 192 * MiB;
constexpr size_t WS_ASSM = 256 * MiB;
constexpr size_t WS_RA = 296 * MiB;
constexpr size_t WS_END = WS_RA + 176 * MiB;
constexpr size_t RA_PROJB = 0, RA_AO = 0, RA_Q = 32 * MiB, RA_K = 80 * MiB, RA_V = 128 * MiB, RA_XLOC = 160 * MiB;
constexpr size_t RA_Y = 32 * MiB, RA_G = 64 * MiB, RA_SOUT = 96 * MiB;
constexpr size_t RA_P = 0, RA_HID = 0, RA_MEMN = 0, RA_KVM = 4 * MiB;
constexpr int CW_BAR = 4096;
constexpr int CW_SQ = 65536;
enum SqId { SQ_MIX = 0, SQ_CQ = 1, SQ_CKV = 2, SQ_A = 3, SQ_S = 4, SQ_X = 5, SQ_FFN = 6, SQ_PER_LAYER = 7 };
static_assert((size_t)(CW_SQ + 16 * T) * 4 <= CTL_ZERO_BYTES, "ctl");

constexpr int RING_BYTES = 131072, XCH_OFF = RING_BYTES  , LDSCTL_OFF = XCH_OFF + 12288, LDS_BYTES = 147456;

__device__ __forceinline__ unsigned cvt_pk_bf16(float lo, float hi) { typedef __bf16 bf2 __attribute__((ext_vector_type(2))); f32x2 v = {lo, hi}; bf2 b = __builtin_convertvector(v, bf2); return __builtin_bit_cast(unsigned, b); }
__device__ __forceinline__ float bf_lo(unsigned w) { return __uint_as_float(w << 16); }
__device__ __forceinline__ float bf_hi(unsigned w) { return __uint_as_float(w & 0xffff0000u); }
__device__ __forceinline__ float rstd_of(float sq, float inv_n) { return rsqrtf(sq * inv_n + EPS); }

#define XB_TMO      128
#define XB_XCNT(j)  (256  + 64 * (j))
#define XB_XSUB(j)  (1280 + 64 * (j))
#define XB_XGEN(j)  (2304 + 64 * (j))
#define XB_TOP      3328
#define XB_TOPGEN   3392
#define XCD_BAR_WORDS 3456
#define XB_SPIN_CAP (1u << 20)
__device__ __forceinline__ unsigned xb_ld(unsigned* p)              { return __hip_atomic_load(p, __ATOMIC_RELAXED, __HIP_MEMORY_SCOPE_AGENT); }
__device__ __forceinline__ unsigned xb_add(unsigned* p, unsigned v) { return __hip_atomic_fetch_add(p, v, __ATOMIC_RELAXED, __HIP_MEMORY_SCOPE_AGENT); }
__device__ __forceinline__ unsigned xb_xcc_id() { return (unsigned)__builtin_amdgcn_s_getreg((3 << 11) | 20) & 0xFu; }
#define XB_SPIN(cond, bar) do { unsigned _sp = 0; while (cond) { __builtin_amdgcn_s_sleep(1); \
    if ((++_sp & 255u) == 0u) { if (xb_ld(&(bar)[XB_TMO])) break; if (_sp > XB_SPIN_CAP) { atomicAdd(&(bar)[XB_TMO], 1u); break; } } } } while (0)
struct XcdBarrier { unsigned* bar; unsigned x; volatile LAS unsigned* st; };
__device__ __forceinline__ XcdBarrier xcd_barrier_post(unsigned* bar, volatile LAS unsigned* st) {
    XcdBarrier b; b.bar = bar; b.x = xb_xcc_id(); b.st = st;
    if (threadIdx.x == 0) (void)xb_add(&bar[XB_XCNT(b.x)], 1u);
    return b;
}
__device__ __forceinline__ void xcd_barrier_complete(unsigned* bar, unsigned x, unsigned& nloc, unsigned& nx) {
    const unsigned G = gridDim.x * gridDim.y * gridDim.z;
    unsigned sum, cnt, mine, sp = 0u;
    for (;;) {
        sum = 0u; cnt = 0u; mine = 0u;
#pragma unroll
        for (unsigned j = 0; j < 16; ++j) { const unsigned c = xb_ld(&bar[XB_XCNT(j)]); sum += c; cnt += (c > 0u) ? 1u : 0u; mine = (j == x) ? c : mine; }
        if (sum == G) break;
        __builtin_amdgcn_s_sleep(1);
        if ((++sp & 255u) == 0u) { if (xb_ld(&bar[XB_TMO])) break; if (sp > XB_SPIN_CAP) { atomicAdd(&bar[XB_TMO], 1u); break; } }
    }
    nloc = mine > 0u ? mine : 1u; nx = cnt > 0u ? cnt : 1u;
}
__device__ __forceinline__ void xcd_barrier(const XcdBarrier& b) {
    asm volatile("s_waitcnt vmcnt(0)" ::: "memory");
    __syncthreads();
    if (threadIdx.x == 0) {
        unsigned* bar = b.bar; asm volatile("" : "+s"(bar));
        __builtin_amdgcn_s_waitcnt(0);
        unsigned nloc = b.st[0], nx = b.st[1];
        if (nloc == 0u) { xcd_barrier_complete(bar, b.x, nloc, nx); b.st[0] = nloc; b.st[1] = nx; }
        const unsigned old = xb_add(&bar[XB_XSUB(b.x)], 1u);
        const unsigned gen = old / nloc;
        if (old + 1u == (gen + 1u) * nloc) {
            __builtin_amdgcn_fence(__ATOMIC_RELEASE, "agent");
            asm volatile("s_waitcnt vmcnt(0)" ::: "memory");
            const unsigned og = xb_add(&bar[XB_TOP], 1u);
            const unsigned tg = og / nx;
            if (og + 1u == (tg + 1u) * nx) xb_add(&bar[XB_TOPGEN], 1u);
            else XB_SPIN(xb_ld(&bar[XB_TOPGEN]) == tg, bar);
            __builtin_amdgcn_fence(__ATOMIC_ACQUIRE, "agent");
            xb_add(&bar[XB_XGEN(b.x)], 1u);
            asm volatile("s_waitcnt vmcnt(0)" ::: "memory");
        } else {
            XB_SPIN(xb_ld(&bar[XB_XGEN(b.x)]) == gen, bar);
            __builtin_amdgcn_fence(__ATOMIC_ACQUIRE, "agent");
            asm volatile("s_waitcnt vmcnt(0)" ::: "memory");
        }
    }
    __syncthreads();
}

namespace pg8 {
constexpr int BM = 256, BK = 64, HALF = 128, HTB = HALF * BK * 2, STAGE_BYTES = 8 * HTB, NXCD = 8, WGM = 4;
__host__ __device__ __forceinline__ int lds_byte(int r, int c) { const int st = (r >> 4) * 2 + (c >> 5), rr = r & 15, cc = c & 31, ob = rr * 64 + cc * 2; return st * 1024 + (ob ^ (((ob >> 9) & 1) << 5)); }
__host__ __device__ __forceinline__ void stage_rc(int b, int& R, int& C) { const int st = b / 1024, sb = b % 1024, swz = sb ^ (((sb >> 9) & 1) << 5); R = (st >> 1) * 16 + swz / 64; C = (st & 1) * 32 + (swz % 64) / 2; }
__host__ __device__ __forceinline__ int perm32(int rho) { const int n = rho >> 4, i = rho & 15; return 8 * (i >> 2) + 4 * n + (i & 3); }
struct Unit { int pm, pn; };
struct StaticOrder {
    int nM, nN, nwg, G, c;
    __device__ void init(int nM_, int nN_, int G_, int c_) { nM = nM_; nN = nN_; nwg = nM * nN; G = G_; c = c_; }
    __device__ bool next(int i, Unit& u) const {
        const long L = (long)i * G + c; if (L >= nwg) return false;
        int wgid = (int)L; { const int q = nwg / NXCD, r = nwg % NXCD, xcd = wgid % NXCD, off = wgid / NXCD; wgid = (xcd < r ? xcd * (q + 1) : r * (q + 1) + (xcd - r) * q) + off; }
        const int nig = WGM * nN, gid = wgid / nig, fm = gid * WGM, gsz = (nM - fm) < WGM ? (nM - fm) : WGM;
        u.pm = fm + ((wgid % nig) % gsz); u.pn = (wgid % nig) / gsz; return true;
    }
};
struct Ctx { int wr, wc, fr, fq, wid, lane, tid; LAS unsigned char* lds; };
typedef f32x4 Acc[2][2][4][2];

struct GemmArgs { int K, lda, ldb, tsplit; long a_delta; };

template <class Epi, class Panel>
__device__ __forceinline__ void gemm_phase(LAS unsigned char* lds, const GemmArgs g, const StaticOrder& S, const Panel& PN, const Epi& E) {
    int tid_ = threadIdx.x; asm volatile("" : "+v"(tid_));
    const int tid = tid_, wid = __builtin_amdgcn_readfirstlane(tid >> 6), lane = tid & 63, wr = wid >> 2, wc = wid & 3, fr = lane & 15, fq = lane >> 4;
    const int nt = g.K / BK;
    Ctx cx{wr, wc, fr, fq, wid, lane, tid, lds};
    unsigned voffA[2], voffB[2];
#pragma unroll
    for (int i = 0; i < 2; ++i) { int R, C; stage_rc(tid * 16 + i * 8192, R, C); const int Rb = (R & ~31) + perm32(R & 31);
        voffA[i] = (unsigned)(R * g.lda + C) * 2u; voffB[i] = (unsigned)(Rb * g.ldb + C) * 2u; }
    const size_t kstep = (size_t)(BK * 2);
    const size_t hstepA = (size_t)HALF * g.lda * 2, hstepB = (size_t)HALF * g.ldb * 2;
    const unsigned ldsw = (unsigned)wid * 1024u;
    const int aoff = lds_byte(wr * 64 + fr, fq * 8), boff = lds_byte(wc * 32 + fr, fq * 8);
#define PG8_SA(b, h) (((b) * 2 + (h)) * HTB)
#define PG8_SB(b, h) ((4 + (b) * 2 + (h)) * HTB)
#define PG8_STAGE(bufoff, gbase, voff) do { _Pragma("unroll") for (int _i = 0; _i < 2; ++_i) \
        __builtin_amdgcn_global_load_lds((const unsigned*)((const char*)(gbase) + (voff)[_i]), (LAS unsigned*)(lds + (bufoff) + ldsw + _i * 8192), 16, 0, 0); } while (0)
#define PG8_LDA(dst, b, h) do { _Pragma("unroll") for (int m = 0; m < 4; ++m) _Pragma("unroll") for (int k = 0; k < 2; ++k) dst[m][k] = *(const LAS bf16x8*)(lds + PG8_SA(b, h) + aoff + m * 2048 + k * 1024); } while (0)
#define PG8_LDB(dst, b, h) do { _Pragma("unroll") for (int n = 0; n < 2; ++n) _Pragma("unroll") for (int k = 0; k < 2; ++k) dst[n][k] = *(const LAS bf16x8*)(lds + PG8_SB(b, h) + boff + n * 2048 + k * 1024); } while (0)
#define PG8_MMA(ai, bj, At, Bt) do { __builtin_amdgcn_s_setprio(1); _Pragma("unroll") for (int m = 0; m < 4; ++m) _Pragma("unroll") for (int n = 0; n < 2; ++n) _Pragma("unroll") for (int k = 0; k < 2; ++k) \
        acc[ai][bj][m][n] = __builtin_amdgcn_mfma_f32_16x16x32_bf16(Bt[n][k], At[m][k], acc[ai][bj][m][n], 0, 0, 0); __builtin_amdgcn_s_setprio(0); } while (0)
#define PG8_WAIT_V(n) asm volatile("s_waitcnt vmcnt(" #n ")" ::: "memory")
#define PG8_WAIT_L(n) asm volatile("s_waitcnt lgkmcnt(" #n ")" ::: "memory")
#define PG8_BAR __builtin_amdgcn_s_barrier()
#define PG8_SCHED __builtin_amdgcn_sched_barrier(0)
#define PG8_AP(base, tt) ((base) + (size_t)(tt) * kstep + (((tt) >= g.tsplit) ? g.a_delta : 0l))
    Unit cur, nxt; int ui = 0;
    if (!S.next(0, cur)) return;
    Acc acc;
#pragma unroll
    for (int a = 0; a < 2; ++a)
#pragma unroll
        for (int b = 0; b < 2; ++b)
#pragma unroll
            for (int m = 0; m < 4; ++m)
#pragma unroll
                for (int n = 0; n < 2; ++n) acc[a][b][m][n] = (f32x4){0.f, 0.f, 0.f, 0.f};
    bf16x8 At[4][2], B0[2][2], B1[2][2];
    const char* cA; const char* cB; PN(cur, cA, cB);
    if constexpr (Epi::HAS_BEGIN) E.begin(cur, cx, ui);
    PG8_STAGE(PG8_SB(0, 0), cB, voffB); PG8_STAGE(PG8_SB(0, 1), cB + hstepB, voffB); PG8_STAGE(PG8_SA(0, 0), cA, voffA); PG8_STAGE(PG8_SA(0, 1), cA + hstepA, voffA);
    if (wr == 1) PG8_BAR;
    PG8_WAIT_V(2); PG8_BAR;
    PG8_STAGE(PG8_SB(1, 0), cB + kstep, voffB); PG8_STAGE(PG8_SA(1, 0), cA + kstep, voffA); PG8_STAGE(PG8_SB(1, 1), cB + hstepB + kstep, voffB);
    PG8_WAIT_V(6); PG8_BAR;
    for (;;) {
        const bool has_next = S.next(ui + 1, nxt);
        const char* nA = cA; const char* nB = cB; if (has_next) PN(nxt, nA, nB);
#pragma unroll 1
        for (int t = 0; t < nt; t += 2) {
            const bool last = (t == nt - 2);
            if constexpr (Epi::HAS_MID) { if (t == g.tsplit) E.mid(acc, cur, cx, ui); }
            const char* a1 = PG8_AP(cA, t + 1);
            const char* a2 = last ? nA : PG8_AP(cA, t + 2); const char* b2 = last ? nB : cB + (size_t)(t + 2) * kstep;
            const char* a3 = last ? nA + kstep : PG8_AP(cA, t + 3); const char* b3 = b2 + kstep;
            PG8_LDB(B0, 0, 0); PG8_LDB(B1, 0, 1); PG8_SCHED; PG8_LDA(At, 0, 0); PG8_STAGE(PG8_SA(1, 1), a1 + hstepA, voffA);
            PG8_WAIT_V(8); PG8_WAIT_L(0); PG8_BAR; PG8_MMA(0, 0, At, B0); PG8_MMA(0, 1, At, B1); PG8_BAR; PG8_SCHED;
            PG8_LDA(At, 0, 1); PG8_STAGE(PG8_SB(0, 0), b2, voffB); PG8_STAGE(PG8_SB(0, 1), b2 + hstepB, voffB); PG8_STAGE(PG8_SA(0, 0), a2, voffA);
            PG8_WAIT_V(8); PG8_WAIT_L(0); PG8_BAR; PG8_MMA(1, 0, At, B0); PG8_MMA(1, 1, At, B1); PG8_BAR; PG8_SCHED;
            PG8_LDB(B0, 1, 0); PG8_LDB(B1, 1, 1); PG8_SCHED; PG8_LDA(At, 1, 0); PG8_STAGE(PG8_SA(0, 1), a2 + hstepA, voffA);
            PG8_WAIT_V(8); PG8_WAIT_L(0); PG8_BAR; PG8_MMA(0, 0, At, B0); PG8_MMA(0, 1, At, B1); PG8_BAR; PG8_SCHED;
            PG8_LDA(At, 1, 1); PG8_STAGE(PG8_SB(1, 0), b3, voffB); PG8_STAGE(PG8_SB(1, 1), b3 + hstepB, voffB); PG8_STAGE(PG8_SA(1, 0), a3, voffA);
            PG8_WAIT_V(8); PG8_WAIT_L(0); PG8_BAR; PG8_MMA(1, 0, At, B0); PG8_MMA(1, 1, At, B1); PG8_BAR; PG8_SCHED;
        }
        if (wr == 0) PG8_BAR;
        E(acc, cur, cx, ui);
        if (!has_next) break;
#pragma unroll
        for (int a = 0; a < 2; ++a)
#pragma unroll
            for (int b = 0; b < 2; ++b)
#pragma unroll
                for (int m = 0; m < 4; ++m)
#pragma unroll
                    for (int n = 0; n < 2; ++n) acc[a][b][m][n] = (f32x4){0.f, 0.f, 0.f, 0.f};
        cur = nxt; cA = nA; cB = nB; ++ui;
        if constexpr (Epi::HAS_BEGIN) E.begin(cur, cx, ui);
        if (wr == 1) PG8_BAR;
    }
    PG8_WAIT_V(0);
    PG8_BAR;
    asm volatile("" ::: "memory");
#undef PG8_SA
#undef PG8_SB
#undef PG8_STAGE
#undef PG8_LDA
#undef PG8_LDB
#undef PG8_MMA
#undef PG8_WAIT_V
#undef PG8_WAIT_L
#undef PG8_BAR
#undef PG8_SCHED
#undef PG8_AP
}
}
namespace ep {
using pg8::Acc; using pg8::Ctx; using pg8::Unit;
#define EP_FOR_ROWS _Pragma("unroll") for (int ai = 0; ai < 2; ++ai) _Pragma("unroll") for (int m = 0; m < 4; ++m)
#define EP_RU (ai * 128 + cx.wr * 64 + m * 16)
#define EP_FENCE asm volatile("" ::: "memory")
#define EP_PRELOAD_RS(name, sqp, invn) float name[2][4]; EP_FOR_ROWS name[ai][m] = (sqp)[u.pm * 256 + EP_RU + cx.fr]; EP_FOR_ROWS name[ai][m] = rstd_of(name[ai][m], invn);
__device__ __forceinline__ u32x4 pack8(const f32x4 a, const f32x4 b) { u32x4 w; w.x = cvt_pk_bf16(a[0], a[1]); w.y = cvt_pk_bf16(a[2], a[3]); w.z = cvt_pk_bf16(b[0], b[1]); w.w = cvt_pk_bf16(b[2], b[3]); return w; }
__device__ __forceinline__ float sq8(const f32x4 a, const f32x4 b) { return (a[0] * a[0] + a[1] * a[1]) + (a[2] * a[2] + a[3] * a[3]) + (b[0] * b[0] + b[1] * b[1]) + (b[2] * b[2] + b[3] * b[3]); }
__device__ __forceinline__ void row_atomic(float* sq_u, int fr, float ss, int fq) { ss += __shfl_xor(ss, 16); ss += __shfl_xor(ss, 32); if (fq == 0) unsafeAtomicAdd(sq_u + fr, ss); }
template <class TT> __device__ __forceinline__ TT* lane_ptr(TT* uni, unsigned lane_bytes) { return (TT*)((char*)uni + lane_bytes); }
template <class TT> __device__ __forceinline__ const TT* lane_ptr(const TT* uni, unsigned lane_bytes) { return (const TT*)((const char*)uni + lane_bytes); }
__device__ __forceinline__ void rope8(f32x4& a, f32x4& b, const f32x4 c4, const f32x4 s4) {
    const f32x4 a0 = a, b0 = b;
    a[0] = a0[0] * c4[0] - a0[1] * s4[0]; a[1] = a0[1] * c4[0] + a0[0] * s4[0]; a[2] = a0[2] * c4[1] - a0[3] * s4[1]; a[3] = a0[3] * c4[1] + a0[2] * s4[1];
    b[0] = b0[0] * c4[2] - b0[1] * s4[2]; b[1] = b0[1] * c4[2] + b0[0] * s4[2]; b[2] = b0[2] * c4[3] - b0[3] * s4[3]; b[3] = b0[3] * c4[3] + b0[2] * s4[3];
}
__device__ __forceinline__ size_t koff_u(int b, int h, int s16, int chunk) { return ((((size_t)(b * 8 + h) * 64 + (s16 >> 6)) * 12 + chunk) * 64 + (s16 & 63)) * 16; }
__device__ __forceinline__ size_t voff_u(int b, int h, int s16, int dh) { return ((((size_t)(b * 8 + h) * 64 + (s16 >> 6)) * 2 + dh) * 64 + (s16 & 63)) * 64; }

struct EpiProj {
    static constexpr bool HAS_MID = false, HAS_BEGIN = false;
    const float* sq_in; float* sq_cq; float* sq_ckv; bf16_t* projb; bf16_t* assm; unsigned char* kb; const float* cs;
    __device__ __forceinline__ void operator()(Acc& acc, const Unit& u, const Ctx& cx, int) const {
        const unsigned l_pj = (unsigned)(cx.fr * 512 + cx.fq * 8) * 2u, l_cs = (unsigned)(cx.fr * 32 + cx.fq * 4) * 4u, l_k = (unsigned)cx.fr * 16u, l_as = (unsigned)(cx.fr * 16) * 2u;
        EP_PRELOAD_RS(rsv, sq_in, 1.0f / 1024.0f)
        EP_FOR_ROWS { const int rowu = u.pm * 256 + EP_RU; const float rs = rsv[ai][m];
            if (u.pn == 0) { float ss = 0.f;
#pragma unroll
                for (int bj = 0; bj < 2; ++bj) { const f32x4 v0 = acc[ai][bj][m][0] * rs, v1 = acc[ai][bj][m][1] * rs; ss += sq8(v0, v1);
                    *(u32x4*)lane_ptr(projb + (size_t)rowu * 512 + bj * 128 + cx.wc * 32, l_pj) = pack8(v0, v1); }
                row_atomic(sq_cq + rowu, cx.fr, ss, cx.fq);
            } else if (u.pn == 1) {
                { const f32x4 v0 = acc[ai][0][m][0] * rs, v1 = acc[ai][0][m][1] * rs; *(u32x4*)lane_ptr(projb + (size_t)rowu * 512 + 256 + cx.wc * 32, l_pj) = pack8(v0, v1); row_atomic(sq_ckv + rowu, cx.fr, sq8(v0, v1), cx.fq); }
                f32x4 v0 = acc[ai][1][m][0] * rs, v1 = acc[ai][1][m][1] * rs;
                if (cx.wc != 0) { v0 = (f32x4){0.f, 0.f, 0.f, 0.f}; v1 = v0; }
                *(u32x4*)lane_ptr(projb + (size_t)rowu * 512 + 384 + cx.wc * 32, l_pj) = pack8(v0, v1);
                if (cx.wc == 0) { const float* cp = lane_ptr(cs + (size_t)rowu * 32, l_cs); const f32x4 c4 = *(const f32x4*)cp, s4 = *(const f32x4*)(cp + 16);
                    rope8(v0, v1, c4, s4); const u32x4 w = pack8(v0, v1); const int b = rowu >> 12, s16 = rowu & 4095;
#pragma unroll
                    for (int h = 0; h < 8; ++h) *(u32x4*)lane_ptr(kb + koff_u(b, h, s16, 8) , l_k + (unsigned)cx.fq * 1024u) = w; }
            } else {
#pragma unroll
                for (int bj = 0; bj < 2; ++bj) { const f32x4 v0 = acc[ai][bj][m][0] * rs, v1 = acc[ai][bj][m][1] * rs; const int chu = (u.pn - 2) * 256 + bj * 128 + cx.wc * 32;
                    *(u32x4*)lane_ptr(assm + ((size_t)(chu >> 4) * NCH + (rowu >> 5)) * KS3 + (rowu & 31) * 16, l_as + (unsigned)(cx.fq >> 1) * (unsigned)(NCH * KS3 * 2) + (unsigned)(cx.fq & 1) * 16u) = pack8(v0, v1); }
            }
            EP_FENCE;
        }
    }
};
struct EpiQ {
    static constexpr bool HAS_MID = false, HAS_BEGIN = false;
    const float* sq_cq; bf16_t* qb; const float* cs;
    __device__ __forceinline__ void operator()(Acc& acc, const Unit& u, const Ctx& cx, int) const {
        const unsigned l_q = (unsigned)(cx.fr * 768 + cx.fq * 8) * 2u, l_cs = (unsigned)(cx.fr * 32 + cx.fq * 4) * 4u;
        EP_PRELOAD_RS(rsv, sq_cq, 1.0f / 256.0f)
        EP_FOR_ROWS { const int rowu = u.pm * 256 + EP_RU; const float rs = rsv[ai][m];
            f32x4 c4 = (f32x4){1.f, 1.f, 1.f, 1.f}, s4 = (f32x4){0.f, 0.f, 0.f, 0.f}; if (u.pn == 2) { const float* cp = lane_ptr(cs + (size_t)rowu * 32, l_cs); c4 = *(const f32x4*)cp; s4 = *(const f32x4*)(cp + 16); }
#pragma unroll
            for (int bj = 0; bj < 2; ++bj) { f32x4 v0 = acc[ai][bj][m][0] * rs, v1 = acc[ai][bj][m][1] * rs;
                if (u.pn == 2) rope8(v0, v1, c4, s4);
                *(u32x4*)lane_ptr(qb + (size_t)rowu * 768 + u.pn * 256 + bj * 128 + cx.wc * 32, l_q) = pack8(v0, v1); }
            EP_FENCE; }
    }
};
struct EpiKV {
    static constexpr bool HAS_MID = false, HAS_BEGIN = false;
    const float* sq_ckv; unsigned char* kb; unsigned char* vb;
    __device__ __forceinline__ void operator()(Acc& acc, const Unit& u, const Ctx& cx, int) const {
        const unsigned l_kv = (cx.wc < 2) ? (unsigned)cx.fr * 16u + (unsigned)cx.fq * 1024u : (unsigned)cx.fr * 64u + (unsigned)cx.fq * 16u;
        EP_PRELOAD_RS(rsv, sq_ckv, 1.0f / 128.0f)
        EP_FOR_ROWS { const int rowu = u.pm * 256 + EP_RU; const float rs = rsv[ai][m]; const int b = rowu >> 12, s16 = rowu & 4095;
#pragma unroll
            for (int bj = 0; bj < 2; ++bj) { const f32x4 v0 = acc[ai][bj][m][0] * rs, v1 = acc[ai][bj][m][1] * rs; const int h = 2 * u.pn + bj;
                unsigned char* dst = (cx.wc < 2) ? kb + koff_u(b, h, s16, cx.wc * 4) : vb + voff_u(b, h, s16, cx.wc - 2);
                *(u32x4*)lane_ptr(dst, l_kv) = pack8(v0, v1); }
            EP_FENCE; }
    }
};
struct EpiUp {
    static constexpr bool HAS_MID = false, HAS_BEGIN = false;
    EpiQ q; EpiKV kv;
    __device__ __forceinline__ void operator()(Acc& acc, const Unit& u, const Ctx& cx, int ui) const { if (u.pn < 3) q(acc, u, cx, ui); else { const Unit u2{u.pm, u.pn - 3}; kv(acc, u2, cx, ui); } }
};
struct EpiXloc {
    static constexpr bool HAS_MID = false, HAS_BEGIN = false;
    float* xloc;
    __device__ __forceinline__ void operator()(Acc& acc, const Unit& u, const Ctx& cx, int) const {
        const unsigned l_x = (unsigned)(cx.fr * 128 + cx.fq * 8) * 4u;
        EP_FOR_ROWS { const int rowu = u.pm * 256 + EP_RU; float* o = lane_ptr(xloc + (size_t)rowu * 128 + cx.wc * 32, l_x); *(f32x4*)o = acc[ai][0][m][0]; *(f32x4*)(o + 4) = acc[ai][0][m][1]; EP_FENCE; }
    }
};
__device__ __forceinline__ float gelu_tanh_f(float x) { const float z = 0.7978845608028654f * (x + 0.044715f * x * x * x); return x * __builtin_amdgcn_rcpf(1.0f + __builtin_amdgcn_exp2f(-2.0f * LOG2E * z)); }
__device__ __forceinline__ f32x4 gelu4(const f32x4 v) { return (f32x4){gelu_tanh_f(v[0]), gelu_tanh_f(v[1]), gelu_tanh_f(v[2]), gelu_tanh_f(v[3])}; }
struct EpiY {
    static constexpr bool HAS_MID = false, HAS_BEGIN = false;
    bf16_t* yb; bf16_t* gb;
    __device__ __forceinline__ void operator()(Acc& acc, const Unit& u, const Ctx& cx, int) const {
        const unsigned l_y = (unsigned)((cx.fr * 32 + (cx.fq >> 1)) * 512 + (cx.fq & 1) * 8) * 2u;
        EP_FOR_ROWS { const int rowu = u.pm * 256 + EP_RU, g = rowu >> 10, chunku = rowu & 1023;
#pragma unroll
            for (int bj = 0; bj < 2; ++bj) { const int colu = u.pn * 256 + bj * 128 + cx.wc * 32; const size_t o = ((size_t)chunku * 32 + (colu >> 4)) * 512 + g * 16;
                const f32x4 v0 = acc[ai][bj][m][0], v1 = acc[ai][bj][m][1]; *(u32x4*)lane_ptr(yb + o, l_y) = pack8(v0, v1); *(u32x4*)lane_ptr(gb + o, l_y) = pack8(gelu4(v0), gelu4(v1)); }
            EP_FENCE;
        }
    }
};
__device__ __forceinline__ float sigm(float z) { return __builtin_amdgcn_rcpf(1.0f + __builtin_amdgcn_exp2f(-LOG2E * z)); }
struct EpiGlu {
    static constexpr bool HAS_MID = false, HAS_BEGIN = false;
    const bf16_t* yb; const float* bglu; bf16_t* sout; float* sq_s;
    __device__ __forceinline__ void operator()(Acc& acc, const Unit& u, const Ctx& cx, int) const {
        const unsigned l_y = (unsigned)(cx.fr * 512 + cx.fq * 8) * 2u, l_b = (unsigned)(cx.fq * 8) * 4u;
        f32x4 bv[2][2];
#pragma unroll
        for (int bj = 0; bj < 2; ++bj) { const float* bp = lane_ptr(bglu + u.pn * 256 + bj * 128 + cx.wc * 32, l_b); bv[bj][0] = *(const f32x4*)bp; bv[bj][1] = *(const f32x4*)(bp + 4); }
#pragma unroll
        for (int ai = 0; ai < 2; ++ai) { u32x4 yw[4][2];
#pragma unroll
            for (int m = 0; m < 4; ++m)
#pragma unroll
                for (int bj = 0; bj < 2; ++bj) yw[m][bj] = *(const u32x4*)lane_ptr(yb + (size_t)(u.pm * 256 + EP_RU) * 512 + u.pn * 256 + bj * 128 + cx.wc * 32, l_y);
#pragma unroll
            for (int m = 0; m < 4; ++m) { const int rowu = u.pm * 256 + EP_RU; float ss = 0.f;
#pragma unroll
                for (int bj = 0; bj < 2; ++bj) { const int colu = u.pn * 256 + bj * 128 + cx.wc * 32; const u32x4 w = yw[m][bj];
                    const f32x4 z0 = acc[ai][bj][m][0] + bv[bj][0], z1 = acc[ai][bj][m][1] + bv[bj][1];
                    const f32x4 v0 = (f32x4){bf_lo(w.x) * sigm(z0[0]), bf_hi(w.x) * sigm(z0[1]), bf_lo(w.y) * sigm(z0[2]), bf_hi(w.y) * sigm(z0[3])};
                    const f32x4 v1 = (f32x4){bf_lo(w.z) * sigm(z1[0]), bf_hi(w.z) * sigm(z1[1]), bf_lo(w.w) * sigm(z1[2]), bf_hi(w.w) * sigm(z1[3])};
                    ss += sq8(v0, v1); *(u32x4*)lane_ptr(sout + (size_t)rowu * 512 + colu, l_y) = pack8(v0, v1); }
                row_atomic(sq_s + rowu, cx.fr, ss, cx.fq); }
            EP_FENCE;
        }
    }
};
template <bool MIX> struct EpiRes {
    static constexpr bool HAS_MID = MIX, HAS_BEGIN = MIX;
    const float* hin32; float* hout32; bf16_t* hb; float* sq_next; const float* sq_a; const float* sq_s;
    __device__ __forceinline__ void begin(const Unit& u, const Ctx& cx, int ui) const {
        if (cx.tid < 256) { const int row = u.pm * 256 + cx.tid; const float ra = rstd_of(sq_a[row], 1.0f / 512.0f), rsd = rstd_of(sq_s[row], 1.0f / 512.0f);
            ((LAS f32x2*)(cx.lds + XCH_OFF + (ui & 1) * 2048))[cx.tid] = (f32x2){ra / rsd, rsd}; }
    }
    __device__ __forceinline__ void mid(Acc& acc, const Unit&, const Ctx& cx, int ui) const {
        const LAS f32x2* tab = (const LAS f32x2*)(cx.lds + XCH_OFF + (ui & 1) * 2048) + cx.fr;
        EP_FOR_ROWS { const float r = tab[EP_RU].x;
#pragma unroll
            for (int bj = 0; bj < 2; ++bj) { acc[ai][bj][m][0] *= r; acc[ai][bj][m][1] *= r; } }
    }
    __device__ __forceinline__ void operator()(Acc& acc, const Unit& u, const Ctx& cx, int ui) const {
        const LAS f32x2* tab = (const LAS f32x2*)(cx.lds + XCH_OFF + (ui & 1) * 2048) + cx.fr;
        const unsigned l_h = (unsigned)(cx.fr * 1024 + cx.fq * 8) * 4u, l_hb = l_h >> 1;
#pragma unroll
        for (int ai = 0; ai < 2; ++ai) {
            f32x4 pre[4][2][2];
#pragma unroll
            for (int m = 0; m < 4; ++m)
#pragma unroll
                for (int bj = 0; bj < 2; ++bj) { const size_t o = (size_t)(u.pm * 256 + EP_RU) * 1024 + u.pn * 256 + bj * 128 + cx.wc * 32;
                    if (hin32) { const float* hq = lane_ptr(hin32 + o, l_h); pre[m][bj][0] = *(const f32x4*)hq; pre[m][bj][1] = *(const f32x4*)(hq + 4); }
                    else { const u32x4 w = *(const u32x4*)lane_ptr(hb + o, l_hb); pre[m][bj][0] = __builtin_bit_cast(f32x4, w); } }
#pragma unroll
            for (int m = 0; m < 4; ++m) { const int ru = EP_RU, rowu = u.pm * 256 + ru; float sc = 1.0f; if (MIX) sc = tab[ru].y; float ss = 0.f;
#pragma unroll
                for (int bj = 0; bj < 2; ++bj) { const size_t o = (size_t)rowu * 1024 + u.pn * 256 + bj * 128 + cx.wc * 32; f32x4 h0, h1;
                    if (hin32) { h0 = pre[m][bj][0]; h1 = pre[m][bj][1]; }
                    else { const u32x4 w = __builtin_bit_cast(u32x4, pre[m][bj][0]); h0 = (f32x4){bf_lo(w.x), bf_hi(w.x), bf_lo(w.y), bf_hi(w.y)}; h1 = (f32x4){bf_lo(w.z), bf_hi(w.z), bf_lo(w.w), bf_hi(w.w)}; }
                    const f32x4 v0 = h0 + acc[ai][bj][m][0] * sc, v1 = h1 + acc[ai][bj][m][1] * sc;
                    if (hout32) { float* hp = lane_ptr(hout32 + o, l_h); *(f32x4*)hp = v0; *(f32x4*)(hp + 4) = v1; }
                    else *(u32x4*)lane_ptr(hb + o, l_hb) = pack8(v0, v1);
                    ss += sq8(v0, v1); }
                row_atomic(sq_next + rowu, cx.fr, ss, cx.fq); }
            EP_FENCE;
        }
    }
};
struct EpiSoftmax {
    static constexpr bool HAS_MID = false, HAS_BEGIN = false;
    const float* sq_x; bf16_t* pb;
    __device__ __forceinline__ void operator()(Acc& acc, const Unit& u, const Ctx& cx, int) const {
        LAS float* PM = (LAS float*)(cx.lds + XCH_OFF + 4096) + cx.fr * 4; LAS float* PS = (LAS float*)(cx.lds + XCH_OFF + 8192) + cx.fr * 4;
        EP_PRELOAD_RS(rsv, sq_x, 1.0f / 1024.0f)
        EP_FOR_ROWS { const int ru = EP_RU; const float rs = rsv[ai][m]; float mx = -3.0e38f;
#pragma unroll
            for (int bj = 0; bj < 2; ++bj)
#pragma unroll
                for (int n = 0; n < 2; ++n) { f32x4 v = acc[ai][bj][m][n] * rs; acc[ai][bj][m][n] = v; mx = fmaxf(fmaxf(mx, fmaxf(v[0], v[1])), fmaxf(v[2], v[3])); }
            mx = fmaxf(mx, __shfl_xor(mx, 16)); mx = fmaxf(mx, __shfl_xor(mx, 32));
            if (cx.fq == 0) PM[ru * 4 + cx.wc] = mx; EP_FENCE; }
        asm volatile("s_waitcnt lgkmcnt(0)" ::: "memory"); __builtin_amdgcn_s_barrier(); asm volatile("" ::: "memory");
        EP_FOR_ROWS { const int ru = EP_RU; const f32x4 q = *(const LAS f32x4*)(PM + ru * 4); const float mx = fmaxf(fmaxf(q[0], q[1]), fmaxf(q[2], q[3])); float sm = 0.f;
#pragma unroll
            for (int bj = 0; bj < 2; ++bj)
#pragma unroll
                for (int n = 0; n < 2; ++n) { f32x4 v = acc[ai][bj][m][n]; v = (f32x4){__builtin_amdgcn_exp2f(v[0] - mx), __builtin_amdgcn_exp2f(v[1] - mx), __builtin_amdgcn_exp2f(v[2] - mx), __builtin_amdgcn_exp2f(v[3] - mx)};
                    acc[ai][bj][m][n] = v; sm += (v[0] + v[1]) + (v[2] + v[3]); }
            sm += __shfl_xor(sm, 16); sm += __shfl_xor(sm, 32);
            if (cx.fq == 0) PS[ru * 4 + cx.wc] = sm; EP_FENCE; }
        asm volatile("s_waitcnt lgkmcnt(0)" ::: "memory"); __builtin_amdgcn_s_barrier(); asm volatile("" ::: "memory");
        const unsigned l_p = (unsigned)(cx.fr * 1024 + cx.fq * 8) * 2u;
        EP_FOR_ROWS { const int ru = EP_RU, rowu = u.pm * 256 + ru; const f32x4 q = *(const LAS f32x4*)(PS + ru * 4); const float inv = __builtin_amdgcn_rcpf((q[0] + q[1]) + (q[2] + q[3]));
#pragma unroll
            for (int bj = 0; bj < 2; ++bj) *(u32x4*)lane_ptr(pb + (size_t)rowu * 1024 + u.pn * 256 + bj * 128 + cx.wc * 32, l_p) = pack8(acc[ai][bj][m][0] * inv, acc[ai][bj][m][1] * inv);
            EP_FENCE; }
    }
};
struct EpiSwiglu {
    static constexpr bool HAS_MID = false, HAS_BEGIN = false;
    const float* sq_f; bf16_t* hid;
    __device__ __forceinline__ void operator()(Acc& acc, const Unit& u, const Ctx& cx, int) const {
        const unsigned l_h = (unsigned)(cx.fr * FF + cx.fq * 8) * 2u;
        EP_PRELOAD_RS(rsv, sq_f, 1.0f / 1024.0f)
        EP_FOR_ROWS { const int rowu = u.pm * 256 + EP_RU; const float rs = rsv[ai][m]; f32x4 o[2];
#pragma unroll
            for (int n = 0; n < 2; ++n) { const f32x4 g = acc[ai][0][m][n] * rs, up = acc[ai][1][m][n] * rs; o[n] = (f32x4){g[0] * sigm(g[0]) * up[0], g[1] * sigm(g[1]) * up[1], g[2] * sigm(g[2]) * up[2], g[3] * sigm(g[3]) * up[3]}; }
            *(u32x4*)lane_ptr(hid + (size_t)rowu * FF + u.pn * 128 + cx.wc * 32, l_h) = pack8(o[0], o[1]); EP_FENCE; }
    }
};
template <class OutFn> struct EpiStore {
    static constexpr bool HAS_MID = false, HAS_BEGIN = false;
    OutFn of;
    __device__ __forceinline__ void operator()(Acc& acc, const Unit& u, const Ctx& cx, int) const {
        int ld; bf16_t* base = of(u, ld); const unsigned l_o = (unsigned)(cx.fr * ld + cx.fq * 8) * 2u;
        EP_FOR_ROWS { const int ru = EP_RU;
#pragma unroll
            for (int bj = 0; bj < 2; ++bj) *(u32x4*)lane_ptr(base + (size_t)ru * ld + bj * 128 + cx.wc * 32, l_o) = pack8(acc[ai][bj][m][0], acc[ai][bj][m][1]);
            EP_FENCE; }
    }
};
}
namespace att {
constexpr int KSLOT = 12288, VSLOT = 8192, NSLOT = 3;
constexpr int L_K = 0, L_V = NSLOT * KSLOT, L_WS = L_V + NSLOT * VSLOT, L_OST = L_WS + 8 * 256, L_END = L_OST + 8 * 4096;
static_assert(L_END <= RING_BYTES, "attention LDS");
__device__ __forceinline__ int crow(int r, int hi) { return (r & 3) + 8 * (r >> 2) + 4 * hi; }
#define SBAR() __builtin_amdgcn_sched_barrier(0)
__device__ __forceinline__ void cmask(f32x16& p0, f32x16& p1, int jb, int qrel, int hi) {
    const float NEG = -INFINITY; const int kb = 64 * jb + 4 * hi;
#pragma unroll
    for (int r = 0; r < 16; ++r) { const int kv = kb + (r & 3) + 8 * (r >> 2); if (kv > qrel) p0[r] = NEG; if (kv + 32 > qrel) p1[r] = NEG; }
}
__device__ __forceinline__ void glds16(const void* gsrc, unsigned lds_dst) { unsigned keep;
    asm volatile("s_mov_b32 %0, m0\n\ts_mov_b32 m0, %2\n\ts_nop 0\n\tglobal_load_lds_dwordx4 %1, off\n\ts_mov_b32 m0, %0" : "=&s"(keep) : "v"(gsrc), "s"(lds_dst) : "memory"); }
__device__ __forceinline__ float max3f(float a, float b, float c) { float r; asm("v_max3_f32 %0, %1, %2, %3" : "=v"(r) : "v"(a), "v"(b), "v"(c)); return r; }
__device__ __forceinline__ float max2f(float a, float b) { float r; asm("v_max_f32_e32 %0, %1, %2" : "=v"(r) : "v"(a), "v"(b)); return r; }
__device__ __forceinline__ float fadd_s(float a, float b) { float r; asm("v_add_f32_e32 %0, %1, %2" : "=v"(r) : "v"(a), "v"(b)); return r; }
__device__ __forceinline__ float fsub_s(float a, float b) { float r; asm("v_sub_f32_e32 %0, %1, %2" : "=v"(r) : "v"(a), "v"(b)); return r; }
#define WAIT_BAR(N) asm volatile("s_waitcnt vmcnt(" #N ") lgkmcnt(0)\n\ts_barrier" ::: "memory")
typedef LAS const char* lds_cptr;
typedef short v4i16_t __attribute__((ext_vector_type(4)));
__device__ __forceinline__ void qkt(f32x16& p0, f32x16& p1, lds_cptr kb, const bf16x8* qr) { const f32x16 negm = f32x16{};
#pragma unroll
    for (int d0 = 0; d0 < 6; ++d0) { const bf16x8 b0 = *(const LAS bf16x8*)(kb + d0 * 2048), b1 = *(const LAS bf16x8*)(kb + d0 * 2048 + 512);
        if (d0 == 0) { p0 = __builtin_amdgcn_mfma_f32_32x32x16_bf16(b0, qr[0], negm, 0, 0, 0); p1 = __builtin_amdgcn_mfma_f32_32x32x16_bf16(b1, qr[0], negm, 0, 0, 0); }
        else { p0 = __builtin_amdgcn_mfma_f32_32x32x16_bf16(b0, qr[d0], p0, 0, 0, 0); p1 = __builtin_amdgcn_mfma_f32_32x32x16_bf16(b1, qr[d0], p1, 0, 0, 0); } }
}
__device__ __forceinline__ void kload2(bf16x8* kf, lds_cptr kp, int j) { kf[2 * j] = *(const LAS bf16x8*)(kp + j * 2048); kf[2 * j + 1] = *(const LAS bf16x8*)(kp + j * 2048 + 512); }
__device__ __forceinline__ s16x4 vtr(lds_cptr p) { return __builtin_bit_cast(s16x4, __builtin_amdgcn_ds_read_tr16_b64_v4i16((LAS v4i16_t*)p)); }
__device__ __forceinline__ float rowmax(const f32x16& p0, const f32x16& p1) {
    float a = max3f(p0[0], p0[1], p1[0]), b = max3f(p0[2], p0[3], p1[1]); a = max3f(a, p1[2], p1[3]);
#pragma unroll
    for (int r = 4; r < 16; r += 4) { a = max3f(a, p0[r], p0[r + 1]); b = max3f(b, p0[r + 2], p0[r + 3]); a = max3f(a, p1[r], p1[r + 1]); b = max3f(b, p1[r + 2], p1[r + 3]); }
    const float m = max2f(a, b);
    auto rr = __builtin_amdgcn_permlane32_swap(__float_as_uint(m), __float_as_uint(m), false, false);
    return max2f(__uint_as_float(rr[0]), __uint_as_float(rr[1]));
}
__device__ __forceinline__ void pv(f32x16* o, int vb, bf16x8 pa0, bf16x8 pa1, bf16x8 pa2, bf16x8 pa3) {
#pragma unroll
    for (int d0 = 0; d0 < 2; ++d0) { s16x4 lo[4], hi[4];
#pragma unroll
        for (int ks = 0; ks < 4; ++ks) {
            asm volatile("ds_read_b64_tr_b16 %0,%1 offset:%c2" : "=&v"(lo[ks]) : "v"(vb), "i"(d0 * 4096 + ks * 1024) : "memory");
            asm volatile("ds_read_b64_tr_b16 %0,%1 offset:%c2" : "=&v"(hi[ks]) : "v"(vb), "i"(d0 * 4096 + ks * 1024 + 512) : "memory"); }
        asm volatile("s_waitcnt lgkmcnt(0)" ::: "memory"); SBAR();
#define PK(k) (bf16x8){lo[k][0], lo[k][1], lo[k][2], lo[k][3], hi[k][0], hi[k][1], hi[k][2], hi[k][3]}
        o[d0] = __builtin_amdgcn_mfma_f32_32x32x16_bf16(pa0, PK(0), o[d0], 0, 0, 0);
        o[d0] = __builtin_amdgcn_mfma_f32_32x32x16_bf16(pa1, PK(1), o[d0], 0, 0, 0);
        o[d0] = __builtin_amdgcn_mfma_f32_32x32x16_bf16(pa2, PK(2), o[d0], 0, 0, 0);
        o[d0] = __builtin_amdgcn_mfma_f32_32x32x16_bf16(pa3, PK(3), o[d0], 0, 0, 0);
#undef PK
    }
}
template <int THRL>
__device__ __forceinline__ void attn_unit(int b, int h, int qb, const bf16_t* Q, const unsigned char* Kg, const unsigned char* Vg, bf16_t* AO, float* sq_a, LAS unsigned char* lds) {
    int tid_ = threadIdx.x; asm volatile("" : "+v"(tid_));
    const int tid = tid_, lane = tid & 63, r32 = lane & 31, hi = lane >> 5; const int wid = __builtin_amdgcn_readfirstlane(tid >> 6);
    const int q0 = qb * 256; const size_t rowbase = (size_t)b * S;
    const bf16_t* Qw = Q + (rowbase + q0 + wid * 32) * 768;
    const unsigned lds0 = (unsigned)(uintptr_t)lds;
    LAS float* wsf = (LAS float*)(lds + L_WS) + wid * 64;
    const unsigned char* ksrc = Kg + (size_t)(b * 8 + h) * 64 * KSLOT + wid * 1536 + lane * 16; const unsigned char* vsrc = Vg + (size_t)(b * 8 + h) * 64 * VSLOT + wid * 1024 + lane * 16;
    const unsigned kdst = lds0 + L_K + wid * 1536, vdst = lds0 + L_V + wid * 1024;
#define DMA_K(t, sl) do { glds16(ksrc + (size_t)(t) * KSLOT, (unsigned)__builtin_amdgcn_readfirstlane(kdst + (sl) * KSLOT)); \
        if (lane < 32) glds16(ksrc + (size_t)(t) * KSLOT + 1024, (unsigned)__builtin_amdgcn_readfirstlane(kdst + (sl) * KSLOT + 1024)); } while (0)
#define DMA_V(t, sl) glds16(vsrc + (size_t)(t) * VSLOT, (unsigned)__builtin_amdgcn_readfirstlane(vdst + (sl) * VSLOT))
    const int vb0 = (int)(lds0 + L_V) + ((lane >> 4) & 1) * 32 + (lane & 3) * 8 + (4 * hi + ((lane & 15) >> 2)) * 64;
    bf16x8 kf[12];
    const lds_cptr kp0 = (lds_cptr)lds + L_K + hi * 1024 + r32 * 16; const lds_cptr vp0 = (lds_cptr)lds + L_V + ((lane >> 4) & 1) * 32 + (lane & 3) * 8 + (4 * hi + ((lane & 15) >> 2)) * 64;
    const int NT = 4 * (qb + 1);
    DMA_K(0, 0); DMA_V(0, 0); DMA_K(1, 1);
    bf16x8 qr[6];
#pragma unroll
    for (int d0 = 0; d0 < 6; ++d0) qr[d0] = *reinterpret_cast<const bf16x8*>(&Qw[(size_t)r32 * 768 + (d0 < 4 ? h * 64 + d0 * 16 : 512 + h * 32 + (d0 - 4) * 16) + hi * 8]);
    float mhat = 0.f, l_reg = 0.f; f32x16 o[2]; o[0] = f32x16{}; o[1] = f32x16{};
    const int qrel = wid * 32 + r32;
#define CMASK(P0, P1, t) do { int jb_ = (t) - (NT - 4); if (jb_ >= 0) cmask(P0, P1, jb_, qrel, hi); } while (0)
    bool resc = false;
#define START(P0, P1) do { const float rm = rowmax(P0, P1); resc = false; \
    mhat = rm; \
    _Pragma("unroll") for (int r = 0; r < 16; ++r) P0[r] = __builtin_amdgcn_exp2f(P0[r] - mhat); } while (0)
#define RESC() do { if (resc) { asm volatile("s_waitcnt lgkmcnt(0)" ::: "memory"); \
      _Pragma("unroll") for (int d_ = 0; d_ < 2; ++d_) _Pragma("unroll") for (int r = 0; r < 16; ++r) o[d_][r] *= wsf[crow(r, hi)]; } } while (0)
    f32x16 pA0, pA1, pB0, pB1;
    int sp = 0, sc = 0, sn = 1;
#define ROT() do { sp = sc; sc = sn; sn = (sn == NSLOT - 1) ? 0 : sn + 1; } while (0)
    DMA_K(2, 2);
    WAIT_BAR(5);
    qkt(pA0, pA1, kp0, qr); asm volatile("s_nop 15\n\ts_nop 7" : "+v"(pA0), "+v"(pA1)); CMASK(pA0, pA1, 0);
    START(pA0, pA1);
#pragma unroll
    for (int r = 0; r < 16; ++r) pA1[r] = __builtin_amdgcn_exp2f(pA1[r] - mhat);
    WAIT_BAR(0);
    DMA_K(3, 0); DMA_V(1, 1);
    ROT();
#pragma unroll
    for (int j = 0; j < 6; ++j) kload2(kf, kp0 + sc * KSLOT, j);
    WAIT_BAR(3);
    s16x4 vlo[8], vhi[8]; u32x4 pw0, pw1, pw2, pw3;
#define PKW(P, B) cvt_pk_bf16(P[B], P[B + 1])
#define PAF(k) __builtin_bit_cast(bf16x8, pw##k)
#define VFR(i) (bf16x8){vlo[i][0], vlo[i][1], vlo[i][2], vlo[i][3], vhi[i][0], vhi[i][1], vhi[i][2], vhi[i][3]}
#define PIN(x) asm volatile("" : "+v"(x))
#define MX3(a, b, c) __builtin_fmaxf(__builtin_fmaxf((a), (b)), (c))
#define GAPA(MF, A0, A1, A2, A3, W0, W1, PW) do { MF; sacc += A0; sacc += A1; sacc += A2; sacc += A3; PIN(sacc); W0; W1; PIN(PW); SBAR(); } while (0)
#define GAPM(MF) do { MF; SBAR(); } while (0)
#define EX(v) __builtin_amdgcn_exp2f(v)
#define GAPB(MF, X, B) do { MF; X[B] = EX(X[B] - mhat); X[B + 1] = EX(X[B + 1] - mhat); X[B + 2] = EX(X[B + 2] - mhat); X[B + 3] = EX(X[B + 3] - mhat); PIN(X); SBAR(); } while (0)
#define VRD(i) do { vlo[i] = vtr(vp_ + (((i) >> 2) * 4096 + ((i) & 3) * 1024)); vhi[i] = vtr(vp_ + (((i) >> 2) * 4096 + ((i) & 3) * 1024 + 512)); } while (0)
#define KRD(G, j) do { if (G) { kload2(kf, kp0 + sn * KSLOT, j); SBAR(); } } while (0)
#define MF32(A, B, C) __builtin_amdgcn_mfma_f32_32x32x16_bf16(A, B, C, 0, 0, 0)
#define STEP(C0, C1, P0, P1, t, GK, GV, GL) do { SBAR(); const f32x16 zero16 = f32x16{}; \
    const lds_cptr vp_ = vp0 + sp * VSLOT; \
    VRD(0); SBAR(); float sacc = (P0[0] + P0[1]); \
    GAPA(C0 = MF32(kf[0], qr[0], zero16), P0[2], P0[3], P0[4], P0[5],     pw0[0] = PKW(P0, 0), pw0[1] = PKW(P0, 2), pw0); \
    VRD(4); SBAR(); GAPA(C1 = MF32(kf[1], qr[0], zero16), P0[6], P0[7], P0[8], P0[9],     pw0[2] = PKW(P0, 4), pw0[3] = PKW(P0, 6), pw0); \
    VRD(1); SBAR(); GAPA(C0 = MF32(kf[2], qr[1], C0),   P0[10], P0[11], P0[12], P0[13], pw1[0] = PKW(P0, 8), pw1[1] = PKW(P0, 10), pw1); \
    VRD(5); SBAR(); GAPA(C1 = MF32(kf[3], qr[1], C1),   P0[14], P0[15], P1[0], P1[1],   pw1[2] = PKW(P0, 12), pw1[3] = PKW(P0, 14), pw1); \
    VRD(2); SBAR(); GAPA(C0 = MF32(kf[4], qr[2], C0),   P1[2], P1[3], P1[4], P1[5],     pw2[0] = PKW(P1, 0), pw2[1] = PKW(P1, 2), pw2); \
    VRD(6); SBAR(); GAPA(C1 = MF32(kf[5], qr[2], C1),   P1[6], P1[7], P1[8], P1[9],     pw2[2] = PKW(P1, 4), pw2[3] = PKW(P1, 6), pw2); \
    VRD(3); SBAR(); GAPA(C0 = MF32(kf[6], qr[3], C0),   P1[10], P1[11], P1[12], P1[13], pw3[0] = PKW(P1, 8), pw3[1] = PKW(P1, 10), pw3); \
    VRD(7); SBAR(); GAPA(C1 = MF32(kf[7], qr[3], C1),   P1[14], P1[15], 0.f, 0.f,       pw3[2] = PKW(P1, 12), pw3[3] = PKW(P1, 14), pw3); \
    GAPM(C0 = MF32(kf[8], qr[4], C0)); GAPM(C1 = MF32(kf[9], qr[4], C1)); GAPM(C0 = MF32(kf[10], qr[5], C0)); GAPM(C1 = MF32(kf[11], qr[5], C1)); \
    l_reg += sacc; \
    if (GK) { DMA_K((t) + 3, sc); } if (GV) { DMA_V((t) + 1, sn); } \
    CMASK(C0, C1, t); \
    { float a = MX3(C0[0], C0[1], C1[0]), b = MX3(C0[2], C0[3], C1[1]); a = MX3(a, C1[2], C1[3]); \
      _Pragma("unroll") for (int r = 4; r < 16; r += 4) { a = MX3(a, C0[r], C0[r + 1]); b = MX3(b, C0[r + 2], C0[r + 3]); a = MX3(a, C1[r], C1[r + 1]); b = MX3(b, C1[r + 2], C1[r + 3]); } \
      float rm = __builtin_fmaxf(a, b); { auto rr = __builtin_amdgcn_permlane32_swap(__float_as_uint(rm), __float_as_uint(rm), false, false); rm = __builtin_fmaxf(__uint_as_float(rr[0]), __uint_as_float(rr[1])); } \
      resc = false; \
      rm -= mhat; \
      if (__builtin_expect(__any(rm > (float)THRL), 0)) { const float dl = __builtin_fmaxf(rm, 0.f); mhat += dl; \
        const float f = __builtin_amdgcn_exp2f(-dl); l_reg *= f; if (hi == 0) wsf[r32] = f; resc = true; } } \
    SBAR(); \
    GAPB(o[0] = MF32(PAF(0), VFR(0), o[0]), C0, 0); \
    KRD(GL, 0); GAPB(o[1] = MF32(PAF(0), VFR(4), o[1]), C0, 4); \
    KRD(GL, 1); GAPB(o[0] = MF32(PAF(1), VFR(1), o[0]), C0, 8); \
    KRD(GL, 2); GAPB(o[1] = MF32(PAF(1), VFR(5), o[1]), C0, 12); \
    KRD(GL, 3); GAPB(o[0] = MF32(PAF(2), VFR(2), o[0]), C1, 0); \
    KRD(GL, 4); GAPB(o[1] = MF32(PAF(2), VFR(6), o[1]), C1, 4); \
    KRD(GL, 5); GAPB(o[0] = MF32(PAF(3), VFR(3), o[0]), C1, 8); \
    GAPB(o[1] = MF32(PAF(3), VFR(7), o[1]), C1, 12); \
    } while (0)
    int t = 1;
#undef CMASK
#define CMASK(P0, P1, t) do {} while (0)
    for (; t + 5 < NT; t += 2) {
        STEP(pB0, pB1, pA0, pA1, t, true, true, true);     WAIT_BAR(3); RESC(); ROT();
        STEP(pA0, pA1, pB0, pB1, t + 1, true, true, true); WAIT_BAR(3); RESC(); ROT();
    }
#undef CMASK
#define CMASK(P0, P1, t) do { int jb_ = (t) - (NT - 4); if (jb_ >= 0) cmask(P0, P1, jb_, qrel, hi); } while (0)
#define ENDW(tt) do { if ((tt) + 3 < NT) { WAIT_BAR(3); } else if ((tt) + 2 < NT) { WAIT_BAR(1); } else { WAIT_BAR(0); } } while (0)
    for (; t + 1 < NT; t += 2) {
        STEP(pB0, pB1, pA0, pA1, t, (t + 3 < NT), (t + 1 < NT), (t + 1 < NT));     ENDW(t);     RESC(); ROT();
        STEP(pA0, pA1, pB0, pB1, t + 1, (t + 4 < NT), (t + 2 < NT), (t + 2 < NT)); ENDW(t + 1); RESC(); ROT();
    }
    STEP(pB0, pB1, pA0, pA1, NT - 1, false, false, false); RESC();
    { float sacc = pB0[0] + pB0[1];
#pragma unroll
      for (int r = 2; r < 16; ++r) sacc += pB0[r];
#pragma unroll
      for (int r = 0; r < 16; ++r) sacc += pB1[r];
      l_reg += sacc;
      pw0 = (u32x4){PKW(pB0, 0), PKW(pB0, 2), PKW(pB0, 4), PKW(pB0, 6)}; pw1 = (u32x4){PKW(pB0, 8), PKW(pB0, 10), PKW(pB0, 12), PKW(pB0, 14)};
      pw2 = (u32x4){PKW(pB1, 0), PKW(pB1, 2), PKW(pB1, 4), PKW(pB1, 6)}; pw3 = (u32x4){PKW(pB1, 8), PKW(pB1, 10), PKW(pB1, 12), PKW(pB1, 14)};
      SBAR(); pv(o, vb0 + sc * VSLOT, PAF(0), PAF(1), PAF(2), PAF(3)); }
#undef PKW
#undef PAF
#undef VFR
#undef PIN
#undef MX3
#undef GAPA
#undef GAPM
#undef GAPB
#undef EX
#undef VRD
#undef KRD
#undef MF32
#undef STEP
#undef ENDW
#undef DMA_K
#undef DMA_V
#undef CMASK
#undef START
#undef RESC
#undef ROT
    { auto rr = __builtin_amdgcn_permlane32_swap(__float_as_uint(l_reg), __float_as_uint(l_reg), false, false); l_reg = __uint_as_float(rr[0]) + __uint_as_float(rr[1]); }
    if (hi == 0) wsf[32 + r32] = l_reg;
    asm volatile("s_waitcnt lgkmcnt(0)" ::: "memory");
    LAS bf16_t* stg = (LAS bf16_t*)(lds + L_OST) + wid * 2048;
#pragma unroll
    for (int r = 0; r < 16; ++r) { const int orow = crow(r, hi); const float rl = __builtin_amdgcn_rcpf(wsf[32 + orow]);
#pragma unroll
        for (int d0 = 0; d0 < 2; ++d0) stg[orow * 64 + d0 * 32 + r32] = (bf16_t)(cvt_pk_bf16(o[d0][r] * rl, 0.f) & 0xffffu); }
    asm volatile("s_waitcnt lgkmcnt(0)" ::: "memory");
    bf16_t* Ow = AO + (rowbase + q0 + wid * 32) * 512 + h * 64;
#pragma unroll
    for (int i = 0; i < 4; ++i) { const int row = i * 8 + (lane >> 3), ch = lane & 7; const u32x4 v = *(const LAS u32x4*)(stg + row * 64 + ch * 8); *(u32x4*)(Ow + (size_t)row * 512 + ch * 8) = v;
        float ss = (bf_lo(v.x) * bf_lo(v.x) + bf_hi(v.x) * bf_hi(v.x)) + (bf_lo(v.y) * bf_lo(v.y) + bf_hi(v.y) * bf_hi(v.y)) + (bf_lo(v.z) * bf_lo(v.z) + bf_hi(v.z) * bf_hi(v.z)) + (bf_lo(v.w) * bf_lo(v.w) + bf_hi(v.w) * bf_hi(v.w));
        ss += __shfl_xor(ss, 1); ss += __shfl_xor(ss, 2); ss += __shfl_xor(ss, 4);
        if (ch == 0) unsafeAtomicAdd(sq_a + rowbase + q0 + wid * 32 + row, ss); }
    asm volatile("s_waitcnt lgkmcnt(0)\n\ts_barrier" ::: "memory");
}
#undef SBAR
#undef WAIT_BAR
__device__ __forceinline__ void attn_phase(int vcu, int G, const bf16_t* Q, const unsigned char* Kg, const unsigned char* Vg, bf16_t* AO, float* sq_a, LAS unsigned char* lds) {
    for (int v = vcu; v < 256; v += G) { const int bh = v >> 2, s = v & 3;
#pragma unroll 1
        for (int i = 0; i < 4; ++i) { const int qb = (i == 0) ? s : (i == 1) ? 7 - s : (i == 2) ? 8 + s : 15 - s; attn_unit<8>(bh >> 3, bh & 7, qb, Q, Kg, Vg, AO, sq_a, lds); } }
}
}

__device__ __forceinline__ void ssm_scan_phase(int vcu, int G, const float* xloc, const float* aL  , bf16_t* assm, LAS unsigned char* lds) {
    int tid_ = threadIdx.x; asm volatile("" : "+v"(tid_));
    const int p = tid_ & 63, wave = __builtin_amdgcn_readfirstlane(tid_ >> 6);
    LAS float* ends = (LAS float*)lds;
    for (int v = vcu; v < 256; v += G) { const int b = v >> 5, g = v & 31; const float ar = aL[(g * 64 + p) * 2], ai = aL[(g * 64 + p) * 2 + 1];
        const int c0 = wave * 16;
        const float* xl = xloc + ((size_t)g * NCH + b * NCHB + c0) * 128; bf16_t* as = assm + ((size_t)g * NCH + b * NCHB + c0) * KS3 + KS1;
        float lr[16], li[16];
#pragma unroll
        for (int k = 0; k < 16; ++k) { lr[k] = xl[(size_t)k * 128 + p]; li[k] = xl[(size_t)k * 128 + 64 + p]; }
        float xr = 0.f, xi = 0.f, pr_[16], pi_[16];
#pragma unroll
        for (int k = 0; k < 16; ++k) { pr_[k] = xr; pi_[k] = xi; const float nr = ar * xr - ai * xi + lr[k], ni = ar * xi + ai * xr + li[k]; xr = nr; xi = ni; }
        ends[(wave * 64 + p) * 2] = xr; ends[(wave * 64 + p) * 2 + 1] = xi;
        float a16r = ar, a16i = ai;
#pragma unroll
        for (int q = 0; q < 4; ++q) { const float nr = a16r * a16r - a16i * a16i, ni = 2.f * a16r * a16i; a16r = nr; a16i = ni; }
        __syncthreads();
        float sr = 0.f, si = 0.f;
        for (int w = 0; w < wave; ++w) { const float er = ends[(w * 64 + p) * 2], ei = ends[(w * 64 + p) * 2 + 1]; const float nr = a16r * sr - a16i * si + er, ni = a16r * si + a16i * sr + ei; sr = nr; si = ni; }
        float wr_ = sr, wi_ = si;
#pragma unroll
        for (int k = 0; k < 16; ++k) { const float orr = pr_[k] + wr_, oii = pi_[k] + wi_;
            as[(size_t)k * KS3 + p] = (bf16_t)(cvt_pk_bf16(orr, 0.f) & 0xffffu); as[(size_t)k * KS3 + 64 + p] = (bf16_t)(cvt_pk_bf16(oii, 0.f) & 0xffffu);
            const float nr = ar * wr_ - ai * wi_, ni = ar * wi_ + ai * wr_; wr_ = nr; wi_ = ni; }
        __syncthreads();
    }
}
__device__ __forceinline__ void sincos_d(double a, double& s, double& c) {
    const double k = rint(a * 0.63661977236758134308);
    double y = fma(-k, 1.57079632679489655800e+00, a); y = fma(-k, 6.12323399573676603587e-17, y);
    const double y2 = y * y;
    double sp = -1.0 / 1307674368000.0; sp = fma(sp, y2, 1.0 / 6227020800.0); sp = fma(sp, y2, -1.0 / 39916800.0); sp = fma(sp, y2, 1.0 / 362880.0);
    sp = fma(sp, y2, -1.0 / 5040.0); sp = fma(sp, y2, 1.0 / 120.0); sp = fma(sp, y2, -1.0 / 6.0); sp = fma(sp * y2, y, y);
    double cp = 1.0 / 20922789888000.0; cp = fma(cp, y2, -1.0 / 87178291200.0); cp = fma(cp, y2, 1.0 / 479001600.0); cp = fma(cp, y2, -1.0 / 3628800.0);
    cp = fma(cp, y2, 1.0 / 40320.0); cp = fma(cp, y2, -1.0 / 720.0); cp = fma(cp, y2, 1.0 / 24.0); cp = fma(cp, y2, -0.5); cp = fma(cp, y2, 1.0);
    const int q = (int)((long long)k & 3);
    if (q == 0) { s = sp; c = cp; } else if (q == 1) { s = cp; c = -sp; } else if (q == 2) { s = -sp; c = -cp; } else { s = -cp; c = sp; }
}
__device__ __forceinline__ float wave_sum(float v) {
#pragma unroll
    for (int o = 1; o < 64; o <<= 1) v += __shfl_xor(v, o);
    return v;
}
template <class ColFn, class GainFn>
__device__ __forceinline__ void conv_T(int gw, int NGW, int& base, int lane, LAS float* scr, int Ksrc, int ldw, int Ndst, bf16_t* dst, int ldd, ColFn colp, GainFn gain, float scale) {
    const int nblk = Ndst / 32, nitems = nblk * (Ksrc / 64);
    int first = gw - (base % NGW); if (first < 0) first += NGW;
    base += nitems;
    for (int it = first; it < nitems; it += NGW) { const int kb = it / nblk, nb = it % nblk, k0 = 64 * kb, n0 = 32 * nb;
        const float* cp = colp(n0 + (lane & 31)); float v[32];
        if (cp) { const float* q = cp + (size_t)(k0 + (lane >> 5)) * ldw;
#pragma unroll
            for (int i = 0; i < 32; ++i) v[i] = q[(size_t)(2 * i) * ldw]; }
        else {
#pragma unroll
            for (int i = 0; i < 32; ++i) v[i] = 0.f; }
#pragma unroll
        for (int i = 0; i < 32; ++i) scr[(2 * i + (lane >> 5)) * 33 + (lane & 31)] = v[i];
        asm volatile("s_waitcnt lgkmcnt(0)" ::: "memory");
        const int c = lane & 7; float gk[8];
#pragma unroll
        for (int e = 0; e < 8; ++e) gk[e] = gain(k0 + 8 * c + e) * scale;
#pragma unroll
        for (int j = 0; j < 4; ++j) { const int n = (lane >> 3) + 8 * j; const LAS float* sp = scr + (8 * c) * 33 + n;
            u32x4 o; o.x = cvt_pk_bf16(sp[0 * 33] * gk[0], sp[1 * 33] * gk[1]); o.y = cvt_pk_bf16(sp[2 * 33] * gk[2], sp[3 * 33] * gk[3]); o.z = cvt_pk_bf16(sp[4 * 33] * gk[4], sp[5 * 33] * gk[5]); o.w = cvt_pk_bf16(sp[6 * 33] * gk[6], sp[7 * 33] * gk[7]);
            *(u32x4*)(dst + (size_t)(n0 + n) * ldd + k0 + 8 * c) = o; }
        asm volatile("s_waitcnt lgkmcnt(0)" ::: "memory");
    }
}
struct In {
    const float *x, *mem; const int* pos; const float *norm_mix_g, *w_in, *q_norm_g, *w_uq, *kv_norm_g, *w_ukv, *lam_re, *lam_im, *log_dt, *b_re, *b_im, *c_re, *c_im, *ssm_d, *w_glu, *b_glu,
        *attn_out_g, *ssm_out_g, *w_out, *norm_x_g, *mem_norm_g, *w_xq, *w_xkv, *w_xo, *norm_ffn_g, *w_gate, *w_up, *w_down, *final_g;
};
struct Freqs { double f[16]; };

__device__ __forceinline__ void ssm_mats(const In& in, int l, int g, int q, unsigned char* ws, LAS unsigned char* lds) {
    const int tid = threadIdx.x;
    LAS float* bbr = (LAS float*)lds; LAS float* bbi = bbr + 1024; LAS float* apr = bbi + 1024; LAS float* api = apr + 34 * 64; LAS float* cr = api + 34 * 64; LAS float* ci = cr + 1024;
    LAS float* ktabT = ci + 1024  ; LAS float* aprT = ktabT + 2048  ; LAS float* apiT = aprT + 64 * 35; LAS float* dvs = apiT + 64 * 35;
    const int lg = l * 32 + g;
    if (tid < 128) { const int p = tid & 63; const double lr = in.lam_re[lg * 64 + p], li = in.lam_im[lg * 64 + p], dt = exp((double)in.log_dt[lg]);
        double sn, cn; sincos_d(fabs(li * dt), sn, cn); if (li * dt < 0) sn = -sn;
        const double er = exp(lr * dt), ar = er * cn, ai = er * sn;
        if (tid < 64) {
            double pr = 1.0, pi = 0.0;
            for (int j = 0; j < 34; ++j) { apr[j * 64 + p] = (float)pr; api[j * 64 + p] = (float)pi; aprT[p * 35 + j] = (float)pr; apiT[p * 35 + j] = (float)pi;
                if (j == LC && q == 0) { float* al = (float*)(ws + WS_AL) + (size_t)(lg * 64 + p) * 2; al[0] = (float)pr; al[1] = (float)pi; }
                const double nr = pr * ar - pi * ai, ni = pr * ai + pi * ar; pr = nr; pi = ni; }
        } else {
            const double den = lr * lr + li * li, cfr = ((ar - 1.0) * lr + ai * li) / den, cfi = (ai * lr - (ar - 1.0) * li) / den; const float fr_ = (float)cfr, fi_ = (float)cfi;
            float bre[16], bim[16];
#pragma unroll
            for (int c = 0; c < 16; ++c) { bre[c] = in.b_re[(size_t)(lg * 64 + p) * 16 + c]; bim[c] = in.b_im[(size_t)(lg * 64 + p) * 16 + c]; }
#pragma unroll
            for (int c = 0; c < 16; ++c) { bbr[p * 16 + c] = fr_ * bre[c] - fi_ * bim[c]; bbi[p * 16 + c] = fr_ * bim[c] + fi_ * bre[c]; }
        }
    } else if (tid < 192) { const int p = tid - 128;
#pragma unroll
        for (int c = 0; c < 16; ++c) { cr[c * 64 + p] = in.c_re[(size_t)(lg * 16 + c) * 64 + p]; ci[c * 64 + p] = in.c_im[(size_t)(lg * 16 + c) * 64 + p]; }
    } else if (tid < 208) dvs[tid - 192] = in.ssm_d[l * 512 + g * 16 + (tid - 192)];
    __syncthreads();
    {
      const int j = tid >> 4, c4 = (tid >> 2) & 3, c = 4 * q + c4, c2b = (tid & 3) * 4; f32x4 sum = (f32x4){0.f, 0.f, 0.f, 0.f};
#pragma unroll 4
      for (int p = 0; p < 64; ++p) { const float yr = apr[j * 64 + p], yi = api[j * 64 + p], xr = cr[c * 64 + p], xi = ci[c * 64 + p]; const float car = xr * yr - xi * yi, cai = xr * yi + xi * yr;
          sum += car * *(const LAS f32x4*)(bbr + p * 16 + c2b) - cai * *(const LAS f32x4*)(bbi + p * 16 + c2b); }
#pragma unroll
      for (int y = 0; y < 4; ++y) ktabT[(c4 * 16 + c2b + y) * 32 + j] = sum[y]; }
    __syncthreads();
    bf16_t* bt1 = (bf16_t*)(ws + WS_SSM + (size_t)lg * SSM_G_STRIDE); bf16_t* bt3 = (bf16_t*)(ws + WS_SSM + (size_t)lg * SSM_G_STRIDE + SSM_BT3_OFF);
    for (int idx = tid; idx < 128 * 80; idx += 512) { const int rq = idx / 80, k0 = (idx % 80) * 8, s = rq >> 2, c4 = rq & 3, c = 4 * q + c4, n = s * 16 + c; float v[8];
        if (k0 < KS1) { const int s2 = k0 >> 4, c0 = k0 & 15; const float dvc = (s2 == s) ? dvs[c] : 0.f; const LAS float* kt = ktabT + (c4 * 16 + c0) * 32 + (s2 <= s ? s - s2 : 0);
#pragma unroll
            for (int e = 0; e < 8; ++e) { float t = kt[e * 32]; if (s2 > s) t = 0.f; if (c0 + e == c) t += dvc; v[e] = t; }
        } else { const int pq = k0 - KS1, p0 = pq & 63; const bool im = (pq >> 6) != 0;
            const LAS float* xrp = cr + c * 64 + p0; const LAS float* xip = ci + c * 64 + p0; const LAS float* yrp = apr + (s + 1) * 64 + p0; const LAS float* yip = api + (s + 1) * 64 + p0;
#pragma unroll
            for (int hh = 0; hh < 2; ++hh) { const f32x4 xr = *(const LAS f32x4*)(xrp + 4 * hh), xi = *(const LAS f32x4*)(xip + 4 * hh), yr = *(const LAS f32x4*)(yrp + 4 * hh), yi = *(const LAS f32x4*)(yip + 4 * hh);
                const f32x4 re = xr * yr - xi * yi, mi = -(xr * yi + xi * yr);
#pragma unroll
                for (int e = 0; e < 4; ++e) v[4 * hh + e] = im ? mi[e] : re[e]; }
        }
        u32x4 o; o.x = cvt_pk_bf16(v[0], v[1]); o.y = cvt_pk_bf16(v[2], v[3]); o.z = cvt_pk_bf16(v[4], v[5]); o.w = cvt_pk_bf16(v[6], v[7]);
        *(u32x4*)(bt3 + (size_t)n * KS3 + k0) = o; }
    for (int idx = tid; idx < 64 * 64; idx += 512) { const int rq = idx >> 6, k0 = (idx & 63) * 8, s2 = k0 >> 4, c0 = k0 & 15; float v[8];
        const bool real_row = rq < 32; const int p = 16 * q + (rq & 15); const bool im = (rq >> 4) & 1; const int n = real_row ? (im ? 64 + p : p) : 128 + 32 * q + (rq - 32);
        if (real_row) { const float yr = aprT[p * 35 + (LC - 1 - s2)], yi = apiT[p * 35 + (LC - 1 - s2)];
#pragma unroll
            for (int hh = 0; hh < 2; ++hh) { const f32x4 br = *(const LAS f32x4*)(bbr + p * 16 + c0 + 4 * hh), bi = *(const LAS f32x4*)(bbi + p * 16 + c0 + 4 * hh);
                const f32x4 re = br * yr - bi * yi, mi = bi * yr + br * yi;
#pragma unroll
                for (int e = 0; e < 4; ++e) v[4 * hh + e] = im ? mi[e] : re[e]; }
        } else {
#pragma unroll
            for (int e = 0; e < 8; ++e) v[e] = 0.f; }
        u32x4 o; o.x = cvt_pk_bf16(v[0], v[1]); o.y = cvt_pk_bf16(v[2], v[3]); o.z = cvt_pk_bf16(v[4], v[5]); o.w = cvt_pk_bf16(v[6], v[7]);
        *(u32x4*)(bt1 + (size_t)n * KS1 + k0) = o; }
    __syncthreads();
}

__device__ __forceinline__ void prologue(const In& in, const Freqs& fr, unsigned char* ws, LAS unsigned char* lds, int vcu, int G, int parts) {
    const int tid = threadIdx.x, lane = tid & 63, wave = __builtin_amdgcn_readfirstlane(tid >> 6);
    __syncthreads();
    if (parts & 1) for (int j = vcu; j < 256; j += G) ssm_mats(in, j >> 7, (j >> 2) & 31, j & 3, ws, lds);
    LAS float* scr = (LAS float*)(lds + wave * 16384);
    const int gw = vcu * 8 + wave, NGW = G * 8;
    if (parts & 2) {
    { bf16_t* hb = (bf16_t*)(ws + WS_HB); float* sq0 = (float*)(ws + WS_CTL) + CW_SQ + (size_t)SQ_MIX * T;
      for (int r = gw * 2; r < T; r += NGW * 2) { const f32x4* xr = (const f32x4*)(in.x + (size_t)r * D) + lane; u32x2* hrow = (u32x2*)(hb + (size_t)r * D) + lane; f32x4 v[8];
#pragma unroll
          for (int j = 0; j < 8; ++j) v[j] = xr[64 * j];
          float s0 = 0.f, s1 = 0.f;
#pragma unroll
          for (int j = 0; j < 4; ++j) { s0 += (v[j][0] * v[j][0] + v[j][1] * v[j][1]) + (v[j][2] * v[j][2] + v[j][3] * v[j][3]); s1 += (v[j + 4][0] * v[j + 4][0] + v[j + 4][1] * v[j + 4][1]) + (v[j + 4][2] * v[j + 4][2] + v[j + 4][3] * v[j + 4][3]); }
#pragma unroll
          for (int j = 0; j < 8; ++j) hrow[64 * j] = (u32x2){cvt_pk_bf16(v[j][0], v[j][1]), cvt_pk_bf16(v[j][2], v[j][3])};
          s0 = wave_sum(s0); s1 = wave_sum(s1); if (lane == 0) { sq0[r] = s0; sq0[r + 1] = s1; } } }
    { bf16_t* mn = (bf16_t*)(ws + WS_RA + RA_MEMN);
      for (int r = gw; r < NB * MEMT; r += NGW) { const f32x4* xr = (const f32x4*)(in.mem + (size_t)r * D) + lane; u32x2* mrow = (u32x2*)(mn + (size_t)r * D) + lane; f32x4 v[4]; float s = 0.f;
#pragma unroll
          for (int j = 0; j < 4; ++j) { v[j] = xr[64 * j]; s += (v[j][0] * v[j][0] + v[j][1] * v[j][1]) + (v[j][2] * v[j][2] + v[j][3] * v[j][3]); }
          const float rs = rstd_of(wave_sum(s), 1.0f / 1024.0f);
#pragma unroll
          for (int j = 0; j < 4; ++j) mrow[64 * j] = (u32x2){cvt_pk_bf16(v[j][0] * rs, v[j][1] * rs), cvt_pk_bf16(v[j][2] * rs, v[j][3] * rs)}; } }
    { float* cs = (float*)(ws + WS_CS);
      for (int i = vcu * 512 + tid; i < T * 16; i += G * 512) { const int t = i >> 4, j = i & 15; double s, c; sincos_d((double)in.pos[t] * fr.f[j], s, c); cs[(size_t)t * 32 + j] = (float)c; cs[(size_t)t * 32 + 16 + j] = (float)s; } }
    }
    if (!(parts & 4)) return;
    int cbase = 0;
    for (int l = 0; l < NL; ++l) {
        unsigned char* wl = ws + WS_W + (size_t)l * WL_STRIDE;
        { const float* W = in.w_in + (size_t)l * D * 928; const float* gn = in.norm_mix_g + l * D;
          conv_T(gw, NGW, cbase, lane, scr, D, 928, 1024, (bf16_t*)(wl + WL_IN), 1024,
                 [=](int n) -> const float* { if (n < 384) return W + n; if (n < 416) { const int i = n - 384; return W + ((i & 1) ? 400 + (i >> 1) : 384 + (i >> 1)); } if (n < 512) return nullptr; return W + 416 + (n - 512); },
                 [=](int k) { return gn[k]; }, 1.0f); }
        { const float* W = in.w_uq + (size_t)l * 256 * 768; const float* gn = in.q_norm_g + l * 256;
          conv_T(gw, NGW, cbase, lane, scr, 256, 768, 768, (bf16_t*)(wl + WL_UP), 256,
                 [=](int n) -> const float* { if (n < 512) return W + (n >> 6) * 96 + (n & 63); const int h = (n - 512) >> 5, i = (n - 512) & 31; return W + h * 96 + ((i & 1) ? 80 + (i >> 1) : 64 + (i >> 1)); },
                 [=](int k) { return gn[k]; }, 0.10206207261596575f * LOG2E); }
        { const float* W = in.w_ukv + (size_t)l * 128 * 1024; const float* gn = in.kv_norm_g + l * 128; bf16_t* dst = (bf16_t*)(wl + WL_UP) + (size_t)768 * 256;
          conv_T(gw, NGW, cbase, lane, scr, 128, 1024, 1024, dst, 256, [=](int n) -> const float* { return W + n; }, [=](int k) { return gn[k]; }, 1.0f);
          for (int i = vcu * 512 + tid; i < 1024 * 16; i += G * 512) *(u32x4*)(dst + (size_t)(i >> 4) * 256 + 128 + (i & 15) * 8) = (u32x4){0u, 0u, 0u, 0u}; }
        { const float* W = in.w_glu + (size_t)l * 512 * 512;
          conv_T(gw, NGW, cbase, lane, scr, 512, 512, 512, (bf16_t*)(wl + WL_GLU), 512, [=](int n) -> const float* { return W + n; }, [=](int) { return 1.0f; }, 1.0f); }
        { const float* W = in.w_out + (size_t)l * D * D; const float* ga = in.attn_out_g + l * 512; const float* gs = in.ssm_out_g + l * 512;
          conv_T(gw, NGW, cbase, lane, scr, D, D, D, (bf16_t*)(wl + WL_OUT), D, [=](int n) -> const float* { return W + n; }, [=](int k) { return k < 512 ? ga[k] : gs[k - 512]; }, 1.0f); }
        { const float* W = in.w_xkv + (size_t)l * D * 2048; const float* gn = in.mem_norm_g + l * D;
          conv_T(gw, NGW, cbase, lane, scr, D, 2048, 2048, (bf16_t*)(ws + WS_WXKV) + (size_t)l * 2048 * D, D, [=](int n) -> const float* { return W + n; }, [=](int k) { return gn[k]; }, 1.0f); }
        { const float* W = in.w_xo + (size_t)l * D * D;
          conv_T(gw, NGW, cbase, lane, scr, D, D, D, (bf16_t*)(ws + WS_WXO) + (size_t)l * D * D, D, [=](int n) -> const float* { return W + n; }, [=](int) { return 1.0f; }, 1.0f); }
        { const float* Wg = in.w_gate + (size_t)l * D * FF; const float* Wu = in.w_up + (size_t)l * D * FF; const float* gn = in.norm_ffn_g + l * D;
          conv_T(gw, NGW, cbase, lane, scr, D, FF, 2 * FF, (bf16_t*)(wl + WL_GU), D,
                 [=](int n) -> const float* { const int tl = n >> 8, r = n & 255; return r < 128 ? Wg + tl * 128 + r : Wu + tl * 128 + (r - 128); }, [=](int k) { return gn[k]; }, 1.0f); }
        { const float* W = in.w_down + (size_t)l * FF * D;
          conv_T(gw, NGW, cbase, lane, scr, FF, D, D, (bf16_t*)(wl + WL_DN), FF, [=](int n) -> const float* { return W + n; }, [=](int) { return 1.0f; }, 1.0f); }
        { const float* W = in.w_xq + (size_t)l * D * D; const float* gn = in.norm_x_g + l * D; bf16_t* dst = (bf16_t*)(wl + WL_XQ);
          for (int i = vcu * 512 + tid; i < D * D / 8; i += G * 512) { const int k = i >> 7; const float sc = gn[k] * (0.0625f * LOG2E); const f32x4 a = *(const f32x4*)(W + (size_t)i * 8) * sc, b = *(const f32x4*)(W + (size_t)i * 8 + 4) * sc;
              *(u32x4*)(dst + (size_t)i * 8) = ep::pack8(a, b); } }
    }
}
struct Args { In in; float* out; unsigned char* ws; Freqs fr; int ph_hi; int pad; };

template <class F> struct PanelFn { F f; __device__ __forceinline__ void operator()(const pg8::Unit& u, const char*& a, const char*& b) const { f(u, a, b); } };
template <class F> __device__ __forceinline__ PanelFn<F> make_panel(F f) { return PanelFn<F>{f}; }
template <class F> struct OutFnT { F f; __device__ __forceinline__ bf16_t* operator()(const pg8::Unit& u, int& ld) const { return f(u, ld); } };
template <class F> __device__ __forceinline__ ep::EpiStore<OutFnT<F>> make_store(F f) { return ep::EpiStore<OutFnT<F>>{OutFnT<F>{f}}; }

__global__ void __launch_bounds__(512, 2) mk_fwd(Args a) {
    extern __shared__ __attribute__((aligned(16))) unsigned char lds_raw[];
    LAS unsigned char* lds = (LAS unsigned char*)lds_raw;
    const int tid = threadIdx.x, lane = tid & 63, wave = __builtin_amdgcn_readfirstlane(tid >> 6);
    const int G = gridDim.x, bx = blockIdx.x, vcu = (G % 8 == 0) ? (bx % 8) * (G / 8) + bx / 8 : bx;
    unsigned char* ws = a.ws; float* out = a.out;
    unsigned* ctl = (unsigned*)(ws + WS_CTL);
    for (int u = tid; u < (LDS_BYTES - LDSCTL_OFF) / 4; u += 512) ((LAS unsigned*)(lds + LDSCTL_OFF))[u] = 0u;
    __syncthreads();
    XcdBarrier bar = xcd_barrier_post(ctl + CW_BAR, (volatile LAS unsigned*)(lds + LDSCTL_OFF));
    int ph = 0;
#ifndef MK_MASK
#define MK_MASK 0xffff
#endif
#ifdef MK_TSET
    unsigned long long t_prev = __builtin_amdgcn_s_memrealtime(), t_acc = 0ull; int id_prev = -1;
#define T_STAMP(id) { const unsigned long long t_now = __builtin_amdgcn_s_memrealtime(); if (id_prev >= 0 && ((MK_TSET >> id_prev) & 1)) t_acc += t_now - t_prev; t_prev = t_now; id_prev = (id); }
#ifdef MK_TBAR
#define GRID_BAR { const unsigned long long tb0 = __builtin_amdgcn_s_memrealtime(); xcd_barrier(bar); t_acc += __builtin_amdgcn_s_memrealtime() - tb0; }
#else
#define GRID_BAR xcd_barrier(bar)
#endif
#else
#define T_STAMP(id)
#ifdef MK_DBLBAR
#define GRID_BAR { xcd_barrier(bar); xcd_barrier(bar); }
#else
#define GRID_BAR xcd_barrier(bar)
#endif
#endif
#define PHASE_BEGIN(id) if (ph++ >= a.ph_hi) return; T_STAMP(id) if ((MK_MASK >> (id)) & 1)
    float* sqb = (float*)ctl + CW_SQ;
#define SQ(l, id) (sqb + (size_t)((l) * SQ_PER_LAYER + (id)) * T)
    bf16_t* hb = (bf16_t*)(ws + WS_HB); bf16_t* assm = (bf16_t*)(ws + WS_ASSM); const float* cs = (const float*)(ws + WS_CS);
    unsigned char* ra = ws + WS_RA;
    pg8::StaticOrder SO;
#ifdef MK_CLKPROBE
    unsigned clk_mhz = 0;
#endif
    const long NEVER = 1 << 30;

#ifndef MK_REP_PRO
#define MK_REP_PRO 1
#define MK_REP_PARTS 7
#define MK_REP_ATTN 1
#define MK_REP_P9 1
#endif
    PHASE_BEGIN(0) { for (int rep = 0; rep < MK_REP_PRO; ++rep) prologue(a.in, a.fr, ws, lds, vcu, G, rep ? MK_REP_PARTS : 7); } GRID_BAR;
    PHASE_BEGIN(1) {
        const char* A0 = (const char*)(ra + RA_MEMN); const char* B0 = (const char*)(ws + WS_WXKV); bf16_t* kvm = (bf16_t*)(ra + RA_KVM);
        SO.init(8, 16, G, bx);
        auto PN = make_panel([=](const pg8::Unit& u, const char*& pa, const char*& pb) { pa = A0 + (size_t)u.pm * 256 * 1024 * 2; pb = B0 + (size_t)u.pn * 256 * 1024 * 2; });
        auto E = make_store([=](const pg8::Unit& u, int& ld) -> bf16_t* { ld = 2048; return kvm + ((size_t)(u.pn >> 3) * 2048 + u.pm * 256) * 2048 + (u.pn & 7) * 256; });
        pg8::gemm_phase(lds, pg8::GemmArgs{1024, 1024, 1024, (int)NEVER, 0}, SO, PN, E);
    } GRID_BAR;
    PHASE_BEGIN(2) {
        const char* kvm = (const char*)(ra + RA_KVM); bf16_t* wkvw = (bf16_t*)(ws + WS_WKVW);
        { SO.init(64, 4, G, bx);
          const char* wx = (const char*)(ws + WS_W + WL_XQ);
          auto PN = make_panel([=](const pg8::Unit& u, const char*& pa, const char*& pb) { const int l = u.pm >> 5, b = (u.pm >> 2) & 7, h = u.pm & 3;
              pa = kvm + (((size_t)l * 2048 + b * 256) * 2048 + h * 256) * 2; pb = wx + (size_t)l * WL_STRIDE + ((size_t)u.pn * 256 * 1024 + h * 256) * 2; });
          auto E = make_store([=](const pg8::Unit& u, int& ld) -> bf16_t* { const int l = u.pm >> 5, b = (u.pm >> 2) & 7, h = u.pm & 3; ld = 1024;
              return wkvw + ((size_t)(l * 16 + b) << 20) + (size_t)(h * 256) * 1024 + u.pn * 256; });
          pg8::gemm_phase(lds, pg8::GemmArgs{256, 2048, 1024, (int)NEVER, 0}, SO, PN, E); }
        { SO.init(256, 1, G, bx);
          const char* wo = (const char*)(ws + WS_WXO);
          auto PN = make_panel([=](const pg8::Unit& u, const char*& pa, const char*& pb) { const int rt = u.pm & 3, h = (u.pm >> 2) & 3, b = (u.pm >> 4) & 7, l = u.pm >> 7;
              pa = wo + (((size_t)l * 1024 + rt * 256) * 1024 + h * 256) * 2; pb = kvm + (((size_t)l * 2048 + b * 256) * 2048 + 1024 + h * 256) * 2; });
          auto E = make_store([=](const pg8::Unit& u, int& ld) -> bf16_t* { const int rt = u.pm & 3, h = (u.pm >> 2) & 3, b = (u.pm >> 4) & 7, l = u.pm >> 7; ld = 1024;
              return wkvw + ((size_t)(l * 16 + 8 + b) << 20) + (size_t)(rt * 256) * 1024 + h * 256; });
          pg8::gemm_phase(lds, pg8::GemmArgs{256, 1024, 2048, (int)NEVER, 0}, SO, PN, E); }
    } GRID_BAR;

    for (int l = 0; l < NL; ++l) {
        const char* wl = (const char*)(ws + WS_W + (size_t)l * WL_STRIDE);
        PHASE_BEGIN(3) {
            SO.init(128, 4, G, bx);
            auto PN = make_panel([=](const pg8::Unit& u, const char*& pa, const char*& pb) { pa = (const char*)hb + (size_t)u.pm * 256 * 1024 * 2; pb = wl + WL_IN + (size_t)u.pn * 256 * 1024 * 2; });
            ep::EpiProj E{SQ(l, SQ_MIX), SQ(l, SQ_CQ), SQ(l, SQ_CKV), (bf16_t*)(ra + RA_PROJB), assm, ra + RA_K, cs};
            pg8::gemm_phase(lds, pg8::GemmArgs{1024, 1024, 1024, (int)NEVER, 0}, SO, PN, E);
        } GRID_BAR;
        PHASE_BEGIN(4) {
            const char* pj = (const char*)(ra + RA_PROJB);
            { SO.init(128, 7, G, bx);
              auto PN = make_panel([=](const pg8::Unit& u, const char*& pa, const char*& pb) { pa = pj + (size_t)u.pm * 256 * 512 * 2 + (u.pn >= 3 ? 512 : 0); pb = wl + WL_UP + (size_t)u.pn * 256 * 256 * 2; });
              ep::EpiUp E{ep::EpiQ{SQ(l, SQ_CQ), (bf16_t*)(ra + RA_Q), cs}, ep::EpiKV{SQ(l, SQ_CKV), ra + RA_K, ra + RA_V}};
              pg8::gemm_phase(lds, pg8::GemmArgs{256, 512, 256, (int)NEVER, 0}, SO, PN, E); }
            { SO.init(128, 1, G, (bx + G / 2) % G);
              const char* bt = (const char*)(ws + WS_SSM) + (size_t)l * 32 * SSM_G_STRIDE;
              auto PN = make_panel([=](const pg8::Unit& u, const char*& pa, const char*& pb) { pa = (const char*)assm + (size_t)u.pm * 256 * KS3 * 2; pb = bt + (size_t)(u.pm >> 2) * SSM_G_STRIDE; });
              ep::EpiXloc E{(float*)(ra + RA_XLOC)};
              pg8::gemm_phase(lds, pg8::GemmArgs{KS1, KS3, KS1, (int)NEVER, 0}, SO, PN, E); }
        } GRID_BAR;
        PHASE_BEGIN(5) {
            ssm_scan_phase(vcu, G, (const float*)(ra + RA_XLOC), (const float*)(ws + WS_AL) + (size_t)l * 32 * 64 * 2, assm, lds);
            for (int rep = 0; rep < MK_REP_ATTN; ++rep) att::attn_phase(vcu, G, (const bf16_t*)(ra + RA_Q), ra + RA_K, ra + RA_V, (bf16_t*)(ra + RA_AO), rep ? SQ(2, 1) : SQ(l, SQ_A), lds);
        } GRID_BAR;
        PHASE_BEGIN(6) {
            SO.init(128, 2, G, bx);
            const char* bt = (const char*)(ws + WS_SSM) + (size_t)l * 32 * SSM_G_STRIDE + SSM_BT3_OFF;
            auto PN = make_panel([=](const pg8::Unit& u, const char*& pa, const char*& pb) { pa = (const char*)assm + (size_t)u.pm * 256 * KS3 * 2; pb = bt + (size_t)(u.pm >> 2) * SSM_G_STRIDE + (size_t)u.pn * 256 * KS3 * 2; });
            ep::EpiY E{(bf16_t*)(ra + RA_Y), (bf16_t*)(ra + RA_G)};
            pg8::gemm_phase(lds, pg8::GemmArgs{KS3, KS3, KS3, (int)NEVER, 0}, SO, PN, E);
        } GRID_BAR;
        PHASE_BEGIN(7) {
            SO.init(128, 2, G, bx);
            const char* gb = (const char*)(ra + RA_G);
            auto PN = make_panel([=](const pg8::Unit& u, const char*& pa, const char*& pb) { pa = gb + (size_t)u.pm * 256 * 512 * 2; pb = wl + WL_GLU + (size_t)u.pn * 256 * 512 * 2; });
            ep::EpiGlu E{(const bf16_t*)(ra + RA_Y), a.in.b_glu + l * 512, (bf16_t*)(ra + RA_SOUT), SQ(l, SQ_S)};
            pg8::gemm_phase(lds, pg8::GemmArgs{512, 512, 512, (int)NEVER, 0}, SO, PN, E);
        } GRID_BAR;
        PHASE_BEGIN(8) {
            SO.init(128, 4, G, bx);
            const char* ao = (const char*)(ra + RA_AO);
            auto PN = make_panel([=](const pg8::Unit& u, const char*& pa, const char*& pb) { pa = ao + (size_t)u.pm * 256 * 512 * 2; pb = wl + WL_OUT + (size_t)u.pn * 256 * 1024 * 2; });
            ep::EpiRes<true> E{l == 0 ? a.in.x : nullptr, nullptr, hb, SQ(l, SQ_X), SQ(l, SQ_A), SQ(l, SQ_S)};
            pg8::gemm_phase(lds, pg8::GemmArgs{1024, 512, 1024, 8, (long)(RA_SOUT - RA_AO) - 8 * 128}, SO, PN, E);
        } GRID_BAR;
        PHASE_BEGIN(9) {
            SO.init(128, 4, G, bx);
            const char* wk = (const char*)(ws + WS_WKVW) + ((size_t)(l * 16) << 21);
            auto PN = make_panel([=](const pg8::Unit& u, const char*& pa, const char*& pb) { pa = (const char*)hb + (size_t)u.pm * 256 * 1024 * 2; pb = wk + ((size_t)(u.pm >> 4) << 21) + (size_t)u.pn * 256 * 1024 * 2; });
            ep::EpiSoftmax E{SQ(l, SQ_X), (bf16_t*)(ra + RA_P)};
            pg8::gemm_phase(lds, pg8::GemmArgs{1024, 1024, 1024, (int)NEVER, 0}, SO, PN, E);
        } GRID_BAR;
        PHASE_BEGIN(10) {
            SO.init(128, 4, G, bx);
            const char* vw = (const char*)(ws + WS_WKVW) + ((size_t)(l * 16 + 8) << 21); const char* pp = (const char*)(ra + RA_P);
            auto PN = make_panel([=](const pg8::Unit& u, const char*& pa, const char*& pb) { pa = pp + (size_t)u.pm * 256 * 1024 * 2; pb = vw + ((size_t)(u.pm >> 4) << 21) + (size_t)u.pn * 256 * 1024 * 2; });
            ep::EpiRes<false> E{nullptr, nullptr, hb, SQ(l, SQ_FFN), nullptr, nullptr};
            pg8::gemm_phase(lds, pg8::GemmArgs{1024, 1024, 1024, (int)NEVER, 0}, SO, PN, E);
        } GRID_BAR;
#ifdef MK_CLKPROBE
        unsigned long long ck0 = __builtin_amdgcn_s_memtime(), rk0 = __builtin_amdgcn_s_memrealtime();
#endif
        PHASE_BEGIN(11) {
            SO.init(128, 22, G, bx);
            auto PN = make_panel([=](const pg8::Unit& u, const char*& pa, const char*& pb) { pa = (const char*)hb + (size_t)u.pm * 256 * 1024 * 2; pb = wl + WL_GU + (size_t)u.pn * 256 * 1024 * 2; });
            ep::EpiSwiglu E{SQ(l, SQ_FFN), (bf16_t*)(ra + RA_HID)};
            for (int rep = 0; rep < MK_REP_P9; ++rep) pg8::gemm_phase(lds, pg8::GemmArgs{1024, 1024, 1024, (int)NEVER, 0}, SO, PN, E);
        } GRID_BAR;
#ifdef MK_CLKPROBE
        if (l == 0) { const unsigned long long ck1 = __builtin_amdgcn_s_memtime(), rk1 = __builtin_amdgcn_s_memrealtime(); clk_mhz = (unsigned)(((ck1 - ck0) * 100ull) / (rk1 - rk0)); }
#endif
        PHASE_BEGIN(12) {
            SO.init(128, 4, G, bx);
            const char* hd = (const char*)(ra + RA_HID);
            auto PN = make_panel([=](const pg8::Unit& u, const char*& pa, const char*& pb) { pa = hd + (size_t)u.pm * 256 * FF * 2; pb = wl + WL_DN + (size_t)u.pn * 256 * FF * 2; });
            ep::EpiRes<false> E{nullptr, l == NL - 1 ? out : nullptr, hb, SQ(l + 1, SQ_MIX), nullptr, nullptr};
            pg8::gemm_phase(lds, pg8::GemmArgs{FF, FF, FF, (int)NEVER, 0}, SO, PN, E);
        } GRID_BAR;
    }
    PHASE_BEGIN(13) {
        const float* sqf = SQ(NL, SQ_MIX); const float* gf = a.in.final_g;
        const f32x4* gr = (const f32x4*)gf + lane; f32x4 gv[4];
#pragma unroll
        for (int j = 0; j < 4; ++j) gv[j] = gr[64 * j];
        for (int r = (vcu * 8 + wave) * 4; r < T; r += G * 8 * 4) { f32x4* orow = (f32x4*)(out + (size_t)r * D) + lane; f32x4 v[16]; float rs[4];
#pragma unroll
            for (int q = 0; q < 4; ++q) rs[q] = sqf[r + q];
#pragma unroll
            for (int j = 0; j < 16; ++j) v[j] = orow[64 * j];
#pragma unroll
            for (int j = 0; j < 16; ++j) orow[64 * j] = v[j] * rstd_of(rs[j >> 2], 1.0f / 1024.0f) * gv[j & 3]; }
    }
#ifdef MK_CLKPROBE
    if (blockIdx.x == 0) { const unsigned long long t_end = __builtin_amdgcn_s_memrealtime(); while (__builtin_amdgcn_s_memrealtime() - t_end < (unsigned long long)clk_mhz * 50ull) __builtin_amdgcn_s_sleep(8); }
#endif
#ifdef MK_TSET
    T_STAMP(14)
    if (blockIdx.x == 0) { const unsigned long long t_end = __builtin_amdgcn_s_memrealtime(); while (__builtin_amdgcn_s_memrealtime() - t_end < t_acc) __builtin_amdgcn_s_sleep(8); }
#endif
#undef PHASE_BEGIN
#undef GRID_BAR
#undef SQ
}

extern "C" void kernel_launch(void* const* d_in, const int* in_sizes, int n_in, void* d_out, int out_size, void* d_ws, size_t ws_size, hipStream_t stream) {
    static int grid = 0;
    if (grid == 0) {
        if (n_in != 32 || out_size != T * D || ws_size < WS_END) { fprintf(stderr, "kernel_launch: unexpected shapes (n_in %d out %d ws %zu)\n", n_in, out_size, ws_size); grid = -1; return; }
        int dev = 0, cus = 0, per_cu = 0;
        if (hipGetDevice(&dev) != hipSuccess || hipDeviceGetAttribute(&cus, hipDeviceAttributeMultiprocessorCount, dev) != hipSuccess) { grid = -1; return; }
        if (hipFuncSetAttribute((const void*)mk_fwd, hipFuncAttributeMaxDynamicSharedMemorySize, LDS_BYTES) != hipSuccess) { fprintf(stderr, "kernel_launch: hipFuncSetAttribute failed\n"); grid = -1; return; }
        if (hipOccupancyMaxActiveBlocksPerMultiprocessor(&per_cu, (const void*)mk_fwd, 512, LDS_BYTES) != hipSuccess || per_cu < 1) { fprintf(stderr, "kernel_launch: occupancy query says %d\n", per_cu); per_cu = 1; }
        (void)hipGetLastError();
        grid = cus;
    }
    if (grid < 0) return;
    if (hipMemsetAsync((char*)d_ws + WS_CTL, 0, CTL_ZERO_BYTES, stream) != hipSuccess) return;
    Args a{};
    const void** ip = (const void**)&a.in;
    for (int i = 0; i < 32; ++i) ip[i] = d_in[i];
    a.out = (float*)d_out; a.ws = (unsigned char*)d_ws;
    for (int i = 0; i < 16; ++i) a.fr.f[i] = std::pow(10000.0, -(double)i / 16.0);
#ifndef MK_PH_HI
#define MK_PH_HI 1000
#endif
    a.ph_hi = MK_PH_HI; a.pad = 0;
    void* args[] = {&a};
    hipError_t e = hipLaunchCooperativeKernel((const void*)mk_fwd, dim3(grid), dim3(512), args, LDS_BYTES, stream);
    if (e != hipSuccess) fprintf(stderr, "kernel_launch: cooperative launch failed: %s (grid %d)\n", hipGetErrorString(e), grid);
}
```
